# Optimizing an MI355X kernel written in HIP

```python
import jax, jax.numpy as jnp
from jax import lax
import numpy as np

D_MODEL = 1024
BATCH = 4
SEQ = 4096
DEPTH = 1

D_MIX = D_MODEL
MLSTM_WIDTH = D_MIX // 2
MLSTM_HEADS = 4
MLSTM_HEAD_DIM = MLSTM_WIDTH // MLSTM_HEADS
MLSTM_CHUNK = 64
CONV_WIDTH = 4
POOL_WIDTH = D_MIX - MLSTM_WIDTH
POOL_WINDOWS = (2, 4, 8, 16)
POOL_GROUPS = len(POOL_WINDOWS)
POOL_GROUP_DIM = POOL_WIDTH // POOL_GROUPS
N_IN = 4 * MLSTM_WIDTH + 2 * MLSTM_HEADS + POOL_WIDTH
N_EXPERTS = 32
TOP_K = 4
D_FF = D_MODEL
SWIGLU_LIMIT = 7.0
SWIGLU_ALPHA = 1.702
EXPERT_BLOCK = 128
EPS = 1e-5

kernel_name = "hybrid_mlstm_pool_moe_block"


def rmsnorm(x, g):
    xf = x.astype(jnp.float32)
    y = xf * lax.rsqrt(jnp.mean(xf * xf, axis=-1, keepdims=True) + EPS)
    return (y * g.astype(jnp.float32)).astype(x.dtype)


def causal_depthwise_conv(u, w):
    k = w.shape[0]
    return lax.conv_general_dilated(
        u, w[:, None, :].astype(u.dtype), window_strides=(1,), padding=[(k - 1, 0)],
        dimension_numbers=("NWC", "WIO", "NWC"), feature_group_count=u.shape[-1])


def mlstm_chunkwise(q, k, v, ig, lf):
    B, H, S, Dh = q.shape
    L = MLSTM_CHUNK
    NC = S // L
    q = q.reshape(B, H, NC, L, Dh)
    k = k.reshape(B, H, NC, L, Dh)
    v = v.reshape(B, H, NC, L, Dh)
    ig = ig.reshape(B, H, NC, L)
    lf = lf.reshape(B, H, NC, L)
    b = jnp.cumsum(lf, axis=-1)
    b_tot = b[..., -1]

    g = b_tot[..., None] - b + ig
    m_loc = jnp.max(g, axis=-1)
    w_loc = jnp.exp(g - m_loc[..., None])
    C_loc = jnp.einsum("bhclk,bhclv->bhckv", w_loc[..., None] * k, v)
    n_loc = jnp.einsum("bhcl,bhclk->bhck", w_loc, k)

    def step(carry, inp):
        C, n, m = carry
        C_l, n_l, m_l, bt = inp
        m_new = jnp.maximum(bt + m, m_l)
        s_old = jnp.exp(bt + m - m_new)
        s_loc = jnp.exp(m_l - m_new)
        C_new = s_old[..., None, None] * C + s_loc[..., None, None] * C_l
        n_new = s_old[..., None] * n + s_loc[..., None] * n_l
        return (C_new, n_new, m_new), (C, n, m)

    init = (jnp.zeros((B, H, Dh, Dh), jnp.float32),
            jnp.zeros((B, H, Dh), jnp.float32),
            jnp.zeros((B, H), jnp.float32))
    xs = (jnp.moveaxis(C_loc, 2, 0), jnp.moveaxis(n_loc, 2, 0),
          jnp.moveaxis(m_loc, 2, 0), jnp.moveaxis(b_tot, 2, 0))
    _, (C_in, n_in, m_in) = lax.scan(step, init, xs)
    C_in = jnp.moveaxis(C_in, 0, 2)
    n_in = jnp.moveaxis(n_in, 0, 2)
    m_in = jnp.moveaxis(m_in, 0, 2)

    causal = jnp.tril(jnp.ones((L, L), dtype=bool))
    log_d = b[..., :, None] - b[..., None, :] + ig[..., None, :]
    log_d = jnp.where(causal, log_d, -jnp.inf)
    a = b + m_in[..., None]
    m_out = jnp.maximum(a, jnp.max(log_d, axis=-1))
    s = jnp.einsum("bhcld,bhcrd->bhclr", q, k) * jnp.exp(log_d - m_out[..., None])
    inter = jnp.exp(a - m_out)
    num = (jnp.einsum("bhclr,bhcrv->bhclv", s, v)
           + inter[..., None] * jnp.einsum("bhcld,bhcdv->bhclv", q, C_in))
    den = jnp.sum(s, axis=-1) + inter * jnp.einsum("bhcld,bhcd->bhcl", q, n_in)
    h = num / jnp.maximum(jnp.abs(den), jnp.exp(-m_out))[..., None]
    return h.reshape(B, H, S, Dh)


def multiscale_pool(u, pool_w, pool_scale):
    B, S, _ = u.shape
    uf = u.astype(jnp.float32).reshape(B, S, POOL_GROUPS, POOL_GROUP_DIM)
    cs = jnp.concatenate([jnp.zeros((B, 1, POOL_GROUPS, POOL_GROUP_DIM), jnp.float32),
                          jnp.cumsum(uf, axis=1)], axis=1)
    t = jnp.arange(S)
    pooled = []
    for gi, w in enumerate(POOL_WINDOWS):
        c = cs[:, :, gi]
        c_lo = jnp.concatenate([jnp.zeros((B, w - 1, POOL_GROUP_DIM), jnp.float32),
                                c[:, :S - w + 1]], axis=1)
        cnt = jnp.minimum(t + 1, w).astype(jnp.float32)
        pooled.append((c[:, 1:] - c_lo) / cnt[None, :, None])
    pooled = jnp.stack(pooled, axis=2) - uf
    mixed = jnp.einsum("bsgc,gcd->bsgd", pooled, pool_w.astype(jnp.float32))
    mixed = mixed.reshape(B, S, POOL_WIDTH) * pool_scale.astype(jnp.float32)
    return mixed.astype(u.dtype)


def hybrid_mixer(h, w_in, ig_b, fg_b, conv_w, head_norm_g, pool_w, pool_scale, w_out):
    B, S, _ = h.shape
    W, H, Dh = MLSTM_WIDTH, MLSTM_HEADS, MLSTM_HEAD_DIM
    p = h @ w_in
    qk = p[..., :2 * W]
    v = p[..., 2 * W:3 * W]
    o = p[..., 3 * W:4 * W]
    gates = p[..., 4 * W:4 * W + 2 * H].astype(jnp.float32)
    u = p[..., 4 * W + 2 * H:]

    qk = jax.nn.silu(causal_depthwise_conv(qk, conv_w))

    def to_heads(t):
        return t.reshape(B, S, H, Dh).transpose(0, 2, 1, 3).astype(jnp.float32)

    q = to_heads(qk[..., :W])
    k = to_heads(qk[..., W:]) * (Dh ** -0.5)
    vh = to_heads(v)
    ig = (gates[..., :H] + ig_b.astype(jnp.float32)).transpose(0, 2, 1)
    lf = jax.nn.log_sigmoid(gates[..., H:] + fg_b.astype(jnp.float32)).transpose(0, 2, 1)
    hm = mlstm_chunkwise(q, k, vh, ig, lf)
    mu = jnp.mean(hm, axis=-1, keepdims=True)
    var = jnp.mean(jnp.square(hm - mu), axis=-1, keepdims=True)
    hm = (hm - mu) * lax.rsqrt(var + EPS)
    hm = hm.transpose(0, 2, 1, 3).reshape(B, S, W) * head_norm_g.astype(jnp.float32)
    y_m = (jax.nn.sigmoid(o.astype(jnp.float32)) * hm).astype(h.dtype)

    y_p = multiscale_pool(u, pool_w, pool_scale)

    return jnp.concatenate([y_m, y_p], axis=-1) @ w_out


def moe_ffn(h, w_router, b_router, w_gate, b_gate, w_up, b_up, w_down, b_down):
    B, S, D = h.shape
    T = B * S
    xt = h.reshape(T, D)
    logits = (xt @ w_router + b_router).astype(jnp.float32)
    top_vals, top_idx = lax.top_k(logits, TOP_K)
    top_gates = jax.nn.softmax(top_vals, axis=-1)

    A = T * TOP_K
    flat_expert = top_idx.reshape(A)
    flat_token = jnp.repeat(jnp.arange(T, dtype=jnp.int32), TOP_K)
    flat_gate = top_gates.reshape(A)
    order = jnp.argsort(flat_expert)
    s_expert = flat_expert[order]
    s_token = flat_token[order]
    s_gate = flat_gate[order]

    counts = jax.ops.segment_sum(jnp.ones((A,), jnp.int32), flat_expert, num_segments=N_EXPERTS)
    group_start = jnp.cumsum(counts) - counts
    padded = ((counts + EXPERT_BLOCK - 1) // EXPERT_BLOCK) * EXPERT_BLOCK
    padded_end = jnp.cumsum(padded)
    padded_start = padded_end - padded
    rank = jnp.arange(A, dtype=jnp.int32) - group_start[s_expert]
    dest = padded_start[s_expert] + rank

    n_blocks = -(-A // EXPERT_BLOCK) + N_EXPERTS
    P = n_blocks * EXPERT_BLOCK
    tok_buf = jnp.full((P,), T, jnp.int32).at[dest].set(s_token)
    gate_buf = jnp.zeros((P,), jnp.float32).at[dest].set(s_gate)
    block_start = jnp.arange(n_blocks, dtype=jnp.int32) * EXPERT_BLOCK
    block_expert = jnp.minimum(jnp.searchsorted(padded_end, block_start, side="right"),
                               N_EXPERTS - 1).astype(jnp.int32)

    x_pad = jnp.concatenate([xt, jnp.zeros((1, D), xt.dtype)], axis=0)
    x_buf = x_pad[tok_buf].reshape(n_blocks, EXPERT_BLOCK, D)

    def expert_block(args):
        xb, e = args
        gate = xb @ w_gate[e] + b_gate[e]
        up = xb @ w_up[e] + b_up[e]
        gate = jnp.minimum(gate, SWIGLU_LIMIT)
        up = jnp.clip(up, -SWIGLU_LIMIT, SWIGLU_LIMIT)
        glu = gate * jax.nn.sigmoid(SWIGLU_ALPHA * gate)
        return (glu * (up + 1.0)) @ w_down[e] + b_down[e]

    y_buf = lax.map(expert_block, (x_buf, block_expert)).reshape(P, D)
    y_buf = y_buf * gate_buf[:, None].astype(y_buf.dtype)
    out = jax.ops.segment_sum(y_buf, tok_buf, num_segments=T + 1)[:T]
    return out.reshape(B, S, D).astype(h.dtype)


def setup_inputs(seed: int = 0) -> dict:
    key = jax.random.key(seed)
    ks = jax.random.split(key, 20)
    f32 = jnp.float32
    L_, D, E, F, H = DEPTH, D_MODEL, N_EXPERTS, D_FF, MLSTM_HEADS
    nrm = lambda k, shape, s: jax.random.normal(k, shape, f32) * s
    x = jax.random.normal(ks[0], (BATCH, SEQ, D), f32)
    norm1_g = 1.0 + nrm(ks[1], (L_, D), 0.02)
    w_in = nrm(ks[2], (L_, D, N_IN), D ** -0.5)
    ig_b = nrm(ks[3], (L_, H), 0.1)
    fg_b = jnp.broadcast_to(jnp.linspace(3.0, 6.0, H, dtype=f32), (L_, H)) + nrm(ks[4], (L_, H), 0.1)
    conv_w = nrm(ks[5], (L_, CONV_WIDTH, 2 * MLSTM_WIDTH), CONV_WIDTH ** -0.5)
    head_norm_g = 1.0 + nrm(ks[6], (L_, MLSTM_WIDTH), 0.02)
    pool_w = nrm(ks[7], (L_, POOL_GROUPS, POOL_GROUP_DIM, POOL_GROUP_DIM), POOL_GROUP_DIM ** -0.5)
    pool_scale = 1.0 + nrm(ks[8], (L_, POOL_WIDTH), 0.02)
    w_out = nrm(ks[9], (L_, D_MIX, D), D_MIX ** -0.5)
    norm2_g = 1.0 + nrm(ks[10], (L_, D), 0.02)
    w_router = nrm(ks[11], (L_, D, E), D ** -0.5)
    b_router = nrm(ks[12], (L_, E), 0.01)
    w_gate = nrm(ks[13], (L_, E, D, F), D ** -0.5)
    b_gate = nrm(ks[14], (L_, E, F), 0.01)
    w_up = nrm(ks[15], (L_, E, D, F), D ** -0.5)
    b_up = nrm(ks[16], (L_, E, F), 0.01)
    w_down = nrm(ks[17], (L_, E, F, D), F ** -0.5)
    b_down = nrm(ks[18], (L_, E, D), 0.01)
    normf_g = 1.0 + nrm(ks[19], (D,), 0.02)
    return {"x": x, "norm1_g": norm1_g, "w_in": w_in, "ig_b": ig_b, "fg_b": fg_b,
            "conv_w": conv_w, "head_norm_g": head_norm_g, "pool_w": pool_w,
            "pool_scale": pool_scale, "w_out": w_out, "norm2_g": norm2_g,
            "w_router": w_router, "b_router": b_router, "w_gate": w_gate,
            "b_gate": b_gate, "w_up": w_up, "b_up": b_up, "w_down": w_down,
            "b_down": b_down, "normf_g": normf_g}


def reference(x, norm1_g, w_in, ig_b, fg_b, conv_w, head_norm_g, pool_w, pool_scale,
              w_out, norm2_g, w_router, b_router, w_gate, b_gate, w_up, b_up,
              w_down, b_down, normf_g):
    for l in range(DEPTH):
        h = rmsnorm(x, norm1_g[l])
        x = x + hybrid_mixer(h, w_in[l], ig_b[l], fg_b[l], conv_w[l], head_norm_g[l],
                             pool_w[l], pool_scale[l], w_out[l])
        h = rmsnorm(x, norm2_g[l])
        x = x + moe_ffn(h, w_router[l], b_router[l], w_gate[l], b_gate[l], w_up[l],
                        b_up[l], w_down[l], b_down[l])
    return rmsnorm(x, normf_g)
```

```cpp
#include <hip/hip_runtime.h>
#include <cstdio>
#include <cstdint>

constexpr int T = 16384, D = 1024, SEQ = 4096;
constexpr int H = 4, DH = 128, LCH = 64, NCH = 64;
constexpr int NIN = 2568;
constexpr int NE = 32, FF = 1024;
constexpr float EPS = 1e-5f;
constexpr int COL_V = 1024, COL_O = 1536, COL_G = 2048, COL_U = 2056;

__device__ __forceinline__ float wave_sum(float v) {
#pragma unroll
    for (int o = 1; o < 64; o <<= 1) v += __shfl_xor(v, o);
    return v;
}
__device__ __forceinline__ float logsigmoidf_(float x) { return fminf(x, 0.f) - log1pf(expf(-fabsf(x))); }
__device__ __forceinline__ float sigmoidf_(float x) { return 1.f / (1.f + expf(-x)); }

__global__ void __launch_bounds__(256) k_rs(const float* __restrict__ x, float* __restrict__ rs) {
    const int wave = threadIdx.x >> 6, lane = threadIdx.x & 63, t = blockIdx.x * 4 + wave;
    const float4* xr = (const float4*)(x + (size_t)t * D);
    float ss = 0.f;
#pragma unroll
    for (int j = 0; j < 4; ++j) { const float4 v = xr[j * 64 + lane]; ss += v.x * v.x + v.y * v.y + v.z * v.z + v.w * v.w; }
    ss = wave_sum(ss);
    if (lane == 0) rs[t] = rsqrtf(ss * (1.f / D) + EPS);
}

struct ALNorm {
    const float* x; const float* rs; const float* g;
    __device__ int nrows(int) const { return T; }
    __device__ float4 load4(int, int row, int k) const {
        float4 v = *(const float4*)(x + (size_t)row * D + k); const float4 gg = *(const float4*)(g + k); const float r = rs[row];
        v.x *= r * gg.x; v.y *= r * gg.y; v.z *= r * gg.z; v.w *= r * gg.w; return v; }
};
struct ALPlain {
    const float* a;
    __device__ int nrows(int) const { return T; }
    __device__ float4 load4(int, int row, int k) const { return *(const float4*)(a + (size_t)row * D + k); }
};
struct ALGather {
    const float* h2; const int* list; const int* cnt;
    __device__ int nrows(int z) const { return cnt[z]; }
    __device__ float4 load4(int z, int row, int k) const {
        if (row >= cnt[z]) return make_float4(0.f, 0.f, 0.f, 0.f);
        const int a = list[z * T + row]; return *(const float4*)(h2 + (size_t)(a >> 2) * D + k); }
};
struct ALAct {
    const float* act; const int* rowbase; const int* cnt;
    __device__ int nrows(int z) const { return cnt[z]; }
    __device__ float4 load4(int z, int row, int k) const {
        if (row >= cnt[z]) return make_float4(0.f, 0.f, 0.f, 0.f);
        return *(const float4*)(act + (size_t)(rowbase[z] + row) * FF + k); }
};
struct EpStore { float* C; int ldc; int pad; __device__ void operator()(int, int row, int col, float a0, float) const { C[(size_t)row * ldc + col] = a0; } };
struct EpResid { const float* x; float* x1; __device__ void operator()(int, int row, int col, float a0, float) const { x1[(size_t)row * D + col] = x[(size_t)row * D + col] + a0; } };
struct EpGlu {
    const float* bg; const float* bu; float* act; const int* rowbase;
    __device__ void operator()(int z, int row, int col, float a0, float a1) const {
        float gate = a0 + bg[z * FF + col], up = a1 + bu[z * FF + col];
        gate = fminf(gate, 7.0f); up = fminf(fmaxf(up, -7.0f), 7.0f);
        const float glu = gate * sigmoidf_(1.702f * gate);
        act[(size_t)(rowbase[z] + row) * FF + col] = glu * (up + 1.0f); }
};
struct EpDown {
    const float* bd; const int* list; const float* gate_of; float* x2;
    __device__ void operator()(int z, int row, int col, float a0, float) const {
        const int a = list[z * T + row]; const float y = (a0 + bd[z * D + col]) * gate_of[a];
        atomicAdd(x2 + (size_t)(a >> 2) * D + col, y); }
};

template <int NBM, class AL, class EP>
__global__ void __launch_bounds__(256) k_gemm(AL al, const float* __restrict__ B0, const float* __restrict__ B1, size_t bstride_z, int ldb, int N, int K, int pad_, EP ep) {
    __shared__ float As[16][65];
    __shared__ float Bs0[16][64];
    __shared__ float Bs1[16][64];
    const int z = blockIdx.z, m0 = blockIdx.y * 64, n0 = blockIdx.x * 64;
    const int nrows = al.nrows(z);
    if (m0 >= nrows) return;
    const float* b0 = B0 + (size_t)z * bstride_z;
    const float* b1 = (NBM == 2) ? B1 + (size_t)z * bstride_z : nullptr;
    const int tx = threadIdx.x & 15, ty = threadIdx.x >> 4;
    float acc0[4][4], acc1[4][4];
#pragma unroll
    for (int i = 0; i < 4; ++i)
#pragma unroll
        for (int j = 0; j < 4; ++j) { acc0[i][j] = 0.f; acc1[i][j] = 0.f; }
    for (int k0 = 0; k0 < K; k0 += 16) {
        { const int r = threadIdx.x >> 2, kq = (threadIdx.x & 3) * 4;
          const float4 v = al.load4(z, m0 + r, k0 + kq);
          As[kq + 0][r] = v.x; As[kq + 1][r] = v.y; As[kq + 2][r] = v.z; As[kq + 3][r] = v.w; }
        { const int kk = threadIdx.x >> 4, nn = (threadIdx.x & 15) * 4;
#pragma unroll
          for (int j = 0; j < 4; ++j) { const int col = n0 + nn + j;
              Bs0[kk][nn + j] = col < N ? b0[(size_t)(k0 + kk) * ldb + col] : 0.f;
              if (NBM == 2) Bs1[kk][nn + j] = col < N ? b1[(size_t)(k0 + kk) * ldb + col] : 0.f; } }
        __syncthreads();
#pragma unroll
        for (int kk = 0; kk < 16; ++kk) {
            float a[4], b[4], c[4];
#pragma unroll
            for (int i = 0; i < 4; ++i) a[i] = As[kk][ty * 4 + i];
#pragma unroll
            for (int j = 0; j < 4; ++j) { b[j] = Bs0[kk][tx * 4 + j]; c[j] = (NBM == 2) ? Bs1[kk][tx * 4 + j] : 0.f; }
#pragma unroll
            for (int i = 0; i < 4; ++i)
#pragma unroll
                for (int j = 0; j < 4; ++j) { acc0[i][j] += a[i] * b[j]; if (NBM == 2) acc1[i][j] += a[i] * c[j]; }
        }
        __syncthreads();
    }
#pragma unroll
    for (int i = 0; i < 4; ++i)
#pragma unroll
        for (int j = 0; j < 4; ++j) { const int row = m0 + ty * 4 + i, col = n0 + tx * 4 + j; if (row < nrows && col < N) ep(z, row, col, acc0[i][j], acc1[i][j]); }
}

__device__ __forceinline__ float conv_silu(const float* __restrict__ P, const float* __restrict__ conv_w, int tok, int s, int ch) {
    float acc = 0.f;
#pragma unroll
    for (int j = 0; j < 4; ++j) { const int sp = s - 3 + j; if (sp >= 0) acc += P[(size_t)(tok - 3 + j) * NIN + ch] * conv_w[j * 1024 + ch]; }
    return acc * sigmoidf_(acc);
}
__device__ __forceinline__ void chunk_gates(const float* __restrict__ P, const float* __restrict__ ig_b, const float* __restrict__ fg_b, int tok0, int h, float* s_ig, float* s_b) {
    const int l = threadIdx.x;
    if (l < 64) { const float* pr = P + (size_t)(tok0 + l) * NIN + COL_G; s_ig[l] = pr[h] + ig_b[h]; s_b[l] = logsigmoidf_(pr[4 + h] + fg_b[h]); }
    __syncthreads();
    if (l == 0) { float c = 0.f; for (int i = 0; i < 64; ++i) { c += s_b[i]; s_b[i] = c; } }
    __syncthreads();
}

__global__ void __launch_bounds__(256) k_mlstm_local(const float* __restrict__ P, const float* __restrict__ ig_b, const float* __restrict__ fg_b, const float* __restrict__ conv_w,
                                                     float* __restrict__ Cst, float* __restrict__ nst, float* __restrict__ mloc, float* __restrict__ btot) {
    __shared__ float wk[64 * 128];
    __shared__ float s_ig[64], s_b[64], s_w[64];
    const int u = blockIdx.x, c = u & 63, h = (u >> 6) & 3, b = u >> 8, tid = threadIdx.x;
    const int tok0 = b * SEQ + c * 64;
    chunk_gates(P, ig_b, fg_b, tok0, h, s_ig, s_b);
    if (tid == 0) {
        const float bt = s_b[63]; float m = -INFINITY;
        for (int l = 0; l < 64; ++l) m = fmaxf(m, bt - s_b[l] + s_ig[l]);
        for (int l = 0; l < 64; ++l) s_w[l] = expf(bt - s_b[l] + s_ig[l] - m);
        mloc[u] = m; btot[u] = bt;
    }
    __syncthreads();
    for (int idx = tid; idx < 64 * 128; idx += 256) { const int l = idx >> 7, d = idx & 127;
        const float kc = conv_silu(P, conv_w, tok0 + l, c * 64 + l, 512 + h * 128 + d) * 0.08838834764831845f;
        wk[idx] = s_w[l] * kc; }
    __syncthreads();
    const int ty = tid >> 4, tx = tid & 15;
    float acc[8][8];
#pragma unroll
    for (int i = 0; i < 8; ++i)
#pragma unroll
        for (int j = 0; j < 8; ++j) acc[i][j] = 0.f;
    for (int l = 0; l < 64; ++l) {
        float a[8], vv[8];
        const float* vp = P + (size_t)(tok0 + l) * NIN + COL_V + h * 128 + tx * 8;
#pragma unroll
        for (int i = 0; i < 8; ++i) { a[i] = wk[l * 128 + ty * 8 + i]; vv[i] = vp[i]; }
#pragma unroll
        for (int i = 0; i < 8; ++i)
#pragma unroll
            for (int j = 0; j < 8; ++j) acc[i][j] += a[i] * vv[j];
    }
#pragma unroll
    for (int i = 0; i < 8; ++i)
#pragma unroll
        for (int j = 0; j < 8; ++j) Cst[((size_t)u * 128 + ty * 8 + i) * 128 + tx * 8 + j] = acc[i][j];
    if (tid < 128) { float s = 0.f; for (int l = 0; l < 64; ++l) s += wk[l * 128 + tid]; nst[(size_t)u * 128 + tid] = s; }
}

__global__ void __launch_bounds__(256) k_scan(float* __restrict__ Cst, float* __restrict__ nst, const float* __restrict__ mloc, const float* __restrict__ btot, float* __restrict__ m_in) {
    const int bh = blockIdx.y, idx = blockIdx.x * 256 + threadIdx.x;
    if (idx >= 16384 + 128) return;
    float C = 0.f, m = 0.f;
    for (int c = 0; c < 64; ++c) {
        const int u = bh * 64 + c;
        float* p = idx < 16384 ? Cst + (size_t)u * 16384 + idx : nst + (size_t)u * 128 + (idx - 16384);
        const float Cl = *p; *p = C;
        const float ml = mloc[u], bt = btot[u];
        if (idx == 0) m_in[u] = m;
        const float mn = fmaxf(bt + m, ml), so = expf(bt + m - mn), sl = expf(ml - mn);
        C = so * C + sl * Cl; m = mn;
    }
}

constexpr int QS = 129;
__global__ void __launch_bounds__(256) k_mlstm_out(const float* __restrict__ P, const float* __restrict__ ig_b, const float* __restrict__ fg_b, const float* __restrict__ conv_w,
                                                   const float* __restrict__ head_norm_g, const float* __restrict__ Cin, const float* __restrict__ nin, const float* __restrict__ m_in,
                                                   float* __restrict__ ycat) {
    extern __shared__ float sm[];
    float* qc = sm;
    float* kc = qc + 64 * QS;
    float* S = kc + 64 * QS;
    float* s_ig = S + 64 * 65; float* s_b = s_ig + 64; float* s_mo = s_b + 64; float* s_den = s_mo + 64; float* s_int = s_den + 64;
    const int u = blockIdx.x, c = u & 63, h = (u >> 6) & 3, b = u >> 8, tid = threadIdx.x;
    const int tok0 = b * SEQ + c * 64;
    chunk_gates(P, ig_b, fg_b, tok0, h, s_ig, s_b);
    const float mi = m_in[u];
    for (int idx = tid; idx < 64 * 128; idx += 256) { const int l = idx >> 7, d = idx & 127;
        qc[l * QS + d] = conv_silu(P, conv_w, tok0 + l, c * 64 + l, h * 128 + d);
        kc[l * QS + d] = conv_silu(P, conv_w, tok0 + l, c * 64 + l, 512 + h * 128 + d) * 0.08838834764831845f; }
    if (tid < 64) { const int l = tid; const float a = s_b[l] + mi; float mx = a;
        for (int r = 0; r <= l; ++r) mx = fmaxf(mx, s_b[l] - s_b[r] + s_ig[r]);
        s_mo[l] = mx; s_int[l] = expf(a - mx); }
    __syncthreads();
    for (int idx = tid; idx < 64 * 64; idx += 256) { const int l = idx >> 6, r = idx & 63; float v = 0.f;
        if (r <= l) { float dot = 0.f; for (int d = 0; d < 128; ++d) dot += qc[l * QS + d] * kc[r * QS + d];
            v = dot * expf(s_b[l] - s_b[r] + s_ig[r] - s_mo[l]); }
        S[l * 65 + r] = v; }
    __syncthreads();
    if (tid < 64) { const int l = tid; float ds = 0.f; for (int r = 0; r < 64; ++r) ds += S[l * 65 + r];
        float qn = 0.f; for (int d = 0; d < 128; ++d) qn += qc[l * QS + d] * nin[(size_t)u * 128 + d];
        s_den[l] = ds + s_int[l] * qn; }
    const int dv = tid & 127, lg = tid >> 7;
    float a1[32], a2[32];
#pragma unroll
    for (int i = 0; i < 32; ++i) { a1[i] = 0.f; a2[i] = 0.f; }
    for (int r = 0; r < 64; ++r) { const float vv = P[(size_t)(tok0 + r) * NIN + COL_V + h * 128 + dv];
#pragma unroll
        for (int i = 0; i < 32; ++i) a1[i] += S[(lg * 32 + i) * 65 + r] * vv; }
    for (int dk = 0; dk < 128; ++dk) { const float cv = Cin[((size_t)u * 128 + dk) * 128 + dv];
#pragma unroll
        for (int i = 0; i < 32; ++i) a2[i] += qc[(lg * 32 + i) * QS + dk] * cv; }
    __syncthreads();
#pragma unroll
    for (int i = 0; i < 32; ++i) { const int l = lg * 32 + i; const float num = a1[i] + s_int[l] * a2[i];
        kc[l * QS + dv] = num / fmaxf(fabsf(s_den[l]), expf(-s_mo[l])); }
    __syncthreads();
    const int wave = tid >> 6, lane = tid & 63;
    for (int i = 0; i < 16; ++i) { const int l = wave * 16 + i; const float h0 = kc[l * QS + lane], h1 = kc[l * QS + lane + 64];
        const float mu = wave_sum(h0 + h1) * (1.f / 128.f); const float d0 = h0 - mu, d1 = h1 - mu;
        const float var = wave_sum(d0 * d0 + d1 * d1) * (1.f / 128.f); const float rstd = rsqrtf(var + EPS);
        const size_t tok = (size_t)(tok0 + l);
        const float o0 = P[tok * NIN + COL_O + h * 128 + lane], o1 = P[tok * NIN + COL_O + h * 128 + lane + 64];
        ycat[tok * D + h * 128 + lane] = sigmoidf_(o0) * d0 * rstd * head_norm_g[h * 128 + lane];
        ycat[tok * D + h * 128 + lane + 64] = sigmoidf_(o1) * d1 * rstd * head_norm_g[h * 128 + lane + 64]; }
}

__global__ void __launch_bounds__(256) k_pool(const float* __restrict__ P, const float* __restrict__ pool_w, const float* __restrict__ pool_scale, float* __restrict__ ycat) {
    __shared__ float pl[64 * 129];
    const int tok0 = blockIdx.x * 64, gi = blockIdx.y, w = 2 << gi, tid = threadIdx.x;
    for (int idx = tid; idx < 64 * 128; idx += 256) { const int l = idx >> 7, cc = idx & 127; const int tok = tok0 + l, s = tok & (SEQ - 1);
        const int cnt = (s + 1 < w) ? s + 1 : w; float sum = 0.f;
        for (int j = 0; j < cnt; ++j) sum += P[(size_t)(tok - j) * NIN + COL_U + gi * 128 + cc];
        pl[l * 129 + cc] = sum / (float)cnt - P[(size_t)tok * NIN + COL_U + gi * 128 + cc]; }
    __syncthreads();
    const int d = tid & 127, lg = tid >> 7;
    float acc[32];
#pragma unroll
    for (int i = 0; i < 32; ++i) acc[i] = 0.f;
    for (int cc = 0; cc < 128; ++cc) { const float wv = pool_w[((size_t)gi * 128 + cc) * 128 + d];
#pragma unroll
        for (int i = 0; i < 32; ++i) acc[i] += pl[(lg * 32 + i) * 129 + cc] * wv; }
    const float sc = pool_scale[gi * 128 + d];
#pragma unroll
    for (int i = 0; i < 32; ++i) ycat[(size_t)(tok0 + lg * 32 + i) * D + 512 + gi * 128 + d] = acc[i] * sc;
}

__global__ void __launch_bounds__(256) k_route(const float* __restrict__ x1, const float* __restrict__ g2, const float* __restrict__ w_router, const float* __restrict__ b_router,
                                               float* __restrict__ h2, int* __restrict__ cnt, int* __restrict__ list, float* __restrict__ gate_of) {
    const int wave = threadIdx.x >> 6, lane = threadIdx.x & 63, t = blockIdx.x * 4 + wave;
    const float4* xr = (const float4*)(x1 + (size_t)t * D);
    float4 v[4]; float ss = 0.f;
#pragma unroll
    for (int j = 0; j < 4; ++j) { v[j] = xr[j * 64 + lane]; ss += v[j].x * v[j].x + v[j].y * v[j].y + v[j].z * v[j].z + v[j].w * v[j].w; }
    const float rs = rsqrtf(wave_sum(ss) * (1.f / D) + EPS);
    float lg[32];
#pragma unroll
    for (int e = 0; e < 32; ++e) lg[e] = 0.f;
#pragma unroll
    for (int j = 0; j < 4; ++j) { const int k = j * 256 + lane * 4; const float4 gg = *(const float4*)(g2 + k);
        float4 hv; hv.x = v[j].x * rs * gg.x; hv.y = v[j].y * rs * gg.y; hv.z = v[j].z * rs * gg.z; hv.w = v[j].w * rs * gg.w;
        *(float4*)(h2 + (size_t)t * D + k) = hv;
        const float hh[4] = {hv.x, hv.y, hv.z, hv.w};
#pragma unroll
        for (int q = 0; q < 4; ++q) { const float4* wr = (const float4*)(w_router + (size_t)(k + q) * NE);
#pragma unroll
            for (int e4 = 0; e4 < 8; ++e4) { const float4 wv = wr[e4];
                lg[e4 * 4 + 0] += hh[q] * wv.x; lg[e4 * 4 + 1] += hh[q] * wv.y; lg[e4 * 4 + 2] += hh[q] * wv.z; lg[e4 * 4 + 3] += hh[q] * wv.w; } } }
#pragma unroll
    for (int e = 0; e < 32; ++e) lg[e] = wave_sum(lg[e]) + b_router[e];
    int bi[4]; float bv[4];
#pragma unroll
    for (int k = 0; k < 4; ++k) { float best = -INFINITY; int b = 0;
#pragma unroll
        for (int e = 0; e < 32; ++e) if (lg[e] > best) { best = lg[e]; b = e; }
#pragma unroll
        for (int e = 0; e < 32; ++e) if (e == b) lg[e] = -INFINITY;
        bi[k] = b; bv[k] = best; }
    float ex[4], se = 0.f;
#pragma unroll
    for (int k = 0; k < 4; ++k) { ex[k] = expf(bv[k] - bv[0]); se += ex[k]; }
    if (lane == 0) {
#pragma unroll
        for (int k = 0; k < 4; ++k) { const int pos = atomicAdd(cnt + bi[k], 1); list[bi[k] * T + pos] = t * 4 + k; gate_of[t * 4 + k] = ex[k] / se; } }
}
__global__ void k_prefix(const int* __restrict__ cnt, int* __restrict__ rowbase) {
    if (threadIdx.x == 0) { int s = 0; for (int e = 0; e < NE; ++e) { rowbase[e] = s; s += cnt[e]; } }
}

__global__ void __launch_bounds__(256) k_final(const float* __restrict__ x2, const float* __restrict__ gf, float* __restrict__ out) {
    const int wave = threadIdx.x >> 6, lane = threadIdx.x & 63, t = blockIdx.x * 4 + wave;
    const float4* xr = (const float4*)(x2 + (size_t)t * D);
    float4 v[4]; float ss = 0.f;
#pragma unroll
    for (int j = 0; j < 4; ++j) { v[j] = xr[j * 64 + lane]; ss += v[j].x * v[j].x + v[j].y * v[j].y + v[j].z * v[j].z + v[j].w * v[j].w; }
    const float rs = rsqrtf(wave_sum(ss) * (1.f / D) + EPS);
#pragma unroll
    for (int j = 0; j < 4; ++j) { const int k = j * 256 + lane * 4; const float4 gg = *(const float4*)(gf + k);
        float4 o; o.x = v[j].x * rs * gg.x; o.y = v[j].y * rs * gg.y; o.z = v[j].z * rs * gg.z; o.w = v[j].w * rs * gg.w;
        *(float4*)(out + (size_t)t * D + k) = o; }
}

constexpr size_t MiB = 1u << 20;
constexpr size_t OFF_P = 0;
constexpr size_t OFF_ACT = 0;
constexpr size_t OFF_C = (size_t)T * NIN * 4;
constexpr size_t OFF_N = OFF_C + 64 * MiB;
constexpr size_t OFF_YCAT = OFF_N + 512 * 1024;
constexpr size_t OFF_X1 = 304 * MiB;
constexpr size_t OFF_H2 = 368 * MiB;
constexpr size_t OFF_SM = 432 * MiB;
constexpr size_t OFF_RS1 = OFF_SM, OFF_MLOC = OFF_SM + 65536, OFF_BTOT = OFF_MLOC + 4096, OFF_MIN = OFF_BTOT + 4096, OFF_CNT = OFF_MIN + 4096, OFF_RB = OFF_CNT + 256,
                 OFF_GATE = OFF_SM + 128 * 1024, OFF_LIST = OFF_SM + 512 * 1024, WS_END = OFF_LIST + (size_t)NE * T * 4;
static_assert(OFF_YCAT + (size_t)T * D * 4 <= OFF_X1 && WS_END <= 440 * MiB, "ws map");

extern "C" void kernel_launch(void* const* d_in, const int* in_sizes, int n_in, void* d_out, int out_size, void* d_ws, size_t ws_size, hipStream_t stream) {
    if (n_in != 20 || ws_size < WS_END) { fprintf(stderr, "kernel_launch: unexpected n_in %d / ws %zu\n", n_in, ws_size); return; }
    const float* x = (const float*)d_in[0]; const float* norm1_g = (const float*)d_in[1]; const float* w_in = (const float*)d_in[2];
    const float* ig_b = (const float*)d_in[3]; const float* fg_b = (const float*)d_in[4]; const float* conv_w = (const float*)d_in[5];
    const float* head_norm_g = (const float*)d_in[6]; const float* pool_w = (const float*)d_in[7]; const float* pool_scale = (const float*)d_in[8];
    const float* w_out = (const float*)d_in[9]; const float* norm2_g = (const float*)d_in[10]; const float* w_router = (const float*)d_in[11];
    const float* b_router = (const float*)d_in[12]; const float* w_gate = (const float*)d_in[13]; const float* b_gate = (const float*)d_in[14];
    const float* w_up = (const float*)d_in[15]; const float* b_up = (const float*)d_in[16]; const float* w_down = (const float*)d_in[17];
    const float* b_down = (const float*)d_in[18]; const float* normf_g = (const float*)d_in[19];
    char* ws = (char*)d_ws;
    float* P = (float*)(ws + OFF_P); float* act = (float*)(ws + OFF_ACT); float* Cst = (float*)(ws + OFF_C); float* nst = (float*)(ws + OFF_N);
    float* ycat = (float*)(ws + OFF_YCAT); float* x1 = (float*)(ws + OFF_X1); float* h2 = (float*)(ws + OFF_H2);
    float* rs1 = (float*)(ws + OFF_RS1); float* mloc = (float*)(ws + OFF_MLOC); float* btot = (float*)(ws + OFF_BTOT); float* m_in = (float*)(ws + OFF_MIN);
    int* cnt = (int*)(ws + OFF_CNT); int* rowbase = (int*)(ws + OFF_RB); float* gate_of = (float*)(ws + OFF_GATE); int* list = (int*)(ws + OFF_LIST);
    float* out = (float*)d_out;

    static bool attr = false;
    constexpr int OUT_LDS = (64 * QS * 2 + 64 * 65 + 64 * 5) * 4;
    if (!attr) { (void)hipFuncSetAttribute((const void*)k_mlstm_out, hipFuncAttributeMaxDynamicSharedMemorySize, OUT_LDS); attr = true; }

    (void)hipMemsetAsync(cnt, 0, 256, stream);
    k_rs<<<T / 4, 256, 0, stream>>>(x, rs1);
    k_gemm<1, ALNorm, EpStore><<<dim3((NIN + 63) / 64, T / 64, 1), 256, 0, stream>>>(ALNorm{x, rs1, norm1_g}, w_in, nullptr, 0, NIN, NIN, D, 0, EpStore{P, NIN, 0});
    k_mlstm_local<<<1024, 256, 0, stream>>>(P, ig_b, fg_b, conv_w, Cst, nst, mloc, btot);
    k_pool<<<dim3(T / 64, 4), 256, 0, stream>>>(P, pool_w, pool_scale, ycat);
    k_scan<<<dim3(65, 16), 256, 0, stream>>>(Cst, nst, mloc, btot, m_in);
    k_mlstm_out<<<1024, 256, OUT_LDS, stream>>>(P, ig_b, fg_b, conv_w, head_norm_g, Cst, nst, m_in, ycat);
    k_gemm<1, ALPlain, EpResid><<<dim3(D / 64, T / 64, 1), 256, 0, stream>>>(ALPlain{ycat}, w_out, nullptr, 0, D, D, D, 0, EpResid{x, x1});
    k_route<<<T / 4, 256, 0, stream>>>(x1, norm2_g, w_router, b_router, h2, cnt, list, gate_of);
    k_prefix<<<1, 64, 0, stream>>>(cnt, rowbase);
    k_gemm<2, ALGather, EpGlu><<<dim3(FF / 64, T / 64, NE), 256, 0, stream>>>(ALGather{h2, list, cnt}, w_gate, w_up, (size_t)D * FF, FF, FF, D, 0, EpGlu{b_gate, b_up, act, rowbase});
    k_gemm<1, ALAct, EpDown><<<dim3(D / 64, T / 64, NE), 256, 0, stream>>>(ALAct{act, rowbase, cnt}, w_down, nullptr, (size_t)FF * D, D, D, FF, 0, EpDown{b_down, list, gate_of, x1});
    k_final<<<T / 4, 256, 0, stream>>>(x1, normf_g, out);
}
```

```cpp
#include <hip/hip_runtime.h>
#include <cstdio>
#include <cstdint>

#ifndef MK_N_LAUNCHES
#define MK_N_LAUNCHES 10
#endif
constexpr int N_PHASES = 10;

constexpr int T = 16384, D = 1024, SEQ = 4096;
constexpr int NIN = 2568;
constexpr int NP = 2560;
constexpr int NE = 32, FF = 1024;
constexpr float EPS = 1e-5f;
constexpr int PC_V = 1024, PC_O = 1536, PC_U = 2048;

#define GAS __attribute__((address_space(1)))
#define LAS __attribute__((address_space(3)))
typedef unsigned short bf16_t;
typedef short bf16x8 __attribute__((ext_vector_type(8)));
typedef float f32x4 __attribute__((ext_vector_type(4)));
typedef unsigned u32x4 __attribute__((ext_vector_type(4)));
typedef unsigned u32x2 __attribute__((ext_vector_type(2)));

__device__ __forceinline__ unsigned cvt_pk_bf16(float lo, float hi) { unsigned r; asm volatile("v_cvt_pk_bf16_f32 %0, %1, %2" : "=v"(r) : "v"(lo), "v"(hi)); return r; }
__device__ __forceinline__ float bf2f(unsigned short b) { return __uint_as_float(((unsigned)b) << 16); }
__device__ __forceinline__ float bflo(unsigned w) { return __uint_as_float(w << 16); }
__device__ __forceinline__ float bfhi(unsigned w) { return __uint_as_float(w & 0xffff0000u); }
__device__ __forceinline__ float wave_sum(float v) {
#pragma unroll
    for (int o = 1; o < 64; o <<= 1) v += __shfl_xor(v, o);
    return v;
}
__device__ __forceinline__ float logsigmoidf_(float x) { return fminf(x, 0.f) - log1pf(expf(-fabsf(x))); }
__device__ __forceinline__ float sigmoidf_(float x) { return 1.f / (1.f + expf(-x)); }
__device__ __forceinline__ float fast_sigmoid(float x) { return __builtin_amdgcn_rcpf(1.0f + __builtin_amdgcn_exp2f(-1.44269504f * x)); }

constexpr size_t MiB = 1u << 20;
constexpr size_t WS_CTL = 0, CTL_ZERO_BYTES = 1 * MiB;
constexpr size_t WS_WIN = 1 * MiB;
constexpr size_t WS_WOUT = 6 * MiB;
constexpr size_t WS_WGU = 8 * MiB;
constexpr size_t WS_YBUF = 8 * MiB;
constexpr size_t WS_WD = 136 * MiB;
constexpr size_t WS_X1 = 200 * MiB;
constexpr size_t WS_CST = 200 * MiB;
constexpr size_t WS_ACT = 264 * MiB;
constexpr size_t WS_P = 264 * MiB;
constexpr size_t WS_XB = 344 * MiB;
constexpr size_t WS_YCAT = 376 * MiB;
constexpr size_t WS_H2 = 408 * MiB;
constexpr size_t WS_SM = 440 * MiB;
constexpr size_t WS_RS1 = WS_SM, WS_GATES = WS_SM + 64 * 1024, WS_NST = WS_GATES + 512 * 1024, WS_MLOC = WS_NST + 512 * 1024, WS_BTOT = WS_MLOC + 4096, WS_MIN = WS_BTOT + 4096,
                 WS_GATEOF = WS_SM + 2 * MiB, WS_LIST = WS_SM + 3 * MiB, WS_END = WS_LIST + (size_t)NE * T * 4;
static_assert(WS_END <= 446 * MiB, "ws map");
constexpr int CW_CNT = 64;
constexpr int CW_BAR = 4096;

constexpr int RING_BYTES = 131072;
constexpr int LDS_BARW = RING_BYTES;
constexpr int LDS_CNT = RING_BYTES + 64;
constexpr int LDS_TP = LDS_CNT + 128;
constexpr int LDS_TE = LDS_TP + 192;
constexpr int LDS_TOK = LDS_TE + 1280;
constexpr int LDS_BYTES = 147456;
static_assert(LDS_TOK + 10 * 1024 <= LDS_BYTES, "LDS map");

#define XB_TMO      128
#define XB_XCNT(j)  (256  + 64 * (j))
#define XB_XSUB(j)  (1280 + 64 * (j))
#define XB_XGEN(j)  (2304 + 64 * (j))
#define XB_TOP      3328
#define XB_TOPGEN   3392
#define XCD_BAR_WORDS 3456
#define XB_SPIN_CAP (1u << 18)
__device__ __forceinline__ unsigned xb_ld(unsigned* p)              { return __hip_atomic_load(p, __ATOMIC_RELAXED, __HIP_MEMORY_SCOPE_AGENT); }
__device__ __forceinline__ unsigned xb_add(unsigned* p, unsigned v) { return __hip_atomic_fetch_add(p, v, __ATOMIC_RELAXED, __HIP_MEMORY_SCOPE_AGENT); }
__device__ __forceinline__ unsigned xb_xcc_id() { return (unsigned)__builtin_amdgcn_s_getreg((3 << 11) | 20) & 0xFu; }
#define XB_SPIN(cond, bar) do { unsigned _sp = 0; while (cond) { __builtin_amdgcn_s_sleep(1); \
    if ((++_sp & 255u) == 0u) { if (xb_ld(&(bar)[XB_TMO])) break; if (_sp > XB_SPIN_CAP) { atomicAdd(&(bar)[XB_TMO], 1u); break; } } } } while (0)
struct XcdBarrier { unsigned* bar; unsigned x; volatile LAS unsigned* st; };
__device__ __forceinline__ XcdBarrier xcd_barrier_post(unsigned* bar, volatile LAS unsigned* st) {
    XcdBarrier b; b.bar = bar; b.x = xb_xcc_id(); b.st = st;
    if (threadIdx.x == 0) (void)xb_add(&bar[XB_XCNT(b.x)], 1u);
    return b;
}
__device__ __forceinline__ void xcd_barrier_complete(unsigned* bar, unsigned x, unsigned& nloc, unsigned& nx) {
    const unsigned G = gridDim.x * gridDim.y * gridDim.z;
    unsigned sum, cnt, mine, sp = 0u;
    for (;;) {
        sum = 0u; cnt = 0u; mine = 0u;
#pragma unroll
        for (unsigned j = 0; j < 16; ++j) { const unsigned c = xb_ld(&bar[XB_XCNT(j)]); sum += c; cnt += (c > 0u) ? 1u : 0u; mine = (j == x) ? c : mine; }
        if (sum == G) break;
        __builtin_amdgcn_s_sleep(1);
        if ((++sp & 255u) == 0u) { if (xb_ld(&bar[XB_TMO])) break; if (sp > XB_SPIN_CAP) { atomicAdd(&bar[XB_TMO], 1u); break; } }
    }
    nloc = mine > 0u ? mine : 1u; nx = cnt > 0u ? cnt : 1u;
}
__device__ __forceinline__ void xcd_barrier(const XcdBarrier& b) {
    asm volatile("s_waitcnt vmcnt(0)" ::: "memory");
    __syncthreads();
    if (threadIdx.x == 0) {
        unsigned* bar = b.bar;
        __builtin_amdgcn_s_waitcnt(0);
        unsigned nloc = b.st[0], nx = b.st[1];
        if (nloc == 0u) { xcd_barrier_complete(bar, b.x, nloc, nx); b.st[0] = nloc; b.st[1] = nx; }
        const unsigned old = xb_add(&bar[XB_XSUB(b.x)], 1u);
        const unsigned gen = old / nloc;
        if (old + 1u == (gen + 1u) * nloc) {
            __builtin_amdgcn_fence(__ATOMIC_RELEASE, "agent");
            asm volatile("s_waitcnt vmcnt(0)" ::: "memory");
            const unsigned og = xb_add(&bar[XB_TOP], 1u);
            const unsigned tg = og / nx;
            if (og + 1u == (tg + 1u) * nx) xb_add(&bar[XB_TOPGEN], 1u);
            else XB_SPIN(xb_ld(&bar[XB_TOPGEN]) == tg, bar);
            __builtin_amdgcn_fence(__ATOMIC_ACQUIRE, "agent");
            xb_add(&bar[XB_XGEN(b.x)], 1u);
            asm volatile("s_waitcnt vmcnt(0)" ::: "memory");
        } else {
            XB_SPIN(xb_ld(&bar[XB_XGEN(b.x)]) == gen, bar);
            __builtin_amdgcn_fence(__ATOMIC_ACQUIRE, "agent");
            asm volatile("s_waitcnt vmcnt(0)" ::: "memory");
        }
    }
    __syncthreads();
}

namespace pg8 {
constexpr int BM = 256, BK = 64, HALF = 128, HTB = HALF * BK * 2, STAGE_BYTES = 8 * HTB, NXCD = 8, WGM = 8;
__host__ __device__ __forceinline__ int lds_byte(int r, int c) { const int st = (r >> 4) * 2 + (c >> 5), rr = r & 15, cc = c & 31, ob = rr * 64 + cc * 2; return st * 1024 + (ob ^ (((ob >> 9) & 1) << 5)); }
__host__ __device__ __forceinline__ void stage_rc(int b, int& R, int& C) { const int st = b / 1024, sb = b % 1024, swz = sb ^ (((sb >> 9) & 1) << 5); R = (st >> 1) * 16 + swz / 64; C = (st & 1) * 32 + (swz % 64) / 2; }
__host__ __device__ __forceinline__ int perm32(int rho) { const int n = rho >> 4, i = rho & 15; return 8 * (i >> 2) + 4 * n + (i & 3); }

struct Unit { int pm, pn, e, nv, lbase; };

struct DenseSched {
    static constexpr bool GATHER = false;
    const bf16_t* A; const bf16_t* Bt; int K; int nM, nN, nwg, G, c;
    __device__ void init(const bf16_t* A_, const bf16_t* Bt_, int M, int N, int K_, int G_, int c_) { A = A_; Bt = Bt_; K = K_; nM = M / BM; nN = N / BM; nwg = nM * nN; G = G_; c = c_; }
    __device__ __forceinline__ bool next(int i, Unit& u) const {
        const long L = (long)i * G + c; if (L >= nwg) return false;
        int wgid = (int)L; { const int q = nwg / NXCD, r = nwg % NXCD, xcd = wgid % NXCD, off = wgid / NXCD; wgid = (xcd < r ? xcd * (q + 1) : r * (q + 1) + (xcd - r) * q) + off; }
        const int nig = WGM * nN, gid = wgid / nig, fm = gid * WGM, gsz = (nM - fm) < WGM ? (nM - fm) : WGM;
        u.pm = fm + ((wgid % nig) % gsz); u.pn = (wgid % nig) / gsz; u.e = 0; u.nv = 256; u.lbase = 0; return true;
    }
    __device__ __forceinline__ const char* a_ptr(const Unit& u) const { return (const char*)A + (size_t)u.pm * (size_t)(BM * 2) * K; }
    __device__ __forceinline__ const char* b_ptr(const Unit& u) const { return (const char*)Bt + (size_t)u.pn * (size_t)(BM * 2) * K; }
    __device__ __forceinline__ void a_voff(int, const int (&R)[2], const int (&C)[2], unsigned (&vA)[2][2]) const {
#pragma unroll
        for (int h = 0; h < 2; ++h)
#pragma unroll
            for (int i = 0; i < 2; ++i) vA[h][i] = (unsigned)((h * HALF + R[i]) * K + C[i]) * 2u;
    }
};
template <bool GATHER_, int NT  >
struct MoeSched {
    static constexpr bool GATHER = GATHER_;
    const bf16_t* A; const bf16_t* Bt; int K; int G, c, nunits;
    const LAS int* cnt; const LAS int* tp; const LAS int* te; const LAS int* tok;
    __device__ __forceinline__ bool next(int i, Unit& u) const {
        const int L = i * G + c; if (L >= nunits) return false;
        const int q = nunits / NXCD, r = nunits % NXCD, xcd = L % NXCD, off = L / NXCD;
        const int w = (xcd < r ? xcd * (q + 1) : r * (q + 1) + (xcd - r) * q) + off;
        const int tt = w / NT; u.pm = tt; u.pn = w % NT;
        const int e = __builtin_amdgcn_readfirstlane(te[tt]); u.e = e; const int j = tt - __builtin_amdgcn_readfirstlane(tp[e]); const int left = __builtin_amdgcn_readfirstlane(cnt[e]) - j * 256; u.nv = left < 256 ? left : 256; u.lbase = e * T + j * 256; return true;
    }
    __device__ __forceinline__ const char* a_ptr(const Unit& u) const { return GATHER ? (const char*)A : (const char*)A + (size_t)u.pm * (size_t)(BM * 2) * K; }
    __device__ __forceinline__ const char* b_ptr(const Unit& u) const { return (const char*)Bt + ((size_t)u.e * NT + u.pn) * (size_t)(BM * 2) * K; }
    __device__ __forceinline__ void a_voff(int ui, const int (&R)[2], const int (&C)[2], unsigned (&vA)[2][2]) const {
#pragma unroll
        for (int h = 0; h < 2; ++h)
#pragma unroll
            for (int i = 0; i < 2; ++i) vA[h][i] = GATHER ? (unsigned)tok[ui * 256 + h * HALF + R[i]] + (unsigned)C[i] * 2u : (unsigned)((h * HALF + R[i]) * K + C[i]) * 2u;
    }
};

struct EpRowScaleBf16 {
    static constexpr bool PERM = true;
    bf16_t* O; int ldc; const float* rs;
    __device__ __forceinline__ void operator()(const f32x4 (&acc)[2][2][4][2], const Unit& u, int wr, int wc, int fr, int fq) const {
        const int row0 = u.pm * BM + wr * 64 + fr, col0 = u.pn * BM + wc * 32 + 8 * fq;
#pragma unroll
        for (int ai = 0; ai < 2; ++ai)
#pragma unroll
            for (int m = 0; m < 4; ++m) { const int row = row0 + ai * HALF + m * 16; const float s = rs[row]; bf16_t* rowp = O + (size_t)row * ldc + col0;
#pragma unroll
                for (int bj = 0; bj < 2; ++bj) { const f32x4 v0 = acc[ai][bj][m][0] * s, v1 = acc[ai][bj][m][1] * s;
                    u32x4 w; w.x = cvt_pk_bf16(v0[0], v0[1]); w.y = cvt_pk_bf16(v0[2], v0[3]); w.z = cvt_pk_bf16(v1[0], v1[1]); w.w = cvt_pk_bf16(v1[2], v1[3]);
                    *(u32x4*)(rowp + bj * HALF) = w; } }
    }
};
struct EpResidF32 {
    static constexpr bool PERM = false;
    const float* base; float* C; int ldc;
    __device__ __forceinline__ void operator()(const f32x4 (&acc)[2][2][4][2], const Unit& u, int wr, int wc, int fr, int fq) const {
        const int row0 = u.pm * BM + wr * 64 + fr, col0 = u.pn * BM + wc * 32 + 4 * fq;
#pragma unroll
        for (int ai = 0; ai < 2; ++ai)
#pragma unroll
            for (int m = 0; m < 4; ++m) { const size_t off = (size_t)(row0 + ai * HALF + m * 16) * ldc + col0;
#pragma unroll
                for (int bj = 0; bj < 2; ++bj)
#pragma unroll
                    for (int n = 0; n < 2; ++n) { const f32x4 bs = *(const f32x4*)(base + off + bj * HALF + n * 16); *(f32x4*)(C + off + bj * HALF + n * 16) = bs + acc[ai][bj][m][n]; } }
    }
};
struct EpGlu {
    static constexpr bool PERM = true;
    bf16_t* act; const float* bg; const float* bu;
    __device__ __forceinline__ void operator()(const f32x4 (&acc)[2][2][4][2], const Unit& u, int wr, int wc, int fr, int fq) const {
        const int c0 = u.pn * HALF + wc * 32 + 8 * fq;
        const f32x4 g0 = *(const f32x4*)(bg + u.e * FF + c0), g1 = *(const f32x4*)(bg + u.e * FF + c0 + 4), u0 = *(const f32x4*)(bu + u.e * FF + c0), u1 = *(const f32x4*)(bu + u.e * FF + c0 + 4);
#pragma unroll
        for (int ai = 0; ai < 2; ++ai)
#pragma unroll
            for (int m = 0; m < 4; ++m) { const int r = ai * HALF + wr * 64 + m * 16 + fr;
                f32x4 ga = acc[ai][0][m][0] + g0, gb = acc[ai][0][m][1] + g1, ua = acc[ai][1][m][0] + u0, ub = acc[ai][1][m][1] + u1; float o[8];
#pragma unroll
                for (int j = 0; j < 4; ++j) { float g = fminf(ga[j], 7.0f), uu = fminf(fmaxf(ua[j], -7.0f), 7.0f); o[j] = g * fast_sigmoid(1.702f * g) * (uu + 1.0f);
                    g = fminf(gb[j], 7.0f); uu = fminf(fmaxf(ub[j], -7.0f), 7.0f); o[4 + j] = g * fast_sigmoid(1.702f * g) * (uu + 1.0f); }
                u32x4 w; w.x = cvt_pk_bf16(o[0], o[1]); w.y = cvt_pk_bf16(o[2], o[3]); w.z = cvt_pk_bf16(o[4], o[5]); w.w = cvt_pk_bf16(o[6], o[7]);
                if (r < u.nv) *(u32x4*)(act + (size_t)(u.pm * BM + r) * FF + c0) = w; }
    }
};
struct EpDown {
    static constexpr bool PERM = true;
    bf16_t* ybuf; const float* bd; const int* list; const float* gate_of;
    __device__ __forceinline__ void operator()(const f32x4 (&acc)[2][2][4][2], const Unit& u, int wr, int wc, int fr, int fq) const {
        const int c0 = u.pn * BM + wc * 32 + 8 * fq;
        f32x4 bv[2][2];
#pragma unroll
        for (int bj = 0; bj < 2; ++bj)
#pragma unroll
            for (int n = 0; n < 2; ++n) bv[bj][n] = *(const f32x4*)(bd + u.e * D + c0 + bj * HALF + 4 * n);
#pragma unroll
        for (int ai = 0; ai < 2; ++ai)
#pragma unroll
            for (int m = 0; m < 4; ++m) { const int r = ai * HALF + wr * 64 + m * 16 + fr;
                if (r < u.nv) { const int a = list[u.lbase + r]; const float gw = gate_of[a]; bf16_t* rowp = ybuf + (size_t)a * D + c0;
#pragma unroll
                    for (int bj = 0; bj < 2; ++bj) { const f32x4 v0 = (acc[ai][bj][m][0] + bv[bj][0]) * gw, v1 = (acc[ai][bj][m][1] + bv[bj][1]) * gw;
                        u32x4 w; w.x = cvt_pk_bf16(v0[0], v0[1]); w.y = cvt_pk_bf16(v0[2], v0[3]); w.z = cvt_pk_bf16(v1[0], v1[1]); w.w = cvt_pk_bf16(v1[2], v1[3]);
                        *(u32x4*)(rowp + bj * HALF) = w; } } }
    }
};

template <class Epi, class Sched>
__device__ __forceinline__ void gemm_phase(LAS unsigned char* lds, const Sched& S, const Epi& E) {
    const int tid = threadIdx.x, wid = __builtin_amdgcn_readfirstlane(tid >> 6), lane = tid & 63, wr = wid >> 2, wc = wid & 3, fr = lane & 15, fq = lane >> 4;
    const int K = S.K, nt = K / BK;
    unsigned voffB[2], vA[2][2]; int Rr[2], Cc[2];
#pragma unroll
    for (int i = 0; i < 2; ++i) { int R, C; stage_rc(tid * 16 + i * 8192, R, C); const int Rb = Epi::PERM ? ((R & ~31) + perm32(R & 31)) : R;
        voffB[i] = (unsigned)(Rb * K + C) * 2u; Rr[i] = R; Cc[i] = C; }
    const size_t kstep = (size_t)(BK * 2);
    const size_t hstep = (size_t)HALF * K * 2;
    const unsigned ldsw = (unsigned)wid * 1024u;
    const int aoff = lds_byte(wr * 64 + fr, fq * 8), boff = lds_byte(wc * 32 + fr, fq * 8);
#define PG8_SA(b, h) (((b) * 2 + (h)) * HTB)
#define PG8_SB(b, h) ((4 + (b) * 2 + (h)) * HTB)
#define PG8_STAGE(bufoff, gbase, voff) do { _Pragma("unroll") for (int _i = 0; _i < 2; ++_i) \
        __builtin_amdgcn_global_load_lds((const unsigned*)((const char*)(gbase) + (voff)[_i]), (LAS unsigned*)(lds + (bufoff) + ldsw + _i * 8192), 16, 0, 0); } while (0)
#define PG8_LDA(dst, b, h) do { _Pragma("unroll") for (int m = 0; m < 4; ++m) _Pragma("unroll") for (int k = 0; k < 2; ++k) dst[m][k] = *(const LAS bf16x8*)(lds + PG8_SA(b, h) + aoff + m * 2048 + k * 1024); } while (0)
#define PG8_LDB(dst, b, h) do { _Pragma("unroll") for (int n = 0; n < 2; ++n) _Pragma("unroll") for (int k = 0; k < 2; ++k) dst[n][k] = *(const LAS bf16x8*)(lds + PG8_SB(b, h) + boff + n * 2048 + k * 1024); } while (0)
#define PG8_MMA(ai, bj, At, Bt) do { __builtin_amdgcn_s_setprio(1); _Pragma("unroll") for (int m = 0; m < 4; ++m) _Pragma("unroll") for (int n = 0; n < 2; ++n) _Pragma("unroll") for (int k = 0; k < 2; ++k) \
        acc[ai][bj][m][n] = __builtin_amdgcn_mfma_f32_16x16x32_bf16(Bt[n][k], At[m][k], acc[ai][bj][m][n], 0, 0, 0); __builtin_amdgcn_s_setprio(0); } while (0)
#define PG8_WAIT_V(n) asm volatile("s_waitcnt vmcnt(" #n ")" ::: "memory")
#define PG8_WAIT_L(n) asm volatile("s_waitcnt lgkmcnt(" #n ")" ::: "memory")
#define PG8_BAR __builtin_amdgcn_s_barrier()
#define PG8_SCHED __builtin_amdgcn_sched_barrier(0)
    Unit cur, nxt; int ui = 0;
    if (!S.next(0, cur)) return;
    S.a_voff(0, Rr, Cc, vA);
    f32x4 acc[2][2][4][2];
#pragma unroll
    for (int a = 0; a < 2; ++a)
#pragma unroll
        for (int b = 0; b < 2; ++b)
#pragma unroll
            for (int m = 0; m < 4; ++m)
#pragma unroll
                for (int n = 0; n < 2; ++n) acc[a][b][m][n] = (f32x4){0.f, 0.f, 0.f, 0.f};
    bf16x8 At[4][2], B0[2][2], B1[2][2];
    const char* cA = S.a_ptr(cur); const char* cB = S.b_ptr(cur);
    PG8_STAGE(PG8_SB(0, 0), cB, voffB); PG8_STAGE(PG8_SB(0, 1), cB + hstep, voffB); PG8_STAGE(PG8_SA(0, 0), cA, vA[0]); PG8_STAGE(PG8_SA(0, 1), cA, vA[1]);
    if (wr == 1) PG8_BAR;
    PG8_WAIT_V(2); PG8_BAR;
    PG8_STAGE(PG8_SB(1, 0), cB + kstep, voffB); PG8_STAGE(PG8_SA(1, 0), cA + kstep, vA[0]); PG8_STAGE(PG8_SB(1, 1), cB + hstep + kstep, voffB);
    PG8_WAIT_V(6); PG8_BAR;
    for (;;) {
        const bool has_next = S.next(ui + 1, nxt);
        const char* nA = has_next ? S.a_ptr(nxt) : cA; const char* nB = has_next ? S.b_ptr(nxt) : cB;
        for (int t = 0; t < nt; t += 2) {
            const bool last = (t == nt - 2);
            const char* a1 = cA + (size_t)(t + 1) * kstep;
            const char* a2 = last ? nA : cA + (size_t)(t + 2) * kstep; const char* b2 = last ? nB : cB + (size_t)(t + 2) * kstep;
            const char* a3 = a2 + kstep; const char* b3 = b2 + kstep;
            PG8_LDB(B0, 0, 0); PG8_LDB(B1, 0, 1); PG8_SCHED; PG8_LDA(At, 0, 0); PG8_STAGE(PG8_SA(1, 1), a1, vA[1]);
            if (Sched::GATHER) { if (last && has_next) S.a_voff(ui + 1, Rr, Cc, vA); }
            PG8_WAIT_V(8); PG8_WAIT_L(0); PG8_BAR; PG8_MMA(0, 0, At, B0); PG8_MMA(0, 1, At, B1); PG8_BAR; PG8_SCHED;
            PG8_LDA(At, 0, 1); PG8_STAGE(PG8_SB(0, 0), b2, voffB); PG8_STAGE(PG8_SB(0, 1), b2 + hstep, voffB); PG8_STAGE(PG8_SA(0, 0), a2, vA[0]);
            PG8_WAIT_V(8); PG8_WAIT_L(0); PG8_BAR; PG8_MMA(1, 0, At, B0); PG8_MMA(1, 1, At, B1); PG8_BAR; PG8_SCHED;
            PG8_LDB(B0, 1, 0); PG8_LDB(B1, 1, 1); PG8_SCHED; PG8_LDA(At, 1, 0); PG8_STAGE(PG8_SA(0, 1), a2, vA[1]);
            PG8_WAIT_V(8); PG8_WAIT_L(0); PG8_BAR; PG8_MMA(0, 0, At, B0); PG8_MMA(0, 1, At, B1); PG8_BAR; PG8_SCHED;
            PG8_LDA(At, 1, 1); PG8_STAGE(PG8_SB(1, 0), b3, voffB); PG8_STAGE(PG8_SB(1, 1), b3 + hstep, voffB); PG8_STAGE(PG8_SA(1, 0), a3, vA[0]);
            PG8_WAIT_V(8); PG8_WAIT_L(0); PG8_BAR; PG8_MMA(1, 0, At, B0); PG8_MMA(1, 1, At, B1); PG8_BAR; PG8_SCHED;
        }
        if (wr == 0) PG8_BAR;
        E(acc, cur, wr, wc, fr, fq);
        if (!has_next) break;
#pragma unroll
        for (int a = 0; a < 2; ++a)
#pragma unroll
            for (int b = 0; b < 2; ++b)
#pragma unroll
                for (int m = 0; m < 4; ++m)
#pragma unroll
                    for (int n = 0; n < 2; ++n) acc[a][b][m][n] = (f32x4){0.f, 0.f, 0.f, 0.f};
        cur = nxt; cA = nA; cB = nB; ++ui;
        if (wr == 1) PG8_BAR;
    }
    PG8_WAIT_V(0);
    PG8_BAR;
#undef PG8_SA
#undef PG8_SB
#undef PG8_STAGE
#undef PG8_LDA
#undef PG8_LDB
#undef PG8_MMA
#undef PG8_WAIT_V
#undef PG8_WAIT_L
#undef PG8_BAR
#undef PG8_SCHED
}
}

constexpr int NWAVES = 8, NTHR = 512;
struct Frame {
    LAS unsigned char* lds;
    int tid, lane, wave, vcu, G;
    const float* in[20]; float* out; unsigned char* ws;
};
struct Args { const float* in[20]; float* out; unsigned char* ws; int ph_lo, ph_hi; };
enum { I_X = 0, I_N1G, I_WIN, I_IGB, I_FGB, I_CONVW, I_HNG, I_POOLW, I_POOLS, I_WOUT, I_N2G, I_WR, I_BR, I_WG, I_BG, I_WU, I_BU, I_WD, I_BD, I_NFG };

#define LDS_WAIT() asm volatile("s_waitcnt lgkmcnt(0)" ::: "memory")

__device__ __forceinline__ void p0_item(const float* __restrict__ W, int ldw, int col0, const float* __restrict__ gk, bf16_t* wt, int k0, LAS float* scr, int lane) {
#pragma unroll 8
    for (int i = 0; i < 32; ++i) { const int kk = 2 * i + (lane >> 5); float v = W[(size_t)(k0 + kk) * ldw + col0 + (lane & 31)]; if (gk) v *= gk[k0 + kk]; scr[kk * 33 + (lane & 31)] = v; }
    LDS_WAIT(); asm volatile("" ::: "memory");
    const int c = lane & 7;
#pragma unroll
    for (int j = 0; j < 4; ++j) { const int n = (lane >> 3) + 8 * j; const LAS float* s = scr + (8 * c) * 33 + n;
        u32x4 o; o.x = cvt_pk_bf16(s[0 * 33], s[1 * 33]); o.y = cvt_pk_bf16(s[2 * 33], s[3 * 33]); o.z = cvt_pk_bf16(s[4 * 33], s[5 * 33]); o.w = cvt_pk_bf16(s[6 * 33], s[7 * 33]);
        *(u32x4*)(wt + (size_t)n * 1024 + k0 + 8 * c) = o; }
    LDS_WAIT(); asm volatile("" ::: "memory");
}
__device__ __forceinline__ void phase0(Frame& F) {
    const int gw = F.vcu * NWAVES + F.wave, NGW = F.G * NWAVES, lane = F.lane;
    bf16_t* win_t = (bf16_t*)(F.ws + WS_WIN); bf16_t* wout_t = (bf16_t*)(F.ws + WS_WOUT); bf16_t* wgu_t = (bf16_t*)(F.ws + WS_WGU); bf16_t* wd_t = (bf16_t*)(F.ws + WS_WD);
    {
        LAS float* wgl = (LAS float*)(F.lds + 98304);
        const float* w_in = F.in[I_WIN]; const float* g1 = F.in[I_N1G];
        for (int s = F.tid; s < 1024; s += NTHR) { const int j = s >> 8, q = (s >> 6) & 3, l = s & 63, k = 256 * j + 4 * l + q; const float g = g1[k];
#pragma unroll
            for (int i = 0; i < 8; ++i) wgl[s * 8 + i] = w_in[(size_t)k * NIN + 2048 + i] * g; }
        __syncthreads();
        bf16_t* xb = (bf16_t*)(F.ws + WS_XB); float* rs1 = (float*)(F.ws + WS_RS1); float* gates = (float*)(F.ws + WS_GATES);
        const float* x = F.in[I_X];
        for (int row = gw; row < T; row += NGW) {
            const f32x4* xr = (const f32x4*)(x + (size_t)row * D) + lane;
            f32x4 v[4]; float ss = 0.f; float ga[8];
#pragma unroll
            for (int i = 0; i < 8; ++i) ga[i] = 0.f;
#pragma unroll
            for (int j = 0; j < 4; ++j) { v[j] = xr[64 * j]; ss += (v[j].x * v[j].x + v[j].y * v[j].y) + (v[j].z * v[j].z + v[j].w * v[j].w); }
#pragma unroll
            for (int j = 0; j < 4; ++j)
#pragma unroll
                for (int q = 0; q < 4; ++q) { const LAS f32x4* wp = (const LAS f32x4*)(wgl + (256 * j + 64 * q + lane) * 8); const f32x4 w0 = wp[0], w1 = wp[1]; const float xv = v[j][q];
                    ga[0] += xv * w0.x; ga[1] += xv * w0.y; ga[2] += xv * w0.z; ga[3] += xv * w0.w; ga[4] += xv * w1.x; ga[5] += xv * w1.y; ga[6] += xv * w1.z; ga[7] += xv * w1.w; }
            const float rs = rsqrtf(wave_sum(ss) * (1.f / D) + EPS);
            float mine = 0.f;
#pragma unroll
            for (int i = 0; i < 8; ++i) { const float s = wave_sum(ga[i]); mine = (lane == i) ? s : mine; }
            if (lane < 8) gates[(size_t)row * 8 + lane] = mine * rs;
            if (lane == 0) rs1[row] = rs;
            u32x2* o8 = (u32x2*)(xb + (size_t)row * D) + lane;
#pragma unroll
            for (int j = 0; j < 4; ++j) { u32x2 o; o.x = cvt_pk_bf16(v[j].x, v[j].y); o.y = cvt_pk_bf16(v[j].z, v[j].w); o8[64 * j] = o; }
        }
    }
    {
        LAS float* scr = (LAS float*)(F.lds + F.wave * 8704);
        constexpr int I_IN = 16 * (NP / 32), I_OUT = 16 * 32, I_EXP = 16 * 32;
        constexpr int NITEMS = I_IN + I_OUT + NE * 3 * I_EXP;
        for (int it = gw; it < NITEMS; it += NGW) {
            int r = it;
            if (r < I_IN) { const int kb = r / (NP / 32), nb = r % (NP / 32), n0 = 32 * nb; p0_item(F.in[I_WIN], NIN, n0 < 2048 ? n0 : n0 + 8, F.in[I_N1G], win_t + (size_t)n0 * 1024, 64 * kb, scr, lane); continue; } r -= I_IN;
            if (r < I_OUT) { const int kb = r / 32, nb = r % 32; p0_item(F.in[I_WOUT], D, 32 * nb, nullptr, wout_t + (size_t)(32 * nb) * 1024, 64 * kb, scr, lane); continue; } r -= I_OUT;
            const int e = r / (3 * I_EXP), r2 = r % (3 * I_EXP), which = r2 / I_EXP, r3 = r2 % I_EXP, kb = r3 / 32, nb = r3 % 32, c0 = 32 * nb;
            if (which == 2) p0_item(F.in[I_WD] + (size_t)e * FF * D, D, c0, nullptr, wd_t + ((size_t)e * D + c0) * 1024, 64 * kb, scr, lane);
            else { const int rowi = 256 * (c0 >> 7) + 128 * which + (c0 & 127);
                p0_item(F.in[which ? I_WU : I_WG] + (size_t)e * D * FF, FF, c0, nullptr, wgu_t + ((size_t)e * 2048 + rowi) * 1024, 64 * kb, scr, lane); }
        }
    }
}

__device__ __forceinline__ float conv_silu(const bf16_t* __restrict__ P, const float* __restrict__ conv_w, int tok, int s, int ch) {
    float acc = 0.f;
#pragma unroll
    for (int j = 0; j < 4; ++j) { const int sp = s - 3 + j; if (sp >= 0) acc += bf2f(P[(size_t)(tok - 3 + j) * NP + ch]) * conv_w[j * 1024 + ch]; }
    return acc * sigmoidf_(acc);
}
__device__ __forceinline__ void chunk_gates(const float* __restrict__ gates, const float* __restrict__ ig_b, const float* __restrict__ fg_b, int tok0, int h, LAS float* s_ig, LAS float* s_b) {
    const int l = threadIdx.x;
    if (l < 64) { const float* pr = gates + (size_t)(tok0 + l) * 8; s_ig[l] = pr[h] + ig_b[h]; s_b[l] = logsigmoidf_(pr[4 + h] + fg_b[h]); }
    __syncthreads();
    if (l == 0) { float c = 0.f; for (int i = 0; i < 64; ++i) { c += s_b[i]; s_b[i] = c; } }
    __syncthreads();
}
__device__ __forceinline__ void phase2_local(Frame& F) {
    const bf16_t* P = (const bf16_t*)(F.ws + WS_P); const float* gates = (const float*)(F.ws + WS_GATES); const float* conv_w = F.in[I_CONVW];
    float* Cst = (float*)(F.ws + WS_CST); float* nst = (float*)(F.ws + WS_NST); float* mloc = (float*)(F.ws + WS_MLOC); float* btot = (float*)(F.ws + WS_BTOT);
    LAS float* wk = (LAS float*)F.lds; LAS float* s_ig = wk + 64 * 128; LAS float* s_b = s_ig + 64; LAS float* s_w = s_b + 64;
    const int tid = F.tid;
    for (int u = blockIdx.x; u < 1024; u += F.G) {
        const int c = u & 63, h = (u >> 6) & 3, b = u >> 8, tok0 = b * SEQ + c * 64;
        chunk_gates(gates, F.in[I_IGB], F.in[I_FGB], tok0, h, s_ig, s_b);
        if (tid == 0) { const float bt = s_b[63]; float m = -INFINITY;
            for (int l = 0; l < 64; ++l) m = fmaxf(m, bt - s_b[l] + s_ig[l]);
            for (int l = 0; l < 64; ++l) s_w[l] = expf(bt - s_b[l] + s_ig[l] - m);
            mloc[u] = m; btot[u] = bt; }
        __syncthreads();
        for (int idx = tid; idx < 64 * 128; idx += NTHR) { const int l = idx >> 7, d = idx & 127;
            wk[idx] = s_w[l] * conv_silu(P, conv_w, tok0 + l, c * 64 + l, 512 + h * 128 + d) * 0.08838834764831845f; }
        __syncthreads();
        const int ty = tid >> 4, tx = tid & 15;
        float acc[4][8];
#pragma unroll
        for (int i = 0; i < 4; ++i)
#pragma unroll
            for (int j = 0; j < 8; ++j) acc[i][j] = 0.f;
        for (int l = 0; l < 64; ++l) {
            const u32x4 vw = *(const u32x4*)(P + (size_t)(tok0 + l) * NP + PC_V + h * 128 + tx * 8);
            const float vv[8] = {bflo(vw.x), bfhi(vw.x), bflo(vw.y), bfhi(vw.y), bflo(vw.z), bfhi(vw.z), bflo(vw.w), bfhi(vw.w)};
#pragma unroll
            for (int i = 0; i < 4; ++i) { const float a = wk[l * 128 + ty * 4 + i];
#pragma unroll
                for (int j = 0; j < 8; ++j) acc[i][j] += a * vv[j]; }
        }
#pragma unroll
        for (int i = 0; i < 4; ++i) { float* cp = Cst + ((size_t)u * 128 + ty * 4 + i) * 128 + tx * 8;
            *(f32x4*)cp = (f32x4){acc[i][0], acc[i][1], acc[i][2], acc[i][3]}; *(f32x4*)(cp + 4) = (f32x4){acc[i][4], acc[i][5], acc[i][6], acc[i][7]}; }
        if (tid < 128) { float s = 0.f; for (int l = 0; l < 64; ++l) s += wk[l * 128 + tid]; nst[(size_t)u * 128 + tid] = s; }
        __syncthreads();
    }
}
__device__ __forceinline__ void phase2_pool(Frame& F) {
    const bf16_t* P = (const bf16_t*)(F.ws + WS_P); bf16_t* ycat = (bf16_t*)(F.ws + WS_YCAT); const float* pool_w = F.in[I_POOLW]; const float* pool_scale = F.in[I_POOLS];
    LAS float* pl = (LAS float*)F.lds;
    const int tid = F.tid;
    for (int u = blockIdx.x; u < 1024; u += F.G) {
        const int tok0 = (u >> 2) * 64, gi = u & 3, w = 2 << gi;
        for (int idx = tid; idx < 64 * 128; idx += NTHR) { const int l = idx >> 7, cc = idx & 127; const int tok = tok0 + l, s = tok & (SEQ - 1);
            const int cnt = (s + 1 < w) ? s + 1 : w; float sum = 0.f;
            for (int j = 0; j < cnt; ++j) sum += bf2f(P[(size_t)(tok - j) * NP + PC_U + gi * 128 + cc]);
            pl[l * 129 + cc] = sum / (float)cnt - bf2f(P[(size_t)tok * NP + PC_U + gi * 128 + cc]); }
        __syncthreads();
        const int d = tid & 127, lg = tid >> 7;
        float acc[16];
#pragma unroll
        for (int i = 0; i < 16; ++i) acc[i] = 0.f;
        for (int cc = 0; cc < 128; ++cc) { const float wv = pool_w[((size_t)gi * 128 + cc) * 128 + d];
#pragma unroll
            for (int i = 0; i < 16; ++i) acc[i] += pl[(lg * 16 + i) * 129 + cc] * wv; }
        const float sc = pool_scale[gi * 128 + d];
#pragma unroll
        for (int i = 0; i < 16; ++i) ycat[(size_t)(tok0 + lg * 16 + i) * D + 512 + gi * 128 + d] = (bf16_t)(cvt_pk_bf16(acc[i] * sc, 0.f) & 0xffffu);
        __syncthreads();
    }
}
__device__ __forceinline__ void phase3_scan(Frame& F) {
    float* Cst = (float*)(F.ws + WS_CST); float* nst = (float*)(F.ws + WS_NST); const float* mloc = (const float*)(F.ws + WS_MLOC); const float* btot = (const float*)(F.ws + WS_BTOT);
    float* m_in = (float*)(F.ws + WS_MIN);
    constexpr int PER = 16384 + 128;
    for (int g = blockIdx.x * NTHR + F.tid; g < 16 * PER; g += F.G * NTHR) {
        const int bh = g / PER, idx = g % PER;
        float C = 0.f, m = 0.f;
        for (int c = 0; c < 64; ++c) {
            const int u = bh * 64 + c;
            float* p = idx < 16384 ? Cst + (size_t)u * 16384 + idx : nst + (size_t)u * 128 + (idx - 16384);
            const float Cl = *p; *p = C;
            const float ml = mloc[u], bt = btot[u];
            if (idx == 0) m_in[u] = m;
            const float mn = fmaxf(bt + m, ml), so = expf(bt + m - mn), sl = expf(ml - mn);
            C = so * C + sl * Cl; m = mn;
        }
    }
}
constexpr int QS = 129;
__device__ __forceinline__ void phase4_out(Frame& F) {
    const bf16_t* P = (const bf16_t*)(F.ws + WS_P); const float* gates = (const float*)(F.ws + WS_GATES); const float* conv_w = F.in[I_CONVW]; const float* head_norm_g = F.in[I_HNG];
    const float* Cin = (const float*)(F.ws + WS_CST); const float* nin = (const float*)(F.ws + WS_NST); const float* m_in = (const float*)(F.ws + WS_MIN);
    bf16_t* ycat = (bf16_t*)(F.ws + WS_YCAT);
    LAS float* qc = (LAS float*)F.lds; LAS float* kc = qc + 64 * QS; LAS float* S = kc + 64 * QS;
    LAS float* s_ig = S + 64 * 65; LAS float* s_b = s_ig + 64; LAS float* s_mo = s_b + 64; LAS float* s_den = s_mo + 64; LAS float* s_int = s_den + 64;
    const int tid = F.tid;
    for (int u = blockIdx.x; u < 1024; u += F.G) {
        const int c = u & 63, h = (u >> 6) & 3, b = u >> 8, tok0 = b * SEQ + c * 64;
        chunk_gates(gates, F.in[I_IGB], F.in[I_FGB], tok0, h, s_ig, s_b);
        const float mi = m_in[u];
        for (int idx = tid; idx < 64 * 128; idx += NTHR) { const int l = idx >> 7, d = idx & 127;
            qc[l * QS + d] = conv_silu(P, conv_w, tok0 + l, c * 64 + l, h * 128 + d);
            kc[l * QS + d] = conv_silu(P, conv_w, tok0 + l, c * 64 + l, 512 + h * 128 + d) * 0.08838834764831845f; }
        if (tid < 64) { const int l = tid; const float a = s_b[l] + mi; float mx = a;
            for (int r = 0; r <= l; ++r) mx = fmaxf(mx, s_b[l] - s_b[r] + s_ig[r]);
            s_mo[l] = mx; s_int[l] = expf(a - mx); }
        __syncthreads();
        for (int idx = tid; idx < 64 * 64; idx += NTHR) { const int l = idx >> 6, r = idx & 63; float v = 0.f;
            if (r <= l) { float dot = 0.f; for (int d = 0; d < 128; ++d) dot += qc[l * QS + d] * kc[r * QS + d];
                v = dot * expf(s_b[l] - s_b[r] + s_ig[r] - s_mo[l]); }
            S[l * 65 + r] = v; }
        __syncthreads();
        if (tid < 64) { const int l = tid; float ds = 0.f; for (int r = 0; r < 64; ++r) ds += S[l * 65 + r];
            float qn = 0.f; for (int d = 0; d < 128; ++d) qn += qc[l * QS + d] * nin[(size_t)u * 128 + d];
            s_den[l] = ds + s_int[l] * qn; }
        const int dv = tid & 127, lg = tid >> 7;
        float a1[16], a2[16];
#pragma unroll
        for (int i = 0; i < 16; ++i) { a1[i] = 0.f; a2[i] = 0.f; }
        for (int r = 0; r < 64; ++r) { const float vv = bf2f(P[(size_t)(tok0 + r) * NP + PC_V + h * 128 + dv]);
#pragma unroll
            for (int i = 0; i < 16; ++i) a1[i] += S[(lg * 16 + i) * 65 + r] * vv; }
        for (int dk = 0; dk < 128; ++dk) { const float cv = Cin[((size_t)u * 128 + dk) * 128 + dv];
#pragma unroll
            for (int i = 0; i < 16; ++i) a2[i] += qc[(lg * 16 + i) * QS + dk] * cv; }
        __syncthreads();
#pragma unroll
        for (int i = 0; i < 16; ++i) { const int l = lg * 16 + i; const float num = a1[i] + s_int[l] * a2[i];
            kc[l * QS + dv] = num / fmaxf(fabsf(s_den[l]), expf(-s_mo[l])); }
        __syncthreads();
        const int wave = F.wave, lane = F.lane;
        for (int i = 0; i < 8; ++i) { const int l = wave * 8 + i; const float h0 = kc[l * QS + lane], h1 = kc[l * QS + lane + 64];
            const float mu = wave_sum(h0 + h1) * (1.f / 128.f); const float d0 = h0 - mu, d1 = h1 - mu;
            const float var = wave_sum(d0 * d0 + d1 * d1) * (1.f / 128.f); const float rstd = rsqrtf(var + EPS);
            const size_t tok = (size_t)(tok0 + l);
            const float o0 = bf2f(P[tok * NP + PC_O + h * 128 + lane]), o1 = bf2f(P[tok * NP + PC_O + h * 128 + lane + 64]);
            ycat[tok * D + h * 128 + lane] = (bf16_t)(cvt_pk_bf16(sigmoidf_(o0) * d0 * rstd * head_norm_g[h * 128 + lane], 0.f) & 0xffffu);
            ycat[tok * D + h * 128 + lane + 64] = (bf16_t)(cvt_pk_bf16(sigmoidf_(o1) * d1 * rstd * head_norm_g[h * 128 + lane + 64], 0.f) & 0xffffu); }
        __syncthreads();
    }
}

__device__ __forceinline__ void phase6_route(Frame& F) {
    const float* x1 = (const float*)(F.ws + WS_X1); const float* g2 = F.in[I_N2G]; const float* w_router = F.in[I_WR]; const float* b_router = F.in[I_BR];
    bf16_t* h2 = (bf16_t*)(F.ws + WS_H2); int* cnt = (int*)(F.ws + WS_CTL) + CW_CNT; int* list = (int*)(F.ws + WS_LIST); float* gate_of = (float*)(F.ws + WS_GATEOF);
    LAS float* wr = (LAS float*)F.lds;
    for (int i = F.tid; i < 1024 * 8; i += NTHR) { const int s = i >> 3, ch = i & 7, j = s >> 8, q = (s >> 6) & 3, l = s & 63, k = 256 * j + 4 * l + q; const float g = g2[k];
        f32x4 w = *(const f32x4*)(w_router + (size_t)k * NE + ch * 4); w = w * g; *(LAS f32x4*)(wr + s * 32 + ((ch ^ (s & 7)) << 2)) = w; }
    __syncthreads();
    const int gw = F.vcu * NWAVES + F.wave, NGW = F.G * NWAVES, lane = F.lane;
    for (int t = gw; t < T; t += NGW) {
        const f32x4* xr = (const f32x4*)(x1 + (size_t)t * D) + lane;
        f32x4 v[4]; float ss = 0.f;
#pragma unroll
        for (int j = 0; j < 4; ++j) { v[j] = xr[64 * j]; ss += (v[j].x * v[j].x + v[j].y * v[j].y) + (v[j].z * v[j].z + v[j].w * v[j].w); }
        const float rs = rsqrtf(wave_sum(ss) * (1.f / D) + EPS);
        float lg[32];
#pragma unroll
        for (int e = 0; e < 32; ++e) lg[e] = 0.f;
        u32x2* o8 = (u32x2*)(h2 + (size_t)t * D) + lane;
#pragma unroll
        for (int j = 0; j < 4; ++j) { const f32x4 gg = *(const f32x4*)(g2 + 256 * j + 4 * lane);
            u32x2 o; o.x = cvt_pk_bf16(v[j].x * rs * gg.x, v[j].y * rs * gg.y); o.y = cvt_pk_bf16(v[j].z * rs * gg.z, v[j].w * rs * gg.w); o8[64 * j] = o;
#pragma unroll
            for (int q = 0; q < 4; ++q) { const int s = 256 * j + 64 * q + lane; const float xv = v[j][q];
#pragma unroll
                for (int ch = 0; ch < 8; ++ch) { const f32x4 w = *(const LAS f32x4*)(wr + s * 32 + ((ch ^ (s & 7)) << 2));
                    lg[ch * 4 + 0] += xv * w.x; lg[ch * 4 + 1] += xv * w.y; lg[ch * 4 + 2] += xv * w.z; lg[ch * 4 + 3] += xv * w.w; } } }
#pragma unroll
        for (int e = 0; e < 32; ++e) lg[e] = wave_sum(lg[e]) * rs + b_router[e];
        int bi[4]; float bv[4];
#pragma unroll
        for (int k = 0; k < 4; ++k) { float best = -INFINITY; int bb = 0;
#pragma unroll
            for (int e = 0; e < 32; ++e) if (lg[e] > best) { best = lg[e]; bb = e; }
#pragma unroll
            for (int e = 0; e < 32; ++e) if (e == bb) lg[e] = -INFINITY;
            bi[k] = bb; bv[k] = best; }
        float ex[4], se = 0.f;
#pragma unroll
        for (int k = 0; k < 4; ++k) { ex[k] = expf(bv[k] - bv[0]); se += ex[k]; }
        if (lane == 0) {
#pragma unroll
            for (int k = 0; k < 4; ++k) { const int pos = atomicAdd(cnt + bi[k], 1); list[bi[k] * T + pos] = t * 4 + k; gate_of[t * 4 + k] = ex[k] / se; } }
    }
}

__device__ __forceinline__ int moe_tables(Frame& F) {
    LAS int* lcnt = (LAS int*)(F.lds + LDS_CNT); LAS int* ltp = (LAS int*)(F.lds + LDS_TP); LAS int* lte = (LAS int*)(F.lds + LDS_TE);
    const int* cnt = (const int*)(F.ws + WS_CTL) + CW_CNT;
    if (F.tid < 32) lcnt[F.tid] = cnt[F.tid];
    __syncthreads();
    if (F.tid == 0) { int s = 0; for (int e = 0; e < NE; ++e) { ltp[e] = s; const int nt = (lcnt[e] + 255) >> 8; for (int j = 0; j < nt; ++j) lte[s + j] = e; s += nt; } ltp[NE] = s; }
    __syncthreads();
    return ltp[NE];
}

__device__ __forceinline__ void phase9_final(Frame& F) {
    const float* x1 = (const float*)(F.ws + WS_X1); const bf16_t* ybuf = (const bf16_t*)(F.ws + WS_YBUF); const float* gf = F.in[I_NFG]; float* out = F.out;
    const int gw = F.vcu * NWAVES + F.wave, NGW = F.G * NWAVES, lane = F.lane;
    for (int t = gw; t < T; t += NGW) {
        const f32x4* xr = (const f32x4*)(x1 + (size_t)t * D) + lane;
        f32x4 v[4];
#pragma unroll
        for (int j = 0; j < 4; ++j) v[j] = xr[64 * j];
#pragma unroll
        for (int k = 0; k < 4; ++k) { const u32x2* yr = (const u32x2*)(ybuf + (size_t)(t * 4 + k) * D) + lane;
#pragma unroll
            for (int j = 0; j < 4; ++j) { const u32x2 y = yr[64 * j]; v[j].x += bflo(y.x); v[j].y += bfhi(y.x); v[j].z += bflo(y.y); v[j].w += bfhi(y.y); } }
        float ss = 0.f;
#pragma unroll
        for (int j = 0; j < 4; ++j) ss += (v[j].x * v[j].x + v[j].y * v[j].y) + (v[j].z * v[j].z + v[j].w * v[j].w);
        const float rs = rsqrtf(wave_sum(ss) * (1.f / D) + EPS);
        f32x4* orow = (f32x4*)(out + (size_t)t * D) + lane;
#pragma unroll
        for (int j = 0; j < 4; ++j) { const f32x4 gg = *(const f32x4*)(gf + 256 * j + 4 * lane); orow[64 * j] = v[j] * rs * gg; }
    }
}

__global__ void __launch_bounds__(NTHR, 2) mega(Args args) {
    extern __shared__ __attribute__((aligned(16))) unsigned char lds_raw[];
    Frame F;
    F.lds = (LAS unsigned char*)lds_raw;
    F.tid = threadIdx.x; F.lane = F.tid & 63; F.wave = __builtin_amdgcn_readfirstlane(F.tid >> 6);
    F.G = gridDim.x; { const int bx = blockIdx.x; F.vcu = (F.G % 8 == 0) ? (bx % 8) * (F.G / 8) + bx / 8 : bx; }
#pragma unroll
    for (int i = 0; i < 20; ++i) F.in[i] = args.in[i];
    F.out = args.out; F.ws = args.ws;
    if (F.tid < 4) ((LAS unsigned*)(F.lds + LDS_BARW))[F.tid] = 0u;
    __syncthreads();
    unsigned* ctl = (unsigned*)(F.ws + WS_CTL);
    XcdBarrier bar; bar.bar = ctl + CW_BAR; bar.x = 0; bar.st = nullptr;
    if (MK_N_LAUNCHES == 1) bar = xcd_barrier_post(ctl + CW_BAR, (volatile LAS unsigned*)(F.lds + LDS_BARW));
    const int lo = args.ph_lo, hi = args.ph_hi;
#define IN(k) (lo <= (k) && (k) < hi)
#define SEAM(k) do { if (IN(k) && IN((k) + 1)) xcd_barrier(bar); } while (0)

    if (IN(0)) { phase0(F); SEAM(0); }
    if (IN(1)) {
        pg8::DenseSched S; S.init((const bf16_t*)(F.ws + WS_XB), (const bf16_t*)(F.ws + WS_WIN), T, NP, D, F.G, (int)blockIdx.x);
        pg8::EpRowScaleBf16 E{(bf16_t*)(F.ws + WS_P), NP, (const float*)(F.ws + WS_RS1)};
        pg8::gemm_phase(F.lds, S, E);
        SEAM(1);
    }
    if (IN(2)) { phase2_local(F); phase2_pool(F); SEAM(2); }
    if (IN(3)) { phase3_scan(F); SEAM(3); }
    if (IN(4)) { phase4_out(F); SEAM(4); }
    if (IN(5)) {
        pg8::DenseSched S; S.init((const bf16_t*)(F.ws + WS_YCAT), (const bf16_t*)(F.ws + WS_WOUT), T, D, D, F.G, (int)blockIdx.x);
        pg8::EpResidF32 E{F.in[I_X], (float*)(F.ws + WS_X1), D};
        pg8::gemm_phase(F.lds, S, E);
        SEAM(5);
    }
    if (IN(6)) { phase6_route(F); SEAM(6); }
    if (IN(7)) {
        const int ntiles = moe_tables(F);
        pg8::MoeSched<true, 8> S; S.A = (const bf16_t*)(F.ws + WS_H2); S.Bt = (const bf16_t*)(F.ws + WS_WGU); S.K = D; S.G = F.G; S.c = (int)blockIdx.x; S.nunits = ntiles * 8;
        S.cnt = (const LAS int*)(F.lds + LDS_CNT); S.tp = (const LAS int*)(F.lds + LDS_TP); S.te = (const LAS int*)(F.lds + LDS_TE); S.tok = (const LAS int*)(F.lds + LDS_TOK);
        {
            const int* list = (const int*)(F.ws + WS_LIST); LAS int* tok = (LAS int*)(F.lds + LDS_TOK); pg8::Unit u;
            for (int i = 0; i < 10 && S.next(i, u); ++i) if (F.tid < 256) tok[i * 256 + F.tid] = (F.tid < u.nv) ? (list[u.lbase + F.tid] >> 2) * (D * 2) : 0;
            __syncthreads();
        }
        pg8::EpGlu E{(bf16_t*)(F.ws + WS_ACT), F.in[I_BG], F.in[I_BU]};
        pg8::gemm_phase(F.lds, S, E);
        SEAM(7);
    }
    if (IN(8)) {
        const int ntiles = moe_tables(F);
        pg8::MoeSched<false, 4> S; S.A = (const bf16_t*)(F.ws + WS_ACT); S.Bt = (const bf16_t*)(F.ws + WS_WD); S.K = FF; S.G = F.G; S.c = (int)blockIdx.x; S.nunits = ntiles * 4;
        S.cnt = (const LAS int*)(F.lds + LDS_CNT); S.tp = (const LAS int*)(F.lds + LDS_TP); S.te = (const LAS int*)(F.lds + LDS_TE); S.tok = (const LAS int*)(F.lds + LDS_TOK);
        pg8::EpDown E{(bf16_t*)(F.ws + WS_YBUF), F.in[I_BD], (const int*)(F.ws + WS_LIST), (const float*)(F.ws + WS_GATEOF)};
        pg8::gemm_phase(F.lds, S, E);
        SEAM(8);
    }
    if (IN(9)) { phase9_final(F); }
#undef IN
#undef SEAM
}

extern "C" void kernel_launch(void* const* d_in, const int* in_sizes, int n_in, void* d_out, int out_size, void* d_ws, size_t ws_size, hipStream_t stream) {
    static int grid = 0;
    if (grid == 0) {
        if (n_in != 20 || in_sizes[0] != T * D || out_size != T * D || ws_size < WS_END) { fprintf(stderr, "kernel_launch: unexpected problem (n_in %d, ws %zu)\n", n_in, ws_size); grid = -1; return; }
        int dev = 0, cus = 0, per_cu = 0;
        if (hipGetDevice(&dev) != hipSuccess || hipDeviceGetAttribute(&cus, hipDeviceAttributeMultiprocessorCount, dev) != hipSuccess) { grid = -1; return; }
        if (hipFuncSetAttribute((const void*)mega, hipFuncAttributeMaxDynamicSharedMemorySize, LDS_BYTES) != hipSuccess) { fprintf(stderr, "kernel_launch: hipFuncSetAttribute failed\n"); grid = -1; return; }
        if (hipOccupancyMaxActiveBlocksPerMultiprocessor(&per_cu, (const void*)mega, NTHR, LDS_BYTES) != hipSuccess || per_cu < 1) fprintf(stderr, "kernel_launch: occupancy query reports %d\n", per_cu);
        (void)hipGetLastError();
        grid = cus;
    }
    if (grid < 0) return;
    (void)hipMemsetAsync((char*)d_ws + WS_CTL, 0, CTL_ZERO_BYTES, stream);
    Args a{};
    for (int i = 0; i < 20; ++i) a.in[i] = (const float*)d_in[i];
    a.out = (float*)d_out; a.ws = (unsigned char*)d_ws;
    if (MK_N_LAUNCHES == 1) { a.ph_lo = 0; a.ph_hi = N_PHASES; hipLaunchKernelGGL(mega, dim3(grid), dim3(NTHR), LDS_BYTES, stream, a); }
    else for (int p = 0; p < N_PHASES; ++p) { a.ph_lo = p; a.ph_hi = p + 1; hipLaunchKernelGGL(mega, dim3(grid), dim3(NTHR), LDS_BYTES, stream, a); }
}
```

```cpp
#include <hip/hip_runtime.h>
#include <cstdio>
#include <cstdint>

#ifndef MK_N_LAUNCHES
#define MK_N_LAUNCHES 1
#endif
constexpr int N_PHASES = 10;
constexpr bool MOE_ALIGN = true;
#ifndef DUP_MASK
#define DUP_MASK 0
#endif
#define REP(k) for (int rep_ = 0; rep_ < 1 + ((DUP_MASK >> (k)) & 1); ++rep_)

constexpr int T = 16384, D = 1024, SEQ = 4096;
constexpr int NIN = 2568;
constexpr int NP = 2560;
constexpr int NE = 32, FF = 1024;
constexpr float EPS = 1e-5f;
constexpr int PC_V = 1024, PC_O = 1536, PC_U = 2048;

#define GAS __attribute__((address_space(1)))
#define LAS __attribute__((address_space(3)))
typedef unsigned short bf16_t;
typedef short bf16x8 __attribute__((ext_vector_type(8)));
typedef float f32x4 __attribute__((ext_vector_type(4)));
typedef unsigned u32x4 __attribute__((ext_vector_type(4)));
typedef unsigned u32x2 __attribute__((ext_vector_type(2)));

__device__ __forceinline__ unsigned cvt_pk_bf16(float lo, float hi) { unsigned r; asm volatile("v_cvt_pk_bf16_f32 %0, %1, %2" : "=v"(r) : "v"(lo), "v"(hi)); return r; }
__device__ __forceinline__ float bf2f(unsigned short b) { return __uint_as_float(((unsigned)b) << 16); }
__device__ __forceinline__ float bflo(unsigned w) { return __uint_as_float(w << 16); }
__device__ __forceinline__ float bfhi(unsigned w) { return __uint_as_float(w & 0xffff0000u); }
template <int CTRL> __device__ __forceinline__ float dpp_mov(float v) { return __builtin_bit_cast(float, __builtin_amdgcn_update_dpp(0, __builtin_bit_cast(int, v), CTRL, 0xF, 0xF, true)); }
__device__ __forceinline__ float wave_sum(float v) {
    v += dpp_mov<0xB1>(v);
    v += dpp_mov<0x4E>(v);
    v += dpp_mov<0x141>(v);
    v += dpp_mov<0x140>(v);
    const int vi = __builtin_bit_cast(int, v);
    return (__builtin_bit_cast(float, __builtin_amdgcn_readlane(vi, 0)) + __builtin_bit_cast(float, __builtin_amdgcn_readlane(vi, 16)))
         + (__builtin_bit_cast(float, __builtin_amdgcn_readlane(vi, 32)) + __builtin_bit_cast(float, __builtin_amdgcn_readlane(vi, 48)));
}
template <int CTRL, int ROWMASK> __device__ __forceinline__ float dpp_old(float old, float v) { return __builtin_bit_cast(float, __builtin_amdgcn_update_dpp(__builtin_bit_cast(int, old), __builtin_bit_cast(int, v), CTRL, ROWMASK, 0xF, false)); }
__device__ __forceinline__ float lane_bcast(float v, int l) { return __builtin_bit_cast(float, __builtin_amdgcn_readlane(__builtin_bit_cast(int, v), l)); }
__device__ __forceinline__ float row16_sum(float v) { v += dpp_mov<0xB1>(v); v += dpp_mov<0x4E>(v); v += dpp_mov<0x141>(v); v += dpp_mov<0x140>(v); return v; }
__device__ __forceinline__ float logsigmoidf_(float x) { return fminf(x, 0.f) - log1pf(expf(-fabsf(x))); }
__device__ __forceinline__ float sigmoidf_(float x) { return 1.f / (1.f + expf(-x)); }
__device__ __forceinline__ float fast_sigmoid(float x) { return __builtin_amdgcn_rcpf(1.0f + __builtin_amdgcn_exp2f(-1.44269504f * x)); }

__device__ __forceinline__ int flane() { return (int)__builtin_amdgcn_mbcnt_hi(~0u, __builtin_amdgcn_mbcnt_lo(~0u, 0u)); }
__device__ __forceinline__ int olane() { int v; asm volatile("v_mbcnt_lo_u32_b32 %0, -1, 0\n\tv_mbcnt_hi_u32_b32 %0, -1, %0" : "=v"(v)); return v; }

constexpr size_t MiB = 1u << 20;
constexpr size_t WS_CTL = 0, CTL_ZERO_BYTES = 1 * MiB;
constexpr size_t WS_WIN = 1 * MiB;
constexpr size_t WS_WOUT = 6 * MiB;
constexpr size_t WS_WGU = 8 * MiB;
constexpr size_t WS_WD = 72 * MiB;
constexpr size_t WS_SGU = 104 * MiB;
constexpr size_t WS_SD = WS_SGU + 512 * 1024;
constexpr size_t WS_X1 = 105 * MiB;
constexpr size_t WS_CST = 105 * MiB;
constexpr size_t WS_CIN = 137 * MiB;
constexpr size_t WS_ACT = 169 * MiB;
constexpr size_t WS_YBUF = 241 * MiB;
constexpr size_t WS_P = 169 * MiB;
constexpr size_t WS_XB = 249 * MiB;
constexpr size_t WS_YCAT = 281 * MiB;
constexpr size_t WS_H2 = 369 * MiB;
constexpr size_t WS_SM = 385 * MiB;
constexpr size_t WS_RS1 = WS_SM, WS_GATES = WS_SM + 64 * 1024, WS_NST = WS_GATES + 512 * 1024, WS_MLOC = WS_NST + 512 * 1024, WS_BTOT = WS_MLOC + 4096, WS_MIN = WS_BTOT + 4096, WS_SH = WS_SM + 1280 * 1024, WS_NIN = WS_SM + 2560 * 1024,
                 WS_POOLWT = WS_SM + 1536 * 1024, WS_GATEOF = WS_SM + 2 * MiB, WS_LIST = WS_SM + 3 * MiB, WS_END = WS_LIST + (size_t)NE * T * 4;
static_assert(WS_END <= 392 * MiB, "ws map");
constexpr float ACT_CLIP = 16.0f, ACT_Q = 127.0f / ACT_CLIP, ACT_SCALE = ACT_CLIP / 127.0f;
constexpr float Y_CLIP = 3.0f, Y_Q = 127.0f / Y_CLIP, Y_SCALE = Y_CLIP / 127.0f;
constexpr int CW_CNT = 64;
constexpr int CW_BAR = 4096;
constexpr int CW_QHEAD = 24;

constexpr int RING_BYTES = 131072;
constexpr int LDS_TOK = RING_BYTES;
constexpr int LDS_TSC = LDS_TOK + 10 * 1024;
constexpr int LDS_CNT = LDS_TSC + 10 * 1024;
constexpr int LDS_TP = LDS_CNT + 128;
constexpr int LDS_TE = LDS_TP + 192;
constexpr int LDS_P6 = 153600;
constexpr int LDS_EPI = 153600;
constexpr int LDS_BARW = 163776;
constexpr int LDS_BYTES = 163840;
static_assert(LDS_TE + 1280 <= LDS_P6 && LDS_P6 + 9728 <= LDS_BARW, "LDS map");
constexpr int WR_LANE_STRIDE = 2064;

#define XB_TMO      128
#define XB_XCNT(j)  (256  + 64 * (j))
#define XB_XSUB(j)  (1280 + 64 * (j))
#define XB_XGEN(j)  (2304 + 64 * (j))
#define XB_TOP      3328
#define XB_TOPGEN   3392
#define XCD_BAR_WORDS 3456
#define XB_SPIN_CAP (1u << 18)
__device__ __forceinline__ unsigned xb_ld(unsigned* p)              { return __hip_atomic_load(p, __ATOMIC_RELAXED, __HIP_MEMORY_SCOPE_AGENT); }
__device__ __forceinline__ unsigned xb_add(unsigned* p, unsigned v) { return __hip_atomic_fetch_add(p, v, __ATOMIC_RELAXED, __HIP_MEMORY_SCOPE_AGENT); }
__device__ __forceinline__ unsigned xb_xcc_id() { return (unsigned)__builtin_amdgcn_s_getreg((3 << 11) | 20) & 0xFu; }
#define XB_SPIN(cond, bar) do { unsigned _sp = 0; while (cond) { __builtin_amdgcn_s_sleep(1); \
    if ((++_sp & 255u) == 0u) { if (xb_ld(&(bar)[XB_TMO])) break; if (_sp > XB_SPIN_CAP) { atomicAdd(&(bar)[XB_TMO], 1u); break; } } } } while (0)
struct XcdBarrier { unsigned* bar; unsigned x; volatile LAS unsigned* st; };
__device__ __forceinline__ XcdBarrier xcd_barrier_post(unsigned* bar, volatile LAS unsigned* st) {
    XcdBarrier b; b.bar = bar; b.x = xb_xcc_id(); b.st = st;
    if (threadIdx.x == 0) (void)xb_add(&bar[XB_XCNT(b.x)], 1u);
    return b;
}
__device__ __forceinline__ void xcd_barrier_complete(unsigned* bar, unsigned x, unsigned& nloc, unsigned& nx) {
    const unsigned G = gridDim.x * gridDim.y * gridDim.z;
    unsigned sum, cnt, mine, sp = 0u;
    for (;;) {
        sum = 0u; cnt = 0u; mine = 0u;
#pragma unroll
        for (unsigned j = 0; j < 16; ++j) { const unsigned c = xb_ld(&bar[XB_XCNT(j)]); sum += c; cnt += (c > 0u) ? 1u : 0u; mine = (j == x) ? c : mine; }
        if (sum == G) break;
        __builtin_amdgcn_s_sleep(1);
        if ((++sp & 255u) == 0u) { if (xb_ld(&bar[XB_TMO])) break; if (sp > XB_SPIN_CAP) { atomicAdd(&bar[XB_TMO], 1u); break; } }
    }
    nloc = mine > 0u ? mine : 1u; nx = cnt > 0u ? cnt : 1u;
}
__device__ __forceinline__ void xcd_barrier(const XcdBarrier& b, const int wave) {
    asm volatile("s_waitcnt vmcnt(0)" ::: "memory");
    __syncthreads();
    if (wave == 0 && flane() == 0) {
        unsigned* bar = b.bar;
        __builtin_amdgcn_s_waitcnt(0);
        unsigned nloc = b.st[0], nx = b.st[1];
        if (nloc == 0u) { xcd_barrier_complete(bar, b.x, nloc, nx); b.st[0] = nloc; b.st[1] = nx; }
        const unsigned old = xb_add(&bar[XB_XSUB(b.x)], 1u);
        const unsigned gen = old / nloc;
        if (old + 1u == (gen + 1u) * nloc) {
            __builtin_amdgcn_fence(__ATOMIC_RELEASE, "agent");
            asm volatile("s_waitcnt vmcnt(0)" ::: "memory");
            const unsigned og = xb_add(&bar[XB_TOP], 1u);
            const unsigned tg = og / nx;
            if (og + 1u == (tg + 1u) * nx) xb_add(&bar[XB_TOPGEN], 1u);
            else XB_SPIN(xb_ld(&bar[XB_TOPGEN]) == tg, bar);
            __builtin_amdgcn_fence(__ATOMIC_ACQUIRE, "agent");
            xb_add(&bar[XB_XGEN(b.x)], 1u);
            asm volatile("s_waitcnt vmcnt(0)" ::: "memory");
        } else {
            XB_SPIN(xb_ld(&bar[XB_XGEN(b.x)]) == gen, bar);
            __builtin_amdgcn_fence(__ATOMIC_ACQUIRE, "agent");
            asm volatile("s_waitcnt vmcnt(0)" ::: "memory");
        }
    }
    __syncthreads();
}

namespace pg8 {
typedef int i32x4 __attribute__((ext_vector_type(4)));
constexpr int BM = 256, BK = 64, HALF = 128, HTB = HALF * BK * 2, STAGE_BYTES = 8 * HTB, NXCD = 8, WGM = 8;
__host__ __device__ __forceinline__ int lds_byte(int r, int c) { const int st = (r >> 4) * 2 + (c >> 5), rr = r & 15, cc = c & 31, ob = rr * 64 + cc * 2; return st * 1024 + (ob ^ (((ob >> 9) & 1) << 5)); }
__host__ __device__ __forceinline__ void stage_rc(int b, int& R, int& C) { const int st = b / 1024, sb = b % 1024, swz = sb ^ (((sb >> 9) & 1) << 5); R = (st >> 1) * 16 + swz / 64; C = (st & 1) * 32 + (swz % 64) / 2; }
__host__ __device__ __forceinline__ int perm32(int rho) { const int n = rho >> 4, i = rho & 15; return 8 * (i >> 2) + 4 * n + (i & 3); }

struct Unit { int pm, pn, e, nv, lbase, half; };

struct DenseSched {
    static constexpr bool GATHER = false; static constexpr int ESZ_ = 2;
    const bf16_t* A; const bf16_t* Bt; int K; int nM, nN, nwg, G, c, nmine, nrep, nfull, split;
    __device__ __forceinline__ void init(const bf16_t* A_, const bf16_t* Bt_, int M, int N, int K_, int G_, int c_, int nrep_) { A = A_; Bt = Bt_; K = K_; nM = M / BM; nN = N / BM; nwg = nM * nN; G = G_; c = c_; nrep = nrep_;
        nfull = (nwg / G) * G; const int rest = nwg - nfull; split = (rest > 0 && 2 * rest <= G) ? 1 : 0;
        const int ntot = split ? nfull + 2 * rest : nwg; nmine = ntot > c ? (ntot - c + G - 1) / G : 0; }
    __device__ __forceinline__ bool next(int i, Unit& u) const {
        if (i >= nmine * nrep) return false; const int L = (i % nmine) * G + c;
        int wgid = L, half = 0;
        if (split && L >= nfull) { wgid = nfull + ((L - nfull) >> 1); half = 1 + ((L - nfull) & 1); }
        { const int q = nwg / NXCD, r = nwg % NXCD, xcd = wgid % NXCD, off = wgid / NXCD; wgid = (xcd < r ? xcd * (q + 1) : r * (q + 1) + (xcd - r) * q) + off; }
        const int nig = WGM * nN, gid = wgid / nig, fm = gid * WGM, gsz = (nM - fm) < WGM ? (nM - fm) : WGM;
        u.pm = fm + ((wgid % nig) % gsz); u.pn = (wgid % nig) / gsz; u.e = 0; u.nv = 256; u.lbase = 0; u.half = half; return true;
    }
    __device__ __forceinline__ const char* a_ptr(const Unit& u) const { return (const char*)A + ((size_t)u.pm * BM + (u.half == 2 ? HALF : 0)) * (size_t)2 * K; }
    __device__ __forceinline__ const char* b_ptr(const Unit& u) const { return (const char*)Bt + (size_t)u.pn * (size_t)(BM * 2) * K; }
    __device__ __forceinline__ void a_voff(int, const int (&R)[2], const int (&C)[2], unsigned (&vA)[2][2]) const {
#pragma unroll
        for (int h = 0; h < 2; ++h)
#pragma unroll
            for (int i = 0; i < 2; ++i) vA[h][i] = (unsigned)((h * HALF + R[i]) * K + C[i]) * 2u;
    }
};
template <bool GATHER_, int NT  , int ESZ  >
struct MoeSched {
    static constexpr bool GATHER = GATHER_;
    static constexpr int ESZ_ = ESZ;
    const void* A; const void* Bt; int K; int G, c, nunits, nmine, nrep, nfull, split;
    const LAS int* cnt; const LAS int* tp; const LAS int* te; const LAS int* tok;
    __device__ __forceinline__ bool next(int i, Unit& u) const {
        if (i >= nmine * nrep) return false; const int L = (i % nmine) * G + c;
        int wg = L, half = 0;
        if (split && L >= nfull) { wg = nfull + ((L - nfull) >> 1); half = 1 + ((L - nfull) & 1); }
        const int q = nunits / NXCD, r = nunits % NXCD, xcd = wg % NXCD, off = wg / NXCD;
        const int w = (xcd < r ? xcd * (q + 1) : r * (q + 1) + (xcd - r) * q) + off;
        const int tt = w / NT; u.pm = tt; u.pn = w % NT; u.half = half;
        const int e = __builtin_amdgcn_readfirstlane(te[tt]); u.e = e; const int j = tt - __builtin_amdgcn_readfirstlane(tp[e]); const int left = __builtin_amdgcn_readfirstlane(cnt[e]) - j * 256; u.nv = left < 256 ? left : 256; u.lbase = e * T + j * 256; return true;
    }
    __device__ __forceinline__ void setup(int nunits_, int G_, int c_, int nrep_, bool allow_split) { nunits = nunits_; G = G_; c = c_; nrep = nrep_;
        nfull = (nunits / G) * G; const int rest = nunits - nfull; split = (allow_split && rest > 0 && 2 * rest <= G) ? 1 : 0;
        const int ntot = split ? nfull + 2 * rest : nunits; nmine = ntot > c ? (ntot - c + G - 1) / G : 0; }
    __device__ __forceinline__ const char* a_ptr(const Unit& u) const { return GATHER ? (const char*)A : (const char*)A + ((size_t)u.pm * BM + (u.half == 2 ? HALF : 0)) * (size_t)ESZ * K; }
    __device__ __forceinline__ const char* b_ptr(const Unit& u) const { return (const char*)Bt + ((size_t)u.e * NT + u.pn) * (size_t)(BM * ESZ) * K; }
    __device__ __forceinline__ void a_voff(int ui, const int (&R)[2], const int (&C)[2], unsigned (&vA)[2][2]) const {
#pragma unroll
        for (int h = 0; h < 2; ++h)
#pragma unroll
            for (int i = 0; i < 2; ++i) vA[h][i] = GATHER ? (unsigned)tok[(ui % nmine) * 256 + h * HALF + R[i]] + (unsigned)C[i] * 2u : (unsigned)((h * HALF + R[i]) * K * ESZ + C[i] * 2);
    }
};

struct EpRowScaleBf16 {
    static constexpr bool PERM = true; typedef f32x4 acc_t;
    bf16_t* O; int ldc; const float* rs; LAS unsigned char* epi;
    __device__ __forceinline__ void prefetch(const Unit& u, int slot, int wid) const {
        if (wid < 4) __builtin_amdgcn_global_load_lds((const unsigned*)(rs + u.pm * BM + (u.half == 2 ? HALF : 0) + ((wid * 64 + flane()) & (u.half ? 127 : 255))), (LAS unsigned*)(epi + slot * 2048 + wid * 256), 4, 0, 0); }
    __device__ __forceinline__ void operator()(const f32x4 (&acc)[2][2][4][2], const Unit& u, int wr, int wc, int fr, int fq, int slot) const {
        const int row0 = u.pm * BM + (u.half == 2 ? HALF : 0) + wr * 64 + fr, col0 = u.pn * BM + wc * 32 + 8 * fq;
        const __amdgpu_buffer_rsrc_t orsrc = __builtin_amdgcn_make_buffer_rsrc((void*)O, 0, T * NP * 2, 0x00020000);
        const LAS float* rsl = (const LAS float*)(epi + slot * 2048) + wr * 64 + fr;
#pragma unroll
        for (int ai = 0; ai < 2; ++ai) if (ai == 0 || u.half == 0)
#pragma unroll
            for (int m = 0; m < 4; ++m) { const int row = row0 + ai * HALF + m * 16; const float s = rsl[ai * HALF + m * 16]; const int boff = (row * ldc + col0) * 2;
#pragma unroll
                for (int bj = 0; bj < 2; ++bj) { const f32x4 v0 = acc[ai][bj][m][0] * s, v1 = acc[ai][bj][m][1] * s;
                    u32x4 w; w.x = cvt_pk_bf16(v0[0], v0[1]); w.y = cvt_pk_bf16(v0[2], v0[3]); w.z = cvt_pk_bf16(v1[0], v1[1]); w.w = cvt_pk_bf16(v1[2], v1[3]);
                    __builtin_amdgcn_raw_buffer_store_b128(w, orsrc, boff + bj * HALF * 2, 0, 16); } }
    }
};
struct EpResidF32 {
    static constexpr bool PERM = false; typedef f32x4 acc_t;
    const float* base; float* C; int ldc;
    __device__ __forceinline__ void prefetch(const Unit&, int, int) const {}
    __device__ __forceinline__ void operator()(const f32x4 (&acc)[2][2][4][2], const Unit& u, int wr, int wc, int fr, int fq, int) const {
        const int row0 = u.pm * BM + (u.half == 2 ? HALF : 0) + wr * 64 + fr, col0 = u.pn * BM + wc * 32 + 4 * fq;
#pragma unroll
        for (int ai = 0; ai < 2; ++ai) if (ai == 0 || u.half == 0)
#pragma unroll
            for (int m = 0; m < 4; ++m) { const size_t off = (size_t)(row0 + ai * HALF + m * 16) * ldc + col0;
#pragma unroll
                for (int bj = 0; bj < 2; ++bj)
#pragma unroll
                    for (int n = 0; n < 2; ++n) { const f32x4 bs = *(const f32x4*)(base + off + bj * HALF + n * 16); *(f32x4*)(C + off + bj * HALF + n * 16) = bs + acc[ai][bj][m][n]; } }
    }
};
__device__ __forceinline__ f32x4 i2f(const i32x4 v) { return (f32x4){(float)v.x, (float)v.y, (float)v.z, (float)v.w}; }
__device__ __forceinline__ unsigned q4(const float a, const float b, const float c, const float d) {
    unsigned w = __builtin_amdgcn_cvt_pk_u8_f32(a + 128.0f, 0, 0u); w = __builtin_amdgcn_cvt_pk_u8_f32(b + 128.0f, 1, w); w = __builtin_amdgcn_cvt_pk_u8_f32(c + 128.0f, 2, w); w = __builtin_amdgcn_cvt_pk_u8_f32(d + 128.0f, 3, w);
    return w ^ 0x80808080u; }
typedef float f32x2p __attribute__((ext_vector_type(2)));
__device__ __forceinline__ f32x2p swiglu_q2(f32x2p gate, f32x2p up) {
    f32x2p g, uu; g.x = fminf(gate.x, 7.0f); g.y = fminf(gate.y, 7.0f); uu.x = __builtin_amdgcn_fmed3f(up.x, -7.0f, 7.0f); uu.y = __builtin_amdgcn_fmed3f(up.y, -7.0f, 7.0f);
    const f32x2p a = g * (-1.702f * 1.44269504f); f32x2p e; e.x = __builtin_amdgcn_exp2f(a.x); e.y = __builtin_amdgcn_exp2f(a.y);
    const f32x2p d = e + 1.0f; f32x2p r; r.x = __builtin_amdgcn_rcpf(d.x); r.y = __builtin_amdgcn_rcpf(d.y);
    const f32x2p t = g * r, uq = uu * ACT_Q + ACT_Q;
    return t * uq + 128.0f;
}
__device__ __forceinline__ unsigned pk_u8x4(f32x2p a, f32x2p b) {
    unsigned w = __builtin_amdgcn_cvt_pk_u8_f32(a.x, 0, 0u); w = __builtin_amdgcn_cvt_pk_u8_f32(a.y, 1, w); w = __builtin_amdgcn_cvt_pk_u8_f32(b.x, 2, w); w = __builtin_amdgcn_cvt_pk_u8_f32(b.y, 3, w); return w ^ 0x80808080u; }
struct EpGlu8 {
    static constexpr bool PERM = true; typedef i32x4 acc_t;
    signed char* act; const float* bg; const float* bu; const float* sgu; const LAS float* tsc; int nmine; mutable int ui; LAS unsigned char* epi;
    __device__ __forceinline__ void prefetch(const Unit& u, int slot, int wid) const {
        const int arr = wid >> 1, j = ((wid & 1) << 6) + flane();
        const float* pb = (arr == 0 ? bg : bu) + u.e * FF + u.pn * HALF + j; const float* ps = sgu + (size_t)u.e * 2048 + u.pn * BM + (arr == 3 ? HALF : 0) + j;
        __builtin_amdgcn_global_load_lds((const unsigned*)(arr < 2 ? pb : ps), (LAS unsigned*)(epi + slot * 2048 + wid * 256), 4, 0, 0); }
    __device__ __forceinline__ void operator()(const i32x4 (&acc)[2][2][4][2], const Unit& u, int wr, int wc, int fr, int fq, int slot) const {
        const int c0 = u.pn * HALF + wc * 32 + 8 * fq;
        const LAS f32x4* ev = (const LAS f32x4*)(epi + slot * 2048 + (wc * 32 + 8 * fq) * 4);
        f32x2p bgv[4], buv[4], sgv[4], suv[4];
#pragma unroll
        for (int hq = 0; hq < 2; ++hq) { const f32x4 b = ev[hq], bu4 = ev[32 + hq], sg4 = ev[64 + hq], su4 = ev[96 + hq];
            bgv[2 * hq] = (f32x2p){b.x, b.y}; bgv[2 * hq + 1] = (f32x2p){b.z, b.w}; buv[2 * hq] = (f32x2p){bu4.x, bu4.y}; buv[2 * hq + 1] = (f32x2p){bu4.z, bu4.w};
            sgv[2 * hq] = (f32x2p){sg4.x, sg4.y}; sgv[2 * hq + 1] = (f32x2p){sg4.z, sg4.w}; suv[2 * hq] = (f32x2p){su4.x, su4.y}; suv[2 * hq + 1] = (f32x2p){su4.z, su4.w}; }
        const LAS float* ts = tsc + (ui % nmine) * 256;
        float sav[2][4];
#pragma unroll
        for (int ai = 0; ai < 2; ++ai)
#pragma unroll
            for (int m = 0; m < 4; ++m) sav[ai][m] = ts[ai * HALF + wr * 64 + m * 16 + fr];
        asm volatile("s_waitcnt lgkmcnt(0)" ::: "memory");
#pragma unroll 1
        for (int rep_ = 0; rep_ < 1 + ((DUP_MASK >> 11) & 1); ++rep_)
#pragma unroll
        for (int ai = 0; ai < 2; ++ai)
#pragma unroll
            for (int m = 0; m < 4; ++m) { const int r = ai * HALF + wr * 64 + m * 16 + fr; const float sa = sav[ai][m];
                f32x2p o[4];
#pragma unroll
                for (int q = 0; q < 4; ++q) { const i32x4 ga = acc[ai][0][m][q >> 1], ua = acc[ai][1][m][q >> 1];
                    f32x2p gf, uf; if (q & 1) { gf.x = (float)ga.z; gf.y = (float)ga.w; uf.x = (float)ua.z; uf.y = (float)ua.w; } else { gf.x = (float)ga.x; gf.y = (float)ga.y; uf.x = (float)ua.x; uf.y = (float)ua.y; }
                    o[q] = swiglu_q2(gf * (sgv[q] * sa) + bgv[q], uf * (suv[q] * sa) + buv[q]); }
                const unsigned w0 = pk_u8x4(o[0], o[1]), w1 = pk_u8x4(o[2], o[3]);
                *(u32x2*)(act + (size_t)(u.pm * BM + r) * FF + c0) = (u32x2){w0, w1}; }
        ++ui;
    }
};
struct EpDown8 {
    static constexpr bool PERM = true; typedef i32x4 acc_t;
    unsigned char* ybuf; const float* bd; const float* sd; const LAS int* tok; const LAS float* tsc; int nmine; mutable int ui; LAS unsigned char* epi;
    __device__ __forceinline__ void prefetch(const Unit& u, int slot, int wid) const {
        const int j = ((wid & 3) << 6) + flane();
        __builtin_amdgcn_global_load_lds((const unsigned*)((wid < 4 ? bd : sd) + u.e * D + u.pn * BM + j), (LAS unsigned*)(epi + slot * 2048 + wid * 256), 4, 0, 0); }
    __device__ __forceinline__ void operator()(const i32x4 (&acc)[2][2][4][2], const Unit& u, int wr, int wc, int fr, int fq, int slot) const {
        const int c0 = u.pn * BM + wc * 32 + 8 * fq;
        const LAS f32x4* ev = (const LAS f32x4*)(epi + slot * 2048 + (wc * 32 + 8 * fq) * 4);
        f32x4 bv[2][2], sv[2][2];
#pragma unroll
        for (int bj = 0; bj < 2; ++bj)
#pragma unroll
            for (int n = 0; n < 2; ++n) { bv[bj][n] = ev[bj * 32 + n]; sv[bj][n] = ev[64 + bj * 32 + n] * ACT_SCALE; }
        int av[2][4]; float gwv[2][4];
#pragma unroll
        for (int ai = 0; ai < 2; ++ai)
#pragma unroll
            for (int m = 0; m < 4; ++m) { const int r = (u.half == 2 ? HALF : 0) + ai * HALF + wr * 64 + m * 16 + fr; const int rc = r < 256 ? r : 255;
                av[ai][m] = tok[(ui % nmine) * 256 + rc]; gwv[ai][m] = tsc[(ui % nmine) * 256 + rc] * Y_Q; }
        asm volatile("s_waitcnt lgkmcnt(0)" ::: "memory");
#pragma unroll
        for (int ai = 0; ai < 2; ++ai) if (ai == 0 || u.half == 0)
#pragma unroll
            for (int m = 0; m < 4; ++m) { const int r = (u.half == 2 ? HALF : 0) + ai * HALF + wr * 64 + m * 16 + fr;
                if (r < u.nv) { const int a = av[ai][m]; const float gw = gwv[ai][m]; unsigned char* rowp = ybuf + (size_t)a * D + c0;
#pragma unroll
                    for (int bj = 0; bj < 2; ++bj) { const f32x4 v0 = (i2f(acc[ai][bj][m][0]) * sv[bj][0] + bv[bj][0]) * gw + 128.0f, v1 = (i2f(acc[ai][bj][m][1]) * sv[bj][1] + bv[bj][1]) * gw + 128.0f;
                        u32x2 w; w.x = pk_u8x4((f32x2p){v0[0], v0[1]}, (f32x2p){v0[2], v0[3]}) ^ 0x80808080u; w.y = pk_u8x4((f32x2p){v1[0], v1[1]}, (f32x2p){v1[2], v1[3]}) ^ 0x80808080u;
                        *(u32x2*)(rowp + bj * HALF) = w; } } }
        ++ui;
    }
};

template <class Epi, class Sched, bool I8 = false, bool ALIGN_EPI = true>
__device__ __forceinline__ void gemm_phase(LAS unsigned char* lds, const Sched& S, const Epi& E, const int wid  ) {
    static_assert(Sched::ESZ_ == (I8 ? 1 : 2), "element size");
    typedef typename Epi::acc_t acc_t;
    const int lane = flane(), tid = wid * 64 + lane, wr = wid >> 2, wc = wid & 3, fr = lane & 15, fq = lane >> 4;
    const int K = S.K, PITCH = K * (I8 ? 1 : 2), nt = PITCH / (BK * 2);
    unsigned voffB[2], vA[2][2]; int Rr[2], Cc[2];
#pragma unroll
    for (int i = 0; i < 2; ++i) { int R, C; stage_rc(tid * 16 + i * 8192, R, C); const int Rb = Epi::PERM ? ((R & ~31) + perm32(R & 31)) : R;
        voffB[i] = (unsigned)(Rb * PITCH + C * 2); Rr[i] = R; Cc[i] = C; }
    const size_t kstep = (size_t)(BK * 2);
    const size_t hstep = (size_t)HALF * PITCH;
    const unsigned ldsw = (unsigned)wid * 1024u;
    const int aoff = lds_byte(wr * 64 + fr, fq * 8), boff = lds_byte(wc * 32 + fr, fq * 8);
#define PG8_SA(b, h) (((b) * 2 + (h)) * HTB)
#define PG8_SB(b, h) ((4 + (b) * 2 + (h)) * HTB)
#define PG8_STAGE(bufoff, gbase, voff) do { _Pragma("unroll") for (int _i = 0; _i < 2; ++_i) \
        __builtin_amdgcn_global_load_lds((const unsigned*)((const char*)(gbase) + (voff)[_i]), (LAS unsigned*)(lds + (bufoff) + ldsw + _i * 8192), 16, 0, 0); } while (0)
#define PG8_LDA(dst, b, h) do { _Pragma("unroll") for (int m = 0; m < 4; ++m) _Pragma("unroll") for (int k = 0; k < 2; ++k) dst[m][k] = *(const LAS bf16x8*)(lds + PG8_SA(b, h) + aoff + m * 2048 + k * 1024); } while (0)
#define PG8_LDB(dst, b, h) do { _Pragma("unroll") for (int n = 0; n < 2; ++n) _Pragma("unroll") for (int k = 0; k < 2; ++k) dst[n][k] = *(const LAS bf16x8*)(lds + PG8_SB(b, h) + boff + n * 2048 + k * 1024); } while (0)
#define PG8_MMA(ai, bj, At, Bt) do { __builtin_amdgcn_s_setprio(1); _Pragma("unroll") for (int m = 0; m < 4; ++m) _Pragma("unroll") for (int n = 0; n < 2; ++n) _Pragma("unroll") for (int k = 0; k < 2; ++k) \
        { if constexpr (I8) acc[ai][bj][m][n] = __builtin_amdgcn_mfma_i32_16x16x64_i8(__builtin_bit_cast(i32x4, Bt[n][k]), __builtin_bit_cast(i32x4, At[m][k]), acc[ai][bj][m][n], 0, 0, 0); \
          else acc[ai][bj][m][n] = __builtin_amdgcn_mfma_f32_16x16x32_bf16(Bt[n][k], At[m][k], acc[ai][bj][m][n], 0, 0, 0); } __builtin_amdgcn_s_setprio(0); } while (0)
#define PG8_WAIT_V(n) asm volatile("s_waitcnt vmcnt(" #n ")" ::: "memory")
#define PG8_WAIT_L(n) asm volatile("s_waitcnt lgkmcnt(" #n ")" ::: "memory")
#define PG8_BAR __builtin_amdgcn_s_barrier()
#define PG8_SCHED __builtin_amdgcn_sched_barrier(0)
    Unit cur, nxt; int ui = 0;
    if (!S.next(0, cur)) return;
    S.a_voff(0, Rr, Cc, vA);
    acc_t acc[2][2][4][2];
#pragma unroll
    for (int a = 0; a < 2; ++a)
#pragma unroll
        for (int b = 0; b < 2; ++b)
#pragma unroll
            for (int m = 0; m < 4; ++m)
#pragma unroll
                for (int n = 0; n < 2; ++n) acc[a][b][m][n] = (acc_t){0, 0, 0, 0};
    bf16x8 At[4][2], B0[2][2], B1[2][2];
    const char* cA = S.a_ptr(cur); const char* cB = S.b_ptr(cur);
    PG8_STAGE(PG8_SB(0, 0), cB, voffB); PG8_STAGE(PG8_SB(0, 1), cB + hstep, voffB); PG8_STAGE(PG8_SA(0, 0), cA, vA[0]); PG8_STAGE(PG8_SA(0, 1), cA, vA[1]);
    if (wr == 1) PG8_BAR;
    PG8_WAIT_V(2); PG8_BAR;
    PG8_STAGE(PG8_SB(1, 0), cB + kstep, voffB); PG8_STAGE(PG8_SA(1, 0), cA + kstep, vA[0]); PG8_STAGE(PG8_SB(1, 1), cB + hstep + kstep, voffB);
    PG8_WAIT_V(6); PG8_BAR;
    for (;;) {
        const bool has_next = S.next(ui + 1, nxt);
        E.prefetch(cur, ui & 1, wid);
        const bool hu = __builtin_amdgcn_readfirstlane(cur.half) != 0;
        const char* nA = has_next ? S.a_ptr(nxt) : cA; const char* nB = has_next ? S.b_ptr(nxt) : cB;
        constexpr int KP = (I8 && ((DUP_MASK >> 22) & 1)) ? 2 : 1;
#pragma unroll 1
        for (int kp = 0; kp < KP; ++kp)
#pragma unroll 1
        for (int t = 0; t < nt; t += 2) {
            const bool lastk = (t == nt - 2), last = lastk && (kp == KP - 1);
            const char* a1 = cA + (size_t)(t + 1) * kstep;
            const char* a2 = lastk ? (last ? nA : cA) : cA + (size_t)(t + 2) * kstep; const char* b2 = lastk ? (last ? nB : cB) : cB + (size_t)(t + 2) * kstep;
#define PG8_ZB() do { if (KP == 2 && kp == 0) { _Pragma("unroll") for (int n = 0; n < 2; ++n) _Pragma("unroll") for (int k = 0; k < 2; ++k) { B0[n][k] = (bf16x8){0,0,0,0,0,0,0,0}; B1[n][k] = (bf16x8){0,0,0,0,0,0,0,0}; } } } while (0)
            const char* a3 = a2 + kstep; const char* b3 = b2 + kstep;
            PG8_LDB(B0, 0, 0); PG8_LDB(B1, 0, 1); PG8_SCHED; PG8_LDA(At, 0, 0); PG8_STAGE(PG8_SA(1, 1), a1, vA[1]);
            if (Sched::GATHER) { if (last && has_next) S.a_voff(ui + 1, Rr, Cc, vA); }
            PG8_WAIT_V(8); PG8_WAIT_L(0); PG8_ZB(); PG8_BAR; PG8_MMA(0, 0, At, B0); PG8_MMA(0, 1, At, B1); PG8_BAR; PG8_SCHED;
            if (!hu) PG8_LDA(At, 0, 1); PG8_STAGE(PG8_SB(0, 0), b2, voffB); PG8_STAGE(PG8_SB(0, 1), b2 + hstep, voffB); PG8_STAGE(PG8_SA(0, 0), a2, vA[0]);
            PG8_WAIT_V(8); PG8_WAIT_L(0); PG8_BAR; if (!hu) { PG8_MMA(1, 0, At, B0); PG8_MMA(1, 1, At, B1); } PG8_BAR; PG8_SCHED;
            PG8_LDB(B0, 1, 0); PG8_LDB(B1, 1, 1); PG8_SCHED; PG8_LDA(At, 1, 0); PG8_STAGE(PG8_SA(0, 1), a2, vA[1]);
            PG8_WAIT_V(8); PG8_WAIT_L(0); PG8_ZB(); PG8_BAR; PG8_MMA(0, 0, At, B0); PG8_MMA(0, 1, At, B1); PG8_BAR; PG8_SCHED;
            if (!hu) PG8_LDA(At, 1, 1); PG8_STAGE(PG8_SB(1, 0), b3, voffB); PG8_STAGE(PG8_SB(1, 1), b3 + hstep, voffB); PG8_STAGE(PG8_SA(1, 0), a3, vA[0]);
            PG8_WAIT_V(8); PG8_WAIT_L(0); PG8_BAR; if (!hu) { PG8_MMA(1, 0, At, B0); PG8_MMA(1, 1, At, B1); } PG8_BAR; PG8_SCHED;
        }
        if constexpr (ALIGN_EPI) { if (wr == 0) PG8_BAR; }
        E(acc, cur, wr, wc, fr, fq, ui & 1);
        if (!has_next) break;
#pragma unroll
        for (int a = 0; a < 2; ++a)
#pragma unroll
            for (int b = 0; b < 2; ++b)
#pragma unroll
                for (int m = 0; m < 4; ++m)
#pragma unroll
                    for (int n = 0; n < 2; ++n) acc[a][b][m][n] = (acc_t){0, 0, 0, 0};
        cur = nxt; cA = nA; cB = nB; ++ui;
        if constexpr (ALIGN_EPI) { if (wr == 1) PG8_BAR; }
    }
    PG8_WAIT_V(0);
    if constexpr (!ALIGN_EPI) { if (wr == 0) PG8_BAR; }
    PG8_BAR;
#undef PG8_SA
#undef PG8_ZB
#undef PG8_SB
#undef PG8_STAGE
#undef PG8_LDA
#undef PG8_LDB
#undef PG8_MMA
#undef PG8_WAIT_V
#undef PG8_WAIT_L
#undef PG8_BAR
#undef PG8_SCHED
}
}

constexpr int NWAVES = 8, NTHR = 512;
struct Frame {
    LAS unsigned char* lds;
    int wave, vcu, G;
    const float* in[20]; float* out; unsigned char* ws;
};
struct Args { const float* in[20]; float* out; unsigned char* ws; int ph_lo, ph_hi; };
enum { I_X = 0, I_N1G, I_WIN, I_IGB, I_FGB, I_CONVW, I_HNG, I_POOLW, I_POOLS, I_WOUT, I_N2G, I_WR, I_BR, I_WG, I_BG, I_WU, I_BU, I_WD, I_BD, I_NFG };

#define LDS_WAIT() asm volatile("s_waitcnt lgkmcnt(0)" ::: "memory")

constexpr int QITEMS = NE * 3 * 32;
constexpr int QEXTRA = ((DUP_MASK >> 13) & 1) * 1024;
constexpr int QSTATIC = 0; static_assert(QSTATIC == 0, "the two-queue pull assumes no static share");
__device__ __forceinline__ void quant_item(const Frame& F, const int it, const int par) {
    const int lane = flane();
    signed char* wgu_q = (signed char*)(F.ws + WS_WGU); signed char* wd_q = (signed char*)(F.ws + WS_WD); float* sgu = (float*)(F.ws + WS_SGU); float* sd = (float*)(F.ws + WS_SD);
    LAS float* scr = (LAS float*)(F.lds + F.wave * 12800);
    LAS unsigned* tile = (LAS unsigned*)(F.lds + F.wave * 12800 + 8704);
    LAS float* cmax = (LAS float*)(F.lds + 8 * 12800);
    const int rsub = lane >> 3, cg = lane & 7, nn = lane & 31, kh = lane >> 5, k0 = 128 * F.wave;
    const float* const p_wg = F.in[I_WG]; const float* const p_wu = F.in[I_WU]; const float* const p_wd = F.in[I_WD];
    const int e = it / 96, r2 = it % 96, which = r2 >> 5, nb = r2 & 31;
    const float* mat = (which == 0 ? p_wg : (which == 1 ? p_wu : p_wd)) + (size_t)e * D * FF;
    const __amdgpu_buffer_rsrc_t rsrc = __builtin_amdgcn_make_buffer_rsrc((void*)mat, 0, D * FF * 4, 0x00020000);
    const int voff = ((k0 + rsub) * 1024 + 32 * nb + 4 * cg) * 4;
    f32x4 v[16];
#pragma unroll
    for (int i = 0; i < 16; ++i) v[i] = __builtin_bit_cast(f32x4, __builtin_amdgcn_raw_buffer_load_b128(rsrc, voff, i * 32768, 2  ));
    f32x4 m4 = {0.f, 0.f, 0.f, 0.f};
#pragma unroll
    for (int i = 0; i < 16; ++i) { m4.x = fmaxf(m4.x, fabsf(v[i].x)); m4.y = fmaxf(m4.y, fabsf(v[i].y)); m4.z = fmaxf(m4.z, fabsf(v[i].z)); m4.w = fmaxf(m4.w, fabsf(v[i].w)); }
#pragma unroll
    for (int o = 8; o < 64; o <<= 1) { m4.x = fmaxf(m4.x, __shfl_xor(m4.x, o)); m4.y = fmaxf(m4.y, __shfl_xor(m4.y, o)); m4.z = fmaxf(m4.z, __shfl_xor(m4.z, o)); m4.w = fmaxf(m4.w, __shfl_xor(m4.w, o)); }
    if (rsub == 0) *(LAS f32x4*)(cmax + (par * 8 + F.wave) * 32 + 4 * cg) = m4;
    __syncthreads();
    float M = 0.f;
#pragma unroll
    for (int w = 0; w < 8; ++w) M = fmaxf(M, cmax[(par * 8 + w) * 32 + nn]);
    const float inv = M > 0.f ? 127.0f / M : 0.f;
    { const int col = 32 * nb + nn, rowi = (which == 2) ? col : 256 * (col >> 7) + 128 * which + (col & 127);
      if (F.wave == 0 && kh == 0) { if (which == 2) sd[e * D + rowi] = M > 0.f ? M * (1.0f / 127.0f) : 1.0f; else sgu[e * 2048 + rowi] = M > 0.f ? M * (1.0f / 127.0f) : 1.0f; } }
#pragma unroll
    for (int half = 0; half < 2; ++half) {
#pragma unroll
        for (int i = 0; i < 8; ++i) { LAS float* d = scr + (8 * i + rsub) * 33 + 4 * cg; const f32x4 x = v[8 * half + i]; d[0] = x.x; d[1] = x.y; d[2] = x.z; d[3] = x.w; }
        LDS_WAIT(); asm volatile("" ::: "memory");
#pragma unroll
        for (int j = 0; j < 8; ++j) { const LAS float* sp = scr + (32 * kh + 4 * j) * 33 + nn;
            const unsigned w = pg8::q4(sp[0] * inv, sp[33] * inv, sp[66] * inv, sp[99] * inv);
            const int word = 16 * half + 8 * kh + j; tile[nn * 32 + (word ^ nn)] = w; }
        LDS_WAIT(); asm volatile("" ::: "memory");
    }
    signed char* dst = (which == 2) ? wd_q + (size_t)e * D * 1024 : wgu_q + (size_t)e * 2048 * 1024;
#pragma unroll
    for (int pss = 0; pss < 4; ++pss) { const int n = pss * 8 + (lane >> 3), j4 = lane & 7; u32x4 w;
        w.x = tile[n * 32 + ((4 * j4 + 0) ^ n)]; w.y = tile[n * 32 + ((4 * j4 + 1) ^ n)]; w.z = tile[n * 32 + ((4 * j4 + 2) ^ n)]; w.w = tile[n * 32 + ((4 * j4 + 3) ^ n)];
        const int coln = 32 * nb + n, rown = (which == 2) ? coln : 256 * (coln >> 7) + 128 * which + (coln & 127);
        *(u32x4*)(dst + (size_t)rown * 1024 + k0 + 16 * j4) = w; }
    LDS_WAIT(); asm volatile("" ::: "memory");
}
__device__ __forceinline__ bool quant_pull(const Frame& F, const int par, const int nq) {
    LAS unsigned* qw = (LAS unsigned*)(F.lds + LDS_BARW) + 2;
    if (F.wave == 0 && flane() == 0) { unsigned* qh = (unsigned*)(F.ws + WS_CTL) + CW_QHEAD;
        unsigned q = (unsigned)atomicAdd(qh, 1u), it = 0xffffffffu;
        if (q < (unsigned)(NE * 64 + QEXTRA)) { q %= (unsigned)(NE * 64); it = (q >> 6) * 96u + (q & 63u); }
        else if (nq > 1) { q = (unsigned)atomicAdd(qh + 64, 1u); if (q < (unsigned)(NE * 32)) it = (q >> 5) * 96u + 64u + (q & 31u); }
        qw[par] = it; }
    __syncthreads();
    const unsigned it = qw[par];
    if (it == 0xffffffffu) return false;
    quant_item(F, (int)it, par);
    return true;
}
__device__ __forceinline__ void xcd_barrier_fill(const XcdBarrier& b, const Frame& F) {
    asm volatile("s_waitcnt vmcnt(0)" ::: "memory");
    __syncthreads();
    LAS unsigned* st = (LAS unsigned*)(F.lds + LDS_BARW);
    const bool t0 = (F.wave == 0 && flane() == 0);
    if (t0) {
        unsigned* bar = b.bar;
        __builtin_amdgcn_s_waitcnt(0);
        unsigned nloc = b.st[0], nx = b.st[1];
        if (nloc == 0u) { xcd_barrier_complete(bar, b.x, nloc, nx); b.st[0] = nloc; b.st[1] = nx; }
        const unsigned old = xb_add(&bar[XB_XSUB(b.x)], 1u);
        const unsigned gen = old / nloc;
        if (old + 1u == (gen + 1u) * nloc) {
            __builtin_amdgcn_fence(__ATOMIC_RELEASE, "agent");
            asm volatile("s_waitcnt vmcnt(0)" ::: "memory");
            const unsigned og = xb_add(&bar[XB_TOP], 1u);
            const unsigned tg = og / nx;
            if (og + 1u == (tg + 1u) * nx) xb_add(&bar[XB_TOPGEN], 1u);
            else XB_SPIN(xb_ld(&bar[XB_TOPGEN]) == tg, bar);
            __builtin_amdgcn_fence(__ATOMIC_ACQUIRE, "agent");
            xb_add(&bar[XB_XGEN(b.x)], 1u);
            asm volatile("s_waitcnt vmcnt(0)" ::: "memory");
            st[2] = 0xffffffffu;
        } else { st[2] = 0u; st[3] = gen; }
    }
    __syncthreads();
    if (st[2] != 0xffffffffu) {
        const unsigned gen = st[3];
        LAS unsigned* rw = (LAS unsigned*)(F.lds + LDS_BARW + 32);
        __syncthreads();
        int par = 0;
        for (;;) {
            if (t0) rw[par] = (xb_ld(&b.bar[XB_XGEN(b.x)]) != gen) ? 1u : 0u;
            __syncthreads();
            if (rw[par]) break;
            if (!quant_pull(F, par, 2)) { if (t0) XB_SPIN(xb_ld(&b.bar[XB_XGEN(b.x)]) == gen, b.bar); break; }
            par ^= 1;
        }
        if (t0) { __builtin_amdgcn_fence(__ATOMIC_ACQUIRE, "agent"); asm volatile("s_waitcnt vmcnt(0)" ::: "memory"); }
    }
    __syncthreads();
}

__device__ __forceinline__ void p0_item_load(const float* __restrict__ W, int ldw, int col0, int k0, int lane, float (&wv)[32]) {
#pragma unroll
    for (int i = 0; i < 32; ++i) wv[i] = W[(size_t)(k0 + 2 * i + (lane >> 5)) * ldw + col0 + (lane & 31)];
}
__device__ __forceinline__ void p0_item_finish(const float (&wv)[32], const float* __restrict__ gk, bf16_t* wt, int k0, LAS float* scr, int lane) {
    const int c = lane & 7;
    f32x4 g0 = {1.f, 1.f, 1.f, 1.f}, g1 = {1.f, 1.f, 1.f, 1.f};
    if (gk) { g0 = *(const f32x4*)(gk + k0 + 8 * c); g1 = *(const f32x4*)(gk + k0 + 8 * c + 4); }
#pragma unroll
    for (int i = 0; i < 32; ++i) scr[(2 * i + (lane >> 5)) * 33 + (lane & 31)] = wv[i];
    LDS_WAIT(); asm volatile("" ::: "memory");
#pragma unroll
    for (int j = 0; j < 4; ++j) { const int n = (lane >> 3) + 8 * j; const LAS float* sp = scr + (8 * c) * 33 + n;
        u32x4 o; o.x = cvt_pk_bf16(sp[0 * 33] * g0.x, sp[1 * 33] * g0.y); o.y = cvt_pk_bf16(sp[2 * 33] * g0.z, sp[3 * 33] * g0.w); o.z = cvt_pk_bf16(sp[4 * 33] * g1.x, sp[5 * 33] * g1.y); o.w = cvt_pk_bf16(sp[6 * 33] * g1.z, sp[7 * 33] * g1.w);
        *(u32x4*)(wt + (size_t)n * 1024 + k0 + 8 * c) = o; }
    LDS_WAIT(); asm volatile("" ::: "memory");
}
#define P0_ITEM_OF(it_, W_, gk_, wt_, ldw_, col0_, k0_) \
    const bool in_ = (it_) < 16 * (NP / 32); const int q_ = in_ ? (it_) : (it_) - 16 * (NP / 32), nbk_ = in_ ? (NP / 32) : 32, kb_ = q_ / nbk_, nb_ = q_ % nbk_, n0_ = 32 * nb_; \
    const float* W_ = in_ ? p_win : p_wout; const float* gk_ = in_ ? p_g : nullptr; bf16_t* wt_ = (in_ ? win_t : wout_t) + (size_t)n0_ * 1024; \
    const int ldw_ = in_ ? NIN : D, col0_ = (in_ && n0_ >= 2048) ? n0_ + 8 : n0_, k0_ = 64 * kb_
__device__ __forceinline__ void phase0(Frame& F) {
    const int lane = flane(), tid = F.wave * 64 + lane;
    const int gw = F.vcu * NWAVES + F.wave, NGW = F.G * NWAVES;
    constexpr int NITEMS = 16 * (NP / 32) + 16 * 32;
    const int pi = blockIdx.x * NTHR + tid; float pwv = 0.f; const float* pw = F.in[I_POOLW];
    if (pi < 4 * 128 * 128) { const int g = pi >> 14, d = (pi >> 7) & 127, cc = pi & 127; pwv = pw[(g * 128 + cc) * 128 + d]; }
    const float* const p_win = F.in[I_WIN]; const float* const p_wout = F.in[I_WOUT]; const float* const p_g = F.in[I_N1G];
    bf16_t* const win_t = (bf16_t*)(F.ws + WS_WIN); bf16_t* const wout_t = (bf16_t*)(F.ws + WS_WOUT);
    float wv[32]; const bool have_item = gw < NITEMS; const int it_first = have_item ? gw : 0;
    P0_ITEM_OF(it_first, iW, igk, iwt, ildw, icol0, ik0);
    if (have_item) p0_item_load(iW, ildw, icol0, ik0, lane, wv);
    {
        LAS float* wgl = (LAS float*)(F.lds + 98304);
        const float* w_in = F.in[I_WIN]; const float* g1 = F.in[I_N1G];
        { float gwv[2][8], gg[2];
#pragma unroll
          for (int t = 0; t < 2; ++t) { const int sidx = tid + t * NTHR, j = sidx >> 8, q = (sidx >> 6) & 3, l = sidx & 63, k = 256 * j + 4 * l + q; gg[t] = g1[k];
#pragma unroll
              for (int i = 0; i < 8; ++i) gwv[t][i] = w_in[(size_t)k * NIN + 2048 + i]; }
#pragma unroll
          for (int t = 0; t < 2; ++t)
#pragma unroll
              for (int i = 0; i < 8; ++i) wgl[(tid + t * NTHR) * 8 + i] = gwv[t][i] * gg[t]; }
        __syncthreads();
        bf16_t* xb = (bf16_t*)(F.ws + WS_XB); float* rs1 = (float*)(F.ws + WS_RS1); float* gates = (float*)(F.ws + WS_GATES);
        const float* x = F.in[I_X];
        f32x4 nx[4];
        if (gw < T) { const f32x4* xr = (const f32x4*)(x + (size_t)gw * D) + lane;
#pragma unroll
            for (int j = 0; j < 4; ++j) nx[j] = xr[64 * j]; }
        for (int row = gw; row < T; row += NGW) {
            f32x4 v[4]; float ss = 0.f; float ga[8];
#pragma unroll
            for (int j = 0; j < 4; ++j) v[j] = nx[j];
            if (row + NGW < T) { const f32x4* xr = (const f32x4*)(x + (size_t)(row + NGW) * D) + lane;
#pragma unroll
                for (int j = 0; j < 4; ++j) nx[j] = xr[64 * j]; }
#pragma unroll
            for (int i = 0; i < 8; ++i) ga[i] = 0.f;
#pragma unroll
            for (int j = 0; j < 4; ++j) ss += (v[j].x * v[j].x + v[j].y * v[j].y) + (v[j].z * v[j].z + v[j].w * v[j].w);
#pragma unroll
            for (int j = 0; j < 4; ++j)
#pragma unroll
                for (int q = 0; q < 4; ++q) { const LAS f32x4* wp = (const LAS f32x4*)(wgl + (256 * j + 64 * q + lane) * 8); const f32x4 w0 = wp[0], w1 = wp[1]; const float xv = v[j][q];
                    ga[0] += xv * w0.x; ga[1] += xv * w0.y; ga[2] += xv * w0.z; ga[3] += xv * w0.w; ga[4] += xv * w1.x; ga[5] += xv * w1.y; ga[6] += xv * w1.z; ga[7] += xv * w1.w; }
            const float rs = rsqrtf(wave_sum(ss) * (1.f / D) + EPS);
            float mine = 0.f;
#pragma unroll
            for (int i = 0; i < 8; ++i) { const float sm = wave_sum(ga[i]); mine = (lane == i) ? sm : mine; }
            if (lane < 8) gates[(size_t)row * 8 + lane] = mine * rs;
            if (lane == 0) rs1[row] = rs;
            u32x2* o8 = (u32x2*)(xb + (size_t)row * D) + lane;
#pragma unroll
            for (int j = 0; j < 4; ++j) { u32x2 o; o.x = cvt_pk_bf16(v[j].x, v[j].y); o.y = cvt_pk_bf16(v[j].z, v[j].w); o8[64 * j] = o; }
        }
    }
    {
        LAS float* scr = (LAS float*)(F.lds + F.wave * 8704);
        if (have_item) p0_item_finish(wv, igk, iwt, ik0, scr, lane);
        for (int it = gw + NGW; it < NITEMS; it += NGW) { P0_ITEM_OF(it, tW, tgk, twt, tldw, tcol0, tk0); p0_item_load(tW, tldw, tcol0, tk0, lane, wv); p0_item_finish(wv, tgk, twt, tk0, scr, lane); }
    }
    if (pi < 4 * 128 * 128) { bf16_t* pwt = (bf16_t*)(F.ws + WS_POOLWT); pwt[pi] = (bf16_t)(cvt_pk_bf16(pwv, 0.f) & 0xffffu); }
    for (int i = pi + F.G * NTHR; i < 4 * 128 * 128; i += F.G * NTHR) { const int g = i >> 14, d = (i >> 7) & 127, cc = i & 127; ((bf16_t*)(F.ws + WS_POOLWT))[i] = (bf16_t)(cvt_pk_bf16(pw[(g * 128 + cc) * 128 + d], 0.f) & 0xffffu); }
    __syncthreads();
#pragma unroll 1
    for (int j = 0; j < QSTATIC * (1 + (DUP_MASK & 1)); ++j) quant_item(F, F.vcu + (j % (QSTATIC > 0 ? QSTATIC : 1)) * F.G, j & 1);
}

typedef short s16x4 __attribute__((ext_vector_type(4)));
typedef float f32x16 __attribute__((ext_vector_type(16)));
typedef float f32x8 __attribute__((ext_vector_type(8)));
typedef float f32x2 __attribute__((ext_vector_type(2)));
typedef __bf16 bfv8 __attribute__((ext_vector_type(8)));
typedef __bf16 bfv2 __attribute__((ext_vector_type(2)));
#define MFMA32(a, b, c) __builtin_amdgcn_mfma_f32_32x32x16_bf16((a), (b), (c), 0, 0, 0)
__device__ __forceinline__ bf16x8 pack8(float a0, float a1, float a2, float a3, float a4, float a5, float a6, float a7) {
    const f32x8 f = {a0, a1, a2, a3, a4, a5, a6, a7}; return __builtin_bit_cast(bf16x8, __builtin_convertvector(f, bfv8)); }
__device__ __forceinline__ unsigned pack2(float a, float b) { const f32x2 f = {a, b}; return __builtin_bit_cast(unsigned, __builtin_convertvector(f, bfv2)); }
__device__ __forceinline__ unsigned img_off(unsigned row, unsigned ch) { return 256u * row + 16u * (ch ^ (((row & 3u) << 2) | ((row >> 2) & 3u))); }
__device__ __forceinline__ bf16x8 img_rr(const LAS unsigned char* img, unsigned row0, unsigned lane, unsigned s) { return *(const LAS bf16x8*)(img + img_off(row0 + (lane & 31u), 2u * s + (lane >> 5))); }
__device__ __forceinline__ bf16x8 img_trn(const LAS unsigned char* img, unsigned k0, unsigned lane, unsigned c) {
    const unsigned h = lane >> 5, blk = (lane >> 4) & 1u, q = (lane & 15u) >> 2, p = lane & 3u, ch = 4u * c + 2u * blk + (p >> 1), sub = 8u * (p & 1u);
    const s16x4 lo = __builtin_amdgcn_ds_read_tr16_b64_v4i16((LAS s16x4*)(img + img_off(k0 + 8u * h + q, ch) + sub));
    const s16x4 hi = __builtin_amdgcn_ds_read_tr16_b64_v4i16((LAS s16x4*)(img + img_off(k0 + 8u * h + 4u + q, ch) + sub));
    return __builtin_shufflevector(lo, hi, 0, 1, 2, 3, 4, 5, 6, 7); }
__device__ __forceinline__ bf16x8 img_trp(const LAS unsigned char* img, unsigned k0, unsigned lane, unsigned c) {
    const unsigned h = lane >> 5, blk = (lane >> 4) & 1u, q = (lane & 15u) >> 2, p = lane & 3u, ch = 4u * c + 2u * blk + (p >> 1), sub = 8u * (p & 1u);
    const s16x4 lo = __builtin_amdgcn_ds_read_tr16_b64_v4i16((LAS s16x4*)(img + img_off(k0 + 4u * h + q, ch) + sub));
    const s16x4 hi = __builtin_amdgcn_ds_read_tr16_b64_v4i16((LAS s16x4*)(img + img_off(k0 + 8u + 4u * h + q, ch) + sub));
    return __builtin_shufflevector(lo, hi, 0, 1, 2, 3, 4, 5, 6, 7); }
__device__ __forceinline__ float wave_scan_add(float v, int) {
    v += dpp_old<0x111, 0xF>(0.f, v); v += dpp_old<0x112, 0xF>(0.f, v); v += dpp_old<0x114, 0xF>(0.f, v); v += dpp_old<0x118, 0xF>(0.f, v);
    v += dpp_old<0x142, 0xA>(0.f, v); v += dpp_old<0x143, 0xC>(0.f, v);
    return v; }
__device__ __forceinline__ float wave_scan_max(float v, int) {
    constexpr float NI = -3.0e38f;
    v = fmaxf(v, dpp_old<0x111, 0xF>(NI, v)); v = fmaxf(v, dpp_old<0x112, 0xF>(NI, v)); v = fmaxf(v, dpp_old<0x114, 0xF>(NI, v)); v = fmaxf(v, dpp_old<0x118, 0xF>(NI, v));
    v = fmaxf(v, dpp_old<0x142, 0xA>(NI, v)); v = fmaxf(v, dpp_old<0x143, 0xC>(NI, v));
    return v; }
__device__ __forceinline__ float wave_max(float v) {
    v = fmaxf(v, dpp_mov<0xB1>(v)); v = fmaxf(v, dpp_mov<0x4E>(v)); v = fmaxf(v, dpp_mov<0x141>(v)); v = fmaxf(v, dpp_mov<0x140>(v));
    return fmaxf(fmaxf(lane_bcast(v, 0), lane_bcast(v, 16)), fmaxf(lane_bcast(v, 32), lane_bcast(v, 48))); }
__device__ __forceinline__ void unpack8(const u32x4 w, float (&f)[8]) { f[0] = bflo(w.x); f[1] = bfhi(w.x); f[2] = bflo(w.y); f[3] = bfhi(w.y); f[4] = bflo(w.z); f[5] = bfhi(w.z); f[6] = bflo(w.w); f[7] = bfhi(w.w); }
__device__ __forceinline__ void conv2rows(const u32x4 (&pre)[5], const float (&cw)[4][8], float (&out)[2][8]) {
    float pf[5][8];
#pragma unroll
    for (int i = 0; i < 5; ++i) unpack8(pre[i], pf[i]);
#pragma unroll
    for (int rr = 0; rr < 2; ++rr)
#pragma unroll
        for (int e = 0; e < 8; ++e) { float a = 0.f;
#pragma unroll
            for (int j = 0; j < 4; ++j) a += pf[rr + j][e] * cw[j][e];
            out[rr][e] = a * fast_sigmoid(a); }
}
__device__ __forceinline__ void load_pre5(const bf16_t* __restrict__ P, int tok0, int c, int l0, int col, u32x4 (&pre)[5]) {
#pragma unroll
    for (int i = 0; i < 5; ++i) { const int l = l0 - 3 + i; pre[i] = (c * 64 + l >= 0) ? *(const u32x4*)(P + (size_t)(tok0 + l) * NP + col) : (u32x4){0u, 0u, 0u, 0u}; }
}
__device__ __forceinline__ void load_cw(const float* __restrict__ conv_w, int ch, float (&cw)[4][8]) {
#pragma unroll
    for (int j = 0; j < 4; ++j) { const f32x4 a = *(const f32x4*)(conv_w + j * 1024 + ch), b = *(const f32x4*)(conv_w + j * 1024 + ch + 4);
        cw[j][0] = a.x; cw[j][1] = a.y; cw[j][2] = a.z; cw[j][3] = a.w; cw[j][4] = b.x; cw[j][5] = b.y; cw[j][6] = b.z; cw[j][7] = b.w; }
}
constexpr float KSCALE = 0.08838834764831845f;

__device__ __forceinline__ void phase2_group(Frame& F) {
    const bf16_t* P = (const bf16_t*)(F.ws + WS_P); const float* gates = (const float*)(F.ws + WS_GATES); const float* conv_w = F.in[I_CONVW];
    u32x4* Cloc = (u32x4*)(F.ws + WS_CST); u32x4* Ctot = (u32x4*)(F.ws + WS_CIN); float* nst = (float*)(F.ws + WS_NST); float* mloc = (float*)(F.ws + WS_MLOC); float* btot = (float*)(F.ws + WS_BTOT);
    float* ntot = (float*)(F.ws + WS_NIN); float* mgrp = (float*)(F.ws + WS_MIN);
    LAS unsigned char* IMG_WK = F.lds; LAS unsigned char* IMG_V = F.lds + 16384; LAS float* s_w = (LAS float*)(F.lds + 32768);
    const int lane = flane(), wave = F.wave, tid = wave * 64 + lane, d8 = tid & 15, lq = tid >> 4, l0 = 2 * lq;
    u32x4 pre[5], vv[2]; float g_i = 0.f, g_f = 0.f;
#define P2_LOAD(uu) do { const int c_ = (uu) & 63, h_ = ((uu) >> 6) & 3, b_ = (uu) >> 8, tok0_ = b_ * SEQ + c_ * 64; \
        load_pre5(P, tok0_, c_, l0, 512 + h_ * 128 + 8 * d8, pre); \
        _Pragma("unroll") for (int rr = 0; rr < 2; ++rr) vv[rr] = *(const u32x4*)(P + (size_t)(tok0_ + l0 + rr) * NP + PC_V + h_ * 128 + 8 * d8); \
        if (wave == 0) { const float* pr_ = gates + (size_t)(tok0_ + lane) * 8; g_i = pr_[h_]; g_f = pr_[4 + h_]; } } while (0)
    for (int up = blockIdx.x; up < 256; up += F.G) {
        const int u0 = (up >> 4) * 64 + 4 * (up & 15), h = (up >> 4) & 3;
        P2_LOAD(u0);
        float cw[4][8]; load_cw(conv_w, 512 + h * 128 + 8 * d8, cw);
        const int a = wave >> 1, b0 = 2 * (wave & 1), r = lane & 31, hh = lane >> 5;
        f32x16 ct0, ct1, cn;
#pragma unroll
        for (int i = 0; i < 16; ++i) { ct0[i] = 0.f; ct1[i] = 0.f; cn[i] = 0.f; }
        float mg = -1e30f, Bg = 0.f;
#pragma unroll 1
        for (int cc = 0; cc < 4; ++cc) {
            const int u = u0 + cc;
            LAS float* sw = s_w + 128 * (cc & 1);
            if (wave == 0) { const float ig = g_i + F.in[I_IGB][h]; const float lf = logsigmoidf_(g_f + F.in[I_FGB][h]);
                const float bb = wave_scan_add(lf, lane); const float bt = lane_bcast(bb, 63); const float g = bt - bb + ig; const float m = wave_max(g);
                sw[lane] = expf(g - m); if (lane == 0) { mloc[u] = m; btot[u] = bt; sw[64] = m; sw[65] = bt; } }
            __syncthreads();
            const float ml = sw[64], bt = sw[65];
            { float kc[2][8]; conv2rows(pre, cw, kc);
#pragma unroll
              for (int rr = 0; rr < 2; ++rr) { const float w = sw[l0 + rr] * KSCALE;
                  *(LAS bf16x8*)(IMG_WK + img_off(l0 + rr, d8)) = pack8(kc[rr][0] * w, kc[rr][1] * w, kc[rr][2] * w, kc[rr][3] * w, kc[rr][4] * w, kc[rr][5] * w, kc[rr][6] * w, kc[rr][7] * w);
                  *(LAS u32x4*)(IMG_V + img_off(l0 + rr, d8)) = vv[rr]; } }
            __syncthreads();
            if (cc < 3) P2_LOAD(u + 1);
            f32x16 acc0, acc1, accn;
#pragma unroll
            for (int i = 0; i < 16; ++i) { acc0[i] = 0.f; acc1[i] = 0.f; accn[i] = 0.f; }
            const bf16x8 ones = {(short)0x3F80, (short)0x3F80, (short)0x3F80, (short)0x3F80, (short)0x3F80, (short)0x3F80, (short)0x3F80, (short)0x3F80};
#pragma unroll
            for (int ks = 0; ks < 4; ++ks) { const bf16x8 A = img_trn(IMG_WK, 16 * ks, lane, a);
                acc0 = MFMA32(A, img_trn(IMG_V, 16 * ks, lane, b0), acc0); acc1 = MFMA32(A, img_trn(IMG_V, 16 * ks, lane, b0 + 1), acc1);
                if (b0 == 0) accn = MFMA32(A, ones, accn); }
            if (b0 == 0 && r == 0) {
#pragma unroll
                for (int i = 0; i < 16; ++i) nst[(size_t)u * 128 + 32 * a + (i & 3) + 8 * (i >> 2) + 4 * hh] = accn[i]; }
            { u32x4* dst = Cloc + ((size_t)u * 8 + wave) * 256 + lane;
#pragma unroll
              for (int q = 0; q < 2; ++q) {
                  dst[q * 64] = (u32x4){pack2(acc0[8 * q], acc0[8 * q + 1]), pack2(acc0[8 * q + 2], acc0[8 * q + 3]), pack2(acc0[8 * q + 4], acc0[8 * q + 5]), pack2(acc0[8 * q + 6], acc0[8 * q + 7])};
                  dst[(2 + q) * 64] = (u32x4){pack2(acc1[8 * q], acc1[8 * q + 1]), pack2(acc1[8 * q + 2], acc1[8 * q + 3]), pack2(acc1[8 * q + 4], acc1[8 * q + 5]), pack2(acc1[8 * q + 6], acc1[8 * q + 7])}; } }
            { const float mn = fmaxf(bt + mg, ml), so = __expf(bt + mg - mn), sl = __expf(ml - mn);
#pragma unroll
              for (int i = 0; i < 16; ++i) { ct0[i] = so * ct0[i] + sl * acc0[i]; ct1[i] = so * ct1[i] + sl * acc1[i]; cn[i] = so * cn[i] + sl * accn[i]; }
              mg = mn; Bg += bt; }
        }
        { u32x4* dst = Ctot + ((size_t)up * 8 + wave) * 256 + lane;
#pragma unroll
          for (int q = 0; q < 2; ++q) {
              dst[q * 64] = (u32x4){pack2(ct0[8 * q], ct0[8 * q + 1]), pack2(ct0[8 * q + 2], ct0[8 * q + 3]), pack2(ct0[8 * q + 4], ct0[8 * q + 5]), pack2(ct0[8 * q + 6], ct0[8 * q + 7])};
              dst[(2 + q) * 64] = (u32x4){pack2(ct1[8 * q], ct1[8 * q + 1]), pack2(ct1[8 * q + 2], ct1[8 * q + 3]), pack2(ct1[8 * q + 4], ct1[8 * q + 5]), pack2(ct1[8 * q + 6], ct1[8 * q + 7])}; } }
        if (b0 == 0 && r == 0) {
#pragma unroll
            for (int i = 0; i < 16; ++i) ntot[(size_t)up * 128 + 32 * a + (i & 3) + 8 * (i >> 2) + 4 * hh] = cn[i]; }
        if (tid == 0) { mgrp[up] = mg; mgrp[256 + up] = Bg; }
        __syncthreads();
    }
#undef P2_LOAD
}
__device__ __forceinline__ void phase2_pool(Frame& F) {
    const bf16_t* P = (const bf16_t*)(F.ws + WS_P); bf16_t* ycat = (bf16_t*)(F.ws + WS_YCAT); const bf16_t* pwt = (const bf16_t*)(F.ws + WS_POOLWT); const float* pool_scale = F.in[I_POOLS];
    LAS unsigned char* IMG_PL = F.lds; LAS unsigned char* IMG_PW = F.lds + 16384; LAS unsigned char* STG = F.lds + 49152;
    const int lane = flane(), wave = F.wave, tid = wave * 64 + lane, d8 = tid & 15, lq = tid >> 4, l0 = 2 * lq;
    for (int u = blockIdx.x; u < 1024; u += F.G) {
        const int tok0 = (u >> 2) * 64, gi = u & 3, w = 2 << gi;
#pragma unroll
        for (int i = 0; i < 4; ++i) { const int idx = tid + i * NTHR, d = idx >> 4, j = idx & 15;
            *(LAS u32x4*)(IMG_PW + img_off(d, j)) = *(const u32x4*)(pwt + ((size_t)gi * 128 + d) * 128 + j * 8); }
        {
            const int s1 = ((tok0 + l0 + 1) & (SEQ - 1));
            const bf16_t* base = P + (size_t)(tok0 + l0 + 1) * NP + PC_U + gi * 128 + 8 * d8;
            u32x4 rw[17];
#pragma unroll
            for (int j = 0; j < 17; ++j) { int jj = j < w ? j : w; jj = jj < s1 ? jj : s1; rw[j] = *(const u32x4*)(base - (size_t)jj * NP); }
            float sum[8], cur0[8], cur1[8], old[8], f[8];
#pragma unroll
            for (int e = 0; e < 8; ++e) sum[e] = 0.f;
#pragma unroll
            for (int j = 2; j < 16; ++j) { const bool on = (j < w) && (s1 - j >= 0); unpack8(rw[j], f);
#pragma unroll
                for (int e = 0; e < 8; ++e) sum[e] += on ? f[e] : 0.f; }
            unpack8(rw[1], cur0); unpack8(rw[0], cur1);
            { const u32x4 ro = (w == 2) ? rw[2] : ((w == 4) ? rw[4] : ((w == 8) ? rw[8] : rw[16])); unpack8(ro, old); const bool on = (s1 - w >= 0);
#pragma unroll
              for (int e = 0; e < 8; ++e) old[e] = on ? old[e] : 0.f; }
            const int s0 = s1 - 1; const float ic0 = 1.f / (float)((s0 + 1 < w) ? s0 + 1 : w), ic1 = 1.f / (float)((s1 + 1 < w) ? s1 + 1 : w);
            float p0[8], p1[8];
#pragma unroll
            for (int e = 0; e < 8; ++e) { const float mid = sum[e] + cur0[e];
                p0[e] = (mid + old[e]) * ic0 - cur0[e]; p1[e] = (mid + cur1[e]) * ic1 - cur1[e]; }
            *(LAS bf16x8*)(IMG_PL + img_off(l0, d8)) = pack8(p0[0], p0[1], p0[2], p0[3], p0[4], p0[5], p0[6], p0[7]);
            *(LAS bf16x8*)(IMG_PL + img_off(l0 + 1, d8)) = pack8(p1[0], p1[1], p1[2], p1[3], p1[4], p1[5], p1[6], p1[7]);
        }
        __syncthreads();
        { const int wi = wave >> 2, wj = wave & 3, r = lane & 31, hh = lane >> 5;
          f32x16 acc;
#pragma unroll
          for (int i = 0; i < 16; ++i) acc[i] = 0.f;
#pragma unroll
          for (int sx = 0; sx < 8; ++sx) acc = MFMA32(img_rr(IMG_PL, 32 * wi, lane, sx), img_rr(IMG_PW, 32 * wj, lane, sx), acc);
          const int d = 32 * wj + r; const float sc = pool_scale[gi * 128 + d];
#pragma unroll
          for (int i = 0; i < 16; ++i) { const int l = 32 * wi + (i & 3) + 8 * (i >> 2) + 4 * hh;
              *(LAS unsigned short*)(STG + l * 256 + 2 * (d ^ ((l & 15) << 3))) = (unsigned short)(pack2(acc[i] * sc, 0.f) & 0xffffu); } }
        __syncthreads();
#pragma unroll
        for (int i = 0; i < 2; ++i) { const int idx = tid + i * NTHR, l = idx >> 4, j = idx & 15;
            *(u32x4*)(ycat + (size_t)(tok0 + l) * D + 512 + gi * 128 + j * 8) = *(const LAS u32x4*)(STG + l * 256 + ((j ^ (l & 15)) << 4)); }
        __syncthreads();
    }
}
__device__ __forceinline__ void state_axpy(f32x16& C0, f32x16& C1, const float so, const float sl, const u32x4 (&t)[4]) {
#pragma unroll
    for (int q = 0; q < 2; ++q) { float f[8]; unpack8(t[q], f);
#pragma unroll
        for (int e = 0; e < 8; ++e) C0[8 * q + e] = so * C0[8 * q + e] + sl * f[e];
        unpack8(t[2 + q], f);
#pragma unroll
        for (int e = 0; e < 8; ++e) C1[8 * q + e] = so * C1[8 * q + e] + sl * f[e]; }
}
__device__ __forceinline__ void phase4_group(Frame& F) {
    const bf16_t* P = (const bf16_t*)(F.ws + WS_P); const float* gates = (const float*)(F.ws + WS_GATES); const float* conv_w = F.in[I_CONVW]; const float* head_norm_g = F.in[I_HNG];
    const u32x4* Cloc = (const u32x4*)(F.ws + WS_CST); const u32x4* Ctot = (const u32x4*)(F.ws + WS_CIN); const float* nst = (const float*)(F.ws + WS_NST);
    const float* mloc = (const float*)(F.ws + WS_MLOC); const float* btot = (const float*)(F.ws + WS_BTOT); const float* ntot = (const float*)(F.ws + WS_NIN); const float* mgrp = (const float*)(F.ws + WS_MIN);
    bf16_t* ycat = (bf16_t*)(F.ws + WS_YCAT);
    LAS unsigned char* IMG_Q = F.lds; LAS unsigned char* IMG_K = F.lds + 16384; LAS unsigned char* IMG_V = F.lds + 32768; LAS unsigned char* IMG_C = F.lds + 49152;
    LAS float* HB = (LAS float*)(F.lds + 81920);
    LAS unsigned char* RAWQ = F.lds + 115712; LAS unsigned char* RAWK = RAWQ + 17408;
    LAS float* s_c = (LAS float*)(F.lds + 150528); LAS float* s_M = s_c + 64; LAS float* s_int = s_M + 64; LAS float* s_edn = s_int + 64; LAS float* s_qn = s_edn + 64; LAS float* s_rd = s_qn + 64;
    LAS float* s_n = s_rd + 256;
    const int lane = flane(), wave = F.wave, tid = wave * 64 + lane, d8 = tid & 15, lq = tid >> 4, l0 = 2 * lq;
#define P4_DMA_RAW(uu) do { const int c_ = (uu) & 63, h_ = ((uu) >> 6) & 3, b_ = (uu) >> 8, tok0_ = b_ * SEQ + c_ * 64; \
        _Pragma("unroll") for (int i = 0; i < 3; ++i) { const int pc = 8 * i + wave; if (pc < 17) { const int rr_ = pc * 4 + (lane >> 4); int tk = tok0_ - 3 + rr_; tk = tk < 0 ? 0 : (tk > T - 1 ? T - 1 : tk); \
            const char* src_ = (const char*)(P + (size_t)tk * NP + h_ * 128) + (lane & 15) * 16; \
            __builtin_amdgcn_global_load_lds((const unsigned*)src_, (LAS unsigned*)(RAWQ + pc * 1024), 16, 0, 0); \
            __builtin_amdgcn_global_load_lds((const unsigned*)(src_ + 1024), (LAS unsigned*)(RAWK + pc * 1024), 16, 0, 0); } } } while (0)
#define P4_DMA_V(uu) do { const int c_ = (uu) & 63, h_ = ((uu) >> 6) & 3, b_ = (uu) >> 8, tok0_ = b_ * SEQ + c_ * 64; const unsigned ol_ = (unsigned)olane(); \
        _Pragma("unroll") for (int i = 0; i < 2; ++i) { const unsigned d = (unsigned)((8 * i + wave) * 64) + ol_, row = d >> 4, sl = d & 15u, j = sl ^ (((row & 3u) << 2) | ((row >> 2) & 3u)); \
            __builtin_amdgcn_global_load_lds((const unsigned*)((const char*)(P + (size_t)(tok0_ + row) * NP + PC_V + h_ * 128) + j * 16), (LAS unsigned*)(IMG_V + (8 * i + wave) * 1024), 16, 0, 0); } } while (0)
    float g_i = 0.f, g_f = 0.f;
#define P4_GATES(uu) do { if (wave == 0) { const int c_ = (uu) & 63, h_ = ((uu) >> 6) & 3, b_ = (uu) >> 8; const float* pr_ = gates + (size_t)(b_ * SEQ + c_ * 64 + lane) * 8; g_i = pr_[h_]; g_f = pr_[4 + h_]; } } while (0)
    const int ca = wave >> 1, cb0 = 2 * (wave & 1), cr = lane & 31, chh = lane >> 5;
    {
        const int up = blockIdx.x; const int bh = up >> 4, g = up & 15, h = bh & 3, b = bh >> 2, u0 = bh * 64 + 4 * g;
        P4_DMA_RAW(u0); P4_DMA_V(u0); P4_GATES(u0);
        f32x16 C0, C1;
#pragma unroll
        for (int i = 0; i < 16; ++i) { C0[i] = 0.f; C1[i] = 0.f; }
        float m = 0.f, nv = 0.f;
        float mgv = -1e30f, Bgv = 0.f;
        if (lane < g) { mgv = mgrp[bh * 16 + lane]; Bgv = mgrp[256 + bh * 16 + lane]; }
#pragma unroll 1
        for (int j0 = 0; j0 < g; j0 += 4) {
            u32x4 t[4][4]; float nt[4];
#pragma unroll
            for (int jj = 0; jj < 4; ++jj) { const int j = (j0 + jj < g) ? j0 + jj : g - 1; const u32x4* src = Ctot + ((size_t)(bh * 16 + j) * 8 + wave) * 256 + lane;
#pragma unroll
                for (int q = 0; q < 4; ++q) t[jj][q] = src[q * 64];
                nt[jj] = (tid < 128) ? ntot[(size_t)(bh * 16 + j) * 128 + tid] : 0.f; }
#pragma unroll
            for (int jj = 0; jj < 4; ++jj) { const float mgj = lane_bcast(mgv, j0 + jj), Bgj = lane_bcast(Bgv, j0 + jj);
                const float mn = fmaxf(Bgj + m, mgj), so = __expf(Bgj + m - mn), sl = __expf(mgj - mn);
                state_axpy(C0, C1, so, sl, t[jj]); nv = so * nv + sl * nt[jj]; m = mn; }
        }
#pragma unroll
        for (int bb = 0; bb < 2; ++bb) { const unsigned dv = 32 * (cb0 + bb) + cr;
#pragma unroll
            for (int gq = 0; gq < 4; ++gq) { u32x2 w;
                if (bb == 0) { w.x = pack2(C0[4 * gq], C0[4 * gq + 1]); w.y = pack2(C0[4 * gq + 2], C0[4 * gq + 3]); } else { w.x = pack2(C1[4 * gq], C1[4 * gq + 1]); w.y = pack2(C1[4 * gq + 2], C1[4 * gq + 3]); }
                *(LAS u32x2*)(IMG_C + img_off(dv, 4 * ca + gq) + 8 * chh) = w; } }
#pragma unroll 1
        for (int cc = 0; cc < 4; ++cc) {
            const int u = u0 + cc, c = 4 * g + cc, tok0 = b * SEQ + c * 64;
            if (tid < 128) s_n[tid] = nv;
            float cwq[4][8], cwk[4][8]; load_cw(conv_w, h * 128 + 8 * d8, cwq); load_cw(conv_w, 512 + h * 128 + 8 * d8, cwk);
            asm volatile("s_waitcnt vmcnt(0)" ::: "memory");
            __syncthreads();
            if (wave == 0) { const float ig = g_i + F.in[I_IGB][h]; const float lf = logsigmoidf_(g_f + F.in[I_FGB][h]);
                const float bb = wave_scan_add(lf, lane); const float cc_ = ig - bb; const float M = fmaxf(m, wave_scan_max(cc_, lane));
                s_c[lane] = cc_; s_M[lane] = M; s_int[lane] = expf(m - M); s_edn[lane] = expf(-bb - M); }
            { u32x4 preq[5], prek[5];
              const f32x4 n0 = *(const LAS f32x4*)(s_n + 8 * d8), n1 = *(const LAS f32x4*)(s_n + 8 * d8 + 4);
#pragma unroll
              for (int i = 0; i < 5; ++i) { const bool ok = (c * 64 + l0 - 3 + i) >= 0; const u32x4 zq = *(const LAS u32x4*)(RAWQ + (l0 + i) * 256 + d8 * 16), zk = *(const LAS u32x4*)(RAWK + (l0 + i) * 256 + d8 * 16);
                  preq[i] = ok ? zq : (u32x4){0u, 0u, 0u, 0u}; prek[i] = ok ? zk : (u32x4){0u, 0u, 0u, 0u}; }
              float qc[2][8], kc[2][8]; conv2rows(preq, cwq, qc); conv2rows(prek, cwk, kc);
#pragma unroll
              for (int rr = 0; rr < 2; ++rr) {
                  *(LAS bf16x8*)(IMG_Q + img_off(l0 + rr, d8)) = pack8(qc[rr][0], qc[rr][1], qc[rr][2], qc[rr][3], qc[rr][4], qc[rr][5], qc[rr][6], qc[rr][7]);
                  *(LAS bf16x8*)(IMG_K + img_off(l0 + rr, d8)) = pack8(kc[rr][0] * KSCALE, kc[rr][1] * KSCALE, kc[rr][2] * KSCALE, kc[rr][3] * KSCALE, kc[rr][4] * KSCALE, kc[rr][5] * KSCALE, kc[rr][6] * KSCALE, kc[rr][7] * KSCALE);
                  float qn = (qc[rr][0] * n0.x + qc[rr][1] * n0.y) + (qc[rr][2] * n0.z + qc[rr][3] * n0.w) + (qc[rr][4] * n1.x + qc[rr][5] * n1.y) + (qc[rr][6] * n1.z + qc[rr][7] * n1.w);
                  qn = row16_sum(qn);
                  if (d8 == 0) s_qn[l0 + rr] = qn; } }
            __syncthreads();
            const bool more = (cc < 3);
            if (more) { P4_DMA_RAW(u + 1); P4_GATES(u + 1); }
            {
                const int wi = wave >> 2, wj = wave & 3, r = lane & 31, hh = lane >> 5, lcol = 32 * wi + r;
                const float Ml = s_M[lcol];
                bf16x8 pa[2][2]; float dsum = 0.f;
                bf16x8 qf[8];
#pragma unroll
                for (int sx = 0; sx < 8; ++sx) qf[sx] = img_rr(IMG_Q, 32 * wi, lane, sx);
#pragma unroll
                for (int rb = 0; rb < 2; ++rb) {
                    if (rb <= wi) {
                        f32x16 sa;
#pragma unroll
                        for (int i = 0; i < 16; ++i) sa[i] = 0.f;
                        { bf16x8 kf[8];
#pragma unroll
                          for (int sx = 0; sx < 8; ++sx) kf[sx] = img_rr(IMG_K, 32 * rb, lane, sx);
#pragma unroll
                          for (int sx = 0; sx < 8; ++sx) sa = MFMA32(kf[sx], qf[sx], sa); }
                        float pv[16];
#pragma unroll
                        for (int gq = 0; gq < 4; ++gq) { const f32x4 c4 = *(const LAS f32x4*)(s_c + 32 * rb + 8 * gq + 4 * hh);
#pragma unroll
                            for (int j = 0; j < 4; ++j) { const int rrow = 32 * rb + 8 * gq + 4 * hh + j; const float e = __expf(c4[j] - Ml);
                                const float v = (rrow <= lcol) ? sa[4 * gq + j] * e : 0.f; pv[4 * gq + j] = v; dsum += v; } }
                        pa[rb][0] = pack8(pv[0], pv[1], pv[2], pv[3], pv[4], pv[5], pv[6], pv[7]);
                        pa[rb][1] = pack8(pv[8], pv[9], pv[10], pv[11], pv[12], pv[13], pv[14], pv[15]);
                    }
                }
                dsum += __shfl_xor(dsum, 32);
                { const float den = dsum + s_int[lcol] * s_qn[lcol]; const float rd = 1.0f / fmaxf(fabsf(den), s_edn[lcol]); if (hh == 0) s_rd[wave * 32 + r] = rd; }
                f32x16 z, z2;
#pragma unroll
                for (int i = 0; i < 16; ++i) { z[i] = 0.f; z2[i] = 0.f; }
#pragma unroll
                for (int rb = 0; rb < 2; ++rb) if (rb <= wi) {
#pragma unroll
                    for (int sx = 0; sx < 2; ++sx) z = MFMA32(pa[rb][sx], img_trp(IMG_V, 32 * rb + 16 * sx, lane, wj), z); }
                { bf16x8 cf[8];
#pragma unroll
                  for (int sx = 0; sx < 8; ++sx) cf[sx] = img_rr(IMG_C, 32 * wj, lane, sx);
#pragma unroll
                  for (int sx = 0; sx < 8; ++sx) z2 = MFMA32(qf[sx], cf[sx], z2); }
#pragma unroll
                for (int gq = 0; gq < 4; ++gq) { const f32x4 rd4 = *(const LAS f32x4*)(s_rd + wave * 32 + 8 * gq + 4 * hh), in4 = *(const LAS f32x4*)(s_int + 32 * wi + 8 * gq + 4 * hh);
#pragma unroll
                    for (int j = 0; j < 4; ++j) HB[(32 * wi + 8 * gq + 4 * hh + j) * 132 + 32 * wj + r] = (z[4 * gq + j] + in4[j] * z2[4 * gq + j]) * rd4[j]; }
            }
            unsigned owc[8];
#pragma unroll
            for (int i = 0; i < 8; ++i) owc[i] = *(const unsigned*)(P + (size_t)(tok0 + wave * 8 + i) * NP + PC_O + h * 128 + 2 * lane);
            __syncthreads();
            u32x4 cl[4] = {{0u, 0u, 0u, 0u}, {0u, 0u, 0u, 0u}, {0u, 0u, 0u, 0u}, {0u, 0u, 0u, 0u}}; float nl = 0.f, ml = 0.f, bt = 0.f;
            if (more) { P4_DMA_V(u + 1);
                const u32x4* src = Cloc + ((size_t)u * 8 + wave) * 256 + olane();
#pragma unroll
                for (int q = 0; q < 4; ++q) cl[q] = src[q * 64];
                if (tid < 128) nl = nst[(size_t)u * 128 + tid];
                ml = mloc[u]; bt = btot[u]; }
            const f32x2 gg = *(const f32x2*)(head_norm_g + h * 128 + 2 * lane);
#pragma unroll
            for (int i = 0; i < 8; ++i) { const int l = wave * 8 + i; const f32x2 hv = *(const LAS f32x2*)(HB + l * 132 + 2 * lane);
                const float mu = wave_sum(hv.x + hv.y) * (1.f / 128.f); const float e0 = hv.x - mu, e1 = hv.y - mu;
                const float var = wave_sum(e0 * e0 + e1 * e1) * (1.f / 128.f); const float rstd = rsqrtf(var + EPS);
                *(unsigned*)(ycat + (size_t)(tok0 + l) * D + h * 128 + 2 * lane) = pack2(fast_sigmoid(bflo(owc[i])) * e0 * rstd * gg.x, fast_sigmoid(bfhi(owc[i])) * e1 * rstd * gg.y); }
            if (more) { const float mn = fmaxf(bt + m, ml), so = __expf(bt + m - mn), sl = __expf(ml - mn);
                const int ol = olane(), ocr = ol & 31, ochh = ol >> 5;
#pragma unroll
                for (int bb = 0; bb < 2; ++bb) { const unsigned dv = 32 * (cb0 + bb) + ocr;
#pragma unroll
                    for (int gq = 0; gq < 4; ++gq) { LAS u32x2* pp = (LAS u32x2*)(IMG_C + img_off(dv, 4 * ca + gq) + 8 * ochh); const u32x2 w = *pp;
                        const u32x4 cw4 = cl[2 * bb + (gq >> 1)]; const unsigned c0 = (gq & 1) ? cw4.z : cw4.x, c1 = (gq & 1) ? cw4.w : cw4.y;
                        u32x2 o; o.x = pack2(so * bflo(w.x) + sl * bflo(c0), so * bfhi(w.x) + sl * bfhi(c0)); o.y = pack2(so * bflo(w.y) + sl * bflo(c1), so * bfhi(w.y) + sl * bfhi(c1));
                        *pp = o; } }
                nv = so * nv + sl * nl; m = mn; }
        }
        asm volatile("s_waitcnt vmcnt(0)" ::: "memory");
        __syncthreads();
    }
#undef P4_DMA_RAW
#undef P4_DMA_V
#undef P4_GATES
}

__device__ __forceinline__ void phase6_route(Frame& F, const int probe_rep) {
    const int lane = flane(), wave = F.wave, tid = wave * 64 + lane;
    const float* x1 = (const float*)(F.ws + WS_X1); const float* g2 = F.in[I_N2G]; const float* w_router = F.in[I_WR]; const float* b_router = F.in[I_BR];
    signed char* h2 = (signed char*)(F.ws + WS_H2); float* shv = (float*)(F.ws + WS_SH); int* cnt0 = (int*)(F.ws + WS_CTL) + CW_CNT; int* list0 = (int*)(F.ws + WS_LIST); float* gate_of = (float*)(F.ws + WS_GATEOF);
    LAS unsigned char* WH = F.lds; LAS unsigned char* WL = F.lds + 65536;
    LAS float* LG = (LAS float*)(F.lds + LDS_TOK);
    LAS float* RST = LG + 64 * 33;
    LAS float* s_rs = RST + 256;
    LAS int* hist = (LAS int*)(F.lds + LDS_P6); LAS int* base = hist + 64; LAS int* s_e = base + 64; LAS int* s_t = s_e + 1024; LAS float* s_g = (LAS float*)(s_t + 256);
    { const int e = tid & 31, kg = tid >> 5;
#pragma unroll 2
      for (int i = 0; i < 8; ++i) { const int c = kg + 16 * i; float w[8], wl[8];
#pragma unroll
          for (int j = 0; j < 8; ++j) { const int k = 8 * c + j; w[j] = w_router[(size_t)k * NE + e] * g2[k]; }
          const bf16x8 hi = pack8(w[0], w[1], w[2], w[3], w[4], w[5], w[6], w[7]);
#pragma unroll
          for (int j = 0; j < 8; ++j) wl[j] = w[j] - bf2f((unsigned short)hi[j]);
          const unsigned off = (unsigned)e * 2048u + 16u * (unsigned)(c ^ (e & 15));
          *(LAS bf16x8*)(WH + off) = hi; *(LAS bf16x8*)(WL + off) = pack8(wl[0], wl[1], wl[2], wl[3], wl[4], wl[5], wl[6], wl[7]); } }
    if (tid < 64) hist[tid] = 0;
    __syncthreads();
    const int t0 = 64 * F.vcu;
    const __amdgpu_buffer_rsrc_t x1rsrc = __builtin_amdgcn_make_buffer_rsrc((void*)x1, 0, T * D * 4, 0x00020000);
#pragma unroll 1
    for (int rep = 0; rep < probe_rep; ++rep) {
        {
            const int tb = wave >> 2, kq = wave & 3, r = lane & 31, h = lane >> 5;
            const int voff = (r * 1024 + 8 * h) * 4, sbase = ((t0 + 32 * tb) * 1024 + 256 * kq) * 4;
            f32x16 acc;
#pragma unroll
            for (int i = 0; i < 16; ++i) acc[i] = 0.f;
            float ss = 0.f;
#pragma unroll
            for (int sb = 0; sb < 16; sb += 8) {
                f32x4 xa[8][2];
#pragma unroll
                for (int sx = 0; sx < 8; ++sx) { xa[sx][0] = __builtin_bit_cast(f32x4, __builtin_amdgcn_raw_buffer_load_b128(x1rsrc, voff, sbase + (sb + sx) * 64, 0));
                    xa[sx][1] = __builtin_bit_cast(f32x4, __builtin_amdgcn_raw_buffer_load_b128(x1rsrc, voff, sbase + (sb + sx) * 64 + 16, 0)); }
#pragma unroll
                for (int sx = 0; sx < 8; ++sx) { const f32x4 p = xa[sx][0], q = xa[sx][1];
                    ss += ((p.x * p.x + p.y * p.y) + (p.z * p.z + p.w * p.w)) + ((q.x * q.x + q.y * q.y) + (q.z * q.z + q.w * q.w));
                    const bf16x8 ah = pack8(p.x, p.y, p.z, p.w, q.x, q.y, q.z, q.w);
                    const bf16x8 al = pack8(p.x - bf2f((unsigned short)ah[0]), p.y - bf2f((unsigned short)ah[1]), p.z - bf2f((unsigned short)ah[2]), p.w - bf2f((unsigned short)ah[3]),
                                            q.x - bf2f((unsigned short)ah[4]), q.y - bf2f((unsigned short)ah[5]), q.z - bf2f((unsigned short)ah[6]), q.w - bf2f((unsigned short)ah[7]));
                    const unsigned boff = (unsigned)r * 2048u + 16u * (unsigned)((32 * kq + 2 * (sb + sx) + h) ^ (r & 15));
                    const bf16x8 bh = *(const LAS bf16x8*)(WH + boff), bl = *(const LAS bf16x8*)(WL + boff);
                    acc = MFMA32(ah, bh, acc); acc = MFMA32(ah, bl, acc); acc = MFMA32(al, bh, acc); }
            }
            ss += __shfl_xor(ss, 32);
            if (h == 0) RST[(32 * tb + r) * 4 + kq] = ss;
#pragma unroll 1
            for (int q = 0; q < 4; ++q) {
                if (kq == q) {
#pragma unroll
                    for (int i = 0; i < 16; ++i) { LAS float* pp = LG + (32 * tb + (i & 3) + 8 * (i >> 2) + 4 * h) * 33 + r; *pp = (q == 0 ? 0.f : *pp) + acc[i]; } }
                __syncthreads();
            }
        }
        LAS int* hist_ = hist + 32 * rep;
        if (wave == 0) {
            const int t = t0 + lane;
            const float rs = rsqrtf(((RST[lane * 4] + RST[lane * 4 + 1]) + (RST[lane * 4 + 2] + RST[lane * 4 + 3])) * (1.f / D) + EPS);
            s_rs[lane] = rs;
            float lg[32];
#pragma unroll
            for (int e = 0; e < 32; ++e) lg[e] = LG[lane * 33 + e] * rs + b_router[e];
            int bi[4]; float bv[4];
#pragma unroll
            for (int k = 0; k < 4; ++k) { float best = -INFINITY; int bb = 0;
#pragma unroll
                for (int e = 0; e < 32; ++e) if (lg[e] > best) { best = lg[e]; bb = e; }
#pragma unroll
                for (int e = 0; e < 32; ++e) if (e == bb) lg[e] = -INFINITY;
                bi[k] = bb; bv[k] = best; }
            float ex[4], se = 0.f;
#pragma unroll
            for (int k = 0; k < 4; ++k) { ex[k] = expf(bv[k] - bv[0]); se += ex[k]; }
#pragma unroll
            for (int k = 0; k < 4; ++k) { const int lr = __hip_atomic_fetch_add(hist_ + bi[k], 1, __ATOMIC_RELAXED, __HIP_MEMORY_SCOPE_WORKGROUP);
                s_e[lane * 4 + k] = bi[k] | (lr << 8); s_g[lane * 4 + k] = ex[k] / se; }
            s_t[lane] = t;
        }
        __syncthreads();
        int nbase = 0;
        if (tid < 32) { const int n = hist_[tid]; nbase = n ? atomicAdd(cnt0 + (rep ? 8128 : 0) + tid * 64, n) : 0; }
        if (rep == probe_rep - 1) {
            f32x4 gg[4], nx[4];
#pragma unroll
            for (int j = 0; j < 4; ++j) { gg[j] = *(const f32x4*)(g2 + 256 * j + 4 * lane); nx[j] = ((const f32x4*)(x1 + (size_t)(t0 + wave * 8) * D) + lane)[64 * j]; }
#pragma unroll 1
            for (int i = 0; i < 8; ++i) {
                const int li = wave * 8 + i, t = t0 + li; const float rs = s_rs[li];
                f32x4 hv[4]; float hmax = 0.f;
#pragma unroll
                for (int j = 0; j < 4; ++j) { hv[j] = nx[j] * gg[j];
                    hmax = fmaxf(fmaxf(hmax, fmaxf(fabsf(hv[j].x), fabsf(hv[j].y))), fmaxf(fabsf(hv[j].z), fabsf(hv[j].w))); }
                if (i < 7) { const f32x4* xr = (const f32x4*)(x1 + (size_t)(t + 1) * D) + lane;
#pragma unroll
                    for (int j = 0; j < 4; ++j) nx[j] = xr[64 * j]; }
                hmax = wave_max(hmax);
                const float qi = hmax > 0.f ? 127.0f / hmax : 0.f; unsigned* o4 = (unsigned*)(h2 + (size_t)t * D) + lane;
#pragma unroll
                for (int j = 0; j < 4; ++j) { const f32x4 hq = hv[j] * qi; o4[64 * j] = pg8::q4(hq.x, hq.y, hq.z, hq.w); }
                if (lane == 0) shv[t] = hmax > 0.f ? hmax * rs * (1.0f / 127.0f) : 1.0f;
            }
        }
        if (tid < 32) base[tid] = nbase;
        __syncthreads();
        if (tid < 256) { const int li = tid >> 2, k = tid & 3, t = s_t[li]; const int ew = s_e[tid], e = ew & 255, lr = ew >> 8; int* list = rep ? (int*)(F.ws + WS_ACT) : list0;
            list[e * T + base[e] + lr] = t * 4 + k; if (!rep) gate_of[t * 4 + k] = s_g[tid]; }
        __syncthreads();
    }
}

__device__ __forceinline__ int moe_tables(Frame& F) {
    LAS int* lcnt = (LAS int*)(F.lds + LDS_CNT); LAS int* ltp = (LAS int*)(F.lds + LDS_TP); LAS int* lte = (LAS int*)(F.lds + LDS_TE);
    const int* cnt = (const int*)(F.ws + WS_CTL) + CW_CNT;
    const int lane = flane();
    if (F.wave == 0) {
        const int c = lane < NE ? cnt[lane * 64] : 0, nt = (c + 255) >> 8;
        const int incl = (int)wave_scan_add((float)nt, lane);
        const int excl = incl - nt;
        if (lane < NE) { lcnt[lane] = c; ltp[lane] = excl; for (int j = 0; j < nt; ++j) lte[excl + j] = lane; }
        if (lane == NE - 1) ltp[NE] = incl;
    }
    __syncthreads();
    return ltp[NE];
}
template <int MODE, class Sched>
__device__ __forceinline__ void build_row_tables(Frame& F, const Sched& S) {
    const int* list = (const int*)(F.ws + WS_LIST); const float* vals = (const float*)(F.ws + (MODE == 0 ? WS_SH : WS_GATEOF));
    LAS int* tok = (LAS int*)(F.lds + LDS_TOK); LAS float* tsc = (LAS float*)(F.lds + LDS_TSC);
    const int tid = F.wave * 64 + flane(); const int nent = (S.nmine < 10 ? S.nmine : 10) * 256;
    int a[5];
#pragma unroll
    for (int k = 0; k < 5; ++k) { const int idx = tid + k * NTHR; a[k] = -1;
        if (idx < nent) { pg8::Unit u; S.next(idx >> 8, u); const int r = idx & 255; if (r < u.nv) a[k] = list[u.lbase + r]; } }
    float v[5];
#pragma unroll
    for (int k = 0; k < 5; ++k) v[k] = vals[a[k] < 0 ? 0 : (MODE == 0 ? (a[k] >> 2) : a[k])];
#pragma unroll
    for (int k = 0; k < 5; ++k) { const int idx = tid + k * NTHR; if (idx < nent) { tok[idx] = a[k] < 0 ? 0 : (MODE == 0 ? (a[k] >> 2) * D : a[k]); tsc[idx] = v[k]; } }
    __syncthreads();
}

__device__ __forceinline__ void phase9_final(Frame& F) {
    const float* x1 = (const float*)(F.ws + WS_X1); const unsigned char* ybuf = (const unsigned char*)(F.ws + WS_YBUF); const float* gf = F.in[I_NFG]; float* out = F.out;
    const int gw = F.vcu * NWAVES + F.wave, NGW = F.G * NWAVES, lane = flane();
    f32x4 gg[4];
#pragma unroll
    for (int j = 0; j < 4; ++j) gg[j] = *(const f32x4*)(gf + 256 * j + 4 * lane);
    for (int t = gw; t < T; t += 2 * NGW) {
        f32x4 v[2][4]; unsigned y[2][4][4];
#pragma unroll
        for (int q = 0; q < 2; ++q) { const int tq = (t + q * NGW < T) ? t + q * NGW : t; const f32x4* xr = (const f32x4*)(x1 + (size_t)tq * D) + lane;
#pragma unroll
            for (int j = 0; j < 4; ++j) v[q][j] = xr[64 * j];
#pragma unroll
            for (int k = 0; k < 4; ++k) { const unsigned* yr = (const unsigned*)(ybuf + (size_t)(tq * 4 + k) * D) + lane;
#pragma unroll
                for (int j = 0; j < 4; ++j) y[q][k][j] = yr[64 * j]; } }
#pragma unroll
        for (int q = 0; q < 2; ++q) { if (t + q * NGW < T) {
#pragma unroll
            for (int j = 0; j < 4; ++j) { f32x4 sb = {0.f, 0.f, 0.f, 0.f};
#pragma unroll
                for (int k = 0; k < 4; ++k) { const unsigned yy = y[q][k][j]; sb.x += (float)(yy & 255u); sb.y += (float)((yy >> 8) & 255u); sb.z += (float)((yy >> 16) & 255u); sb.w += (float)(yy >> 24); }
                v[q][j] = v[q][j] + (sb - 512.0f) * Y_SCALE; }
            float ss = 0.f;
#pragma unroll
            for (int j = 0; j < 4; ++j) ss += (v[q][j].x * v[q][j].x + v[q][j].y * v[q][j].y) + (v[q][j].z * v[q][j].z + v[q][j].w * v[q][j].w);
            const float rs = rsqrtf(wave_sum(ss) * (1.f / D) + EPS);
            f32x4* orow = (f32x4*)(out + (size_t)(t + q * NGW) * D) + lane;
#pragma unroll
            for (int j = 0; j < 4; ++j) orow[64 * j] = v[q][j] * rs * gg[j]; } }
    }
}

__global__ void __launch_bounds__(NTHR, 2) mega(Args args) {
    extern __shared__ __attribute__((aligned(16))) unsigned char lds_raw[];
    Frame F;
    F.lds = (LAS unsigned char*)lds_raw;
    F.wave = __builtin_amdgcn_readfirstlane((int)threadIdx.x >> 6);
    F.G = gridDim.x; { const int bx = blockIdx.x; F.vcu = (F.G % 8 == 0) ? (bx % 8) * (F.G / 8) + bx / 8 : bx; }
#pragma unroll
    for (int i = 0; i < 20; ++i) F.in[i] = args.in[i];
    F.out = args.out; F.ws = args.ws;
    if (threadIdx.x < 16) ((LAS unsigned*)(F.lds + LDS_BARW))[threadIdx.x] = 0u;
    __syncthreads();
    unsigned* ctl = (unsigned*)(F.ws + WS_CTL);
    XcdBarrier bar; bar.bar = ctl + CW_BAR; bar.x = 0; bar.st = nullptr;
    if (MK_N_LAUNCHES == 1) bar = xcd_barrier_post(ctl + CW_BAR, (volatile LAS unsigned*)(F.lds + LDS_BARW));
    const int lo = args.ph_lo, hi = args.ph_hi;
#define IN(k) (lo <= (k) && (k) < hi)
#define SEAM(k) do { if (IN(k) && IN((k) + 1)) { if ((k) <= 6) xcd_barrier_fill(bar, F); else xcd_barrier(bar, F.wave); if ((DUP_MASK >> 10) & 1) xcd_barrier(bar, F.wave); } } while (0)

    if (IN(0)) { REP(0) phase0(F); SEAM(0); }
    if (IN(1)) { {
        pg8::DenseSched S; S.init((const bf16_t*)(F.ws + WS_XB), (const bf16_t*)(F.ws + WS_WIN), T, NP, D, F.G, (int)blockIdx.x, 1 + ((DUP_MASK >> 1) & 1));
        pg8::EpRowScaleBf16 E{(bf16_t*)(F.ws + WS_P), NP, (const float*)(F.ws + WS_RS1), F.lds + LDS_EPI};
        pg8::gemm_phase(F.lds, S, E, F.wave); }
        SEAM(1);
    }
    if (IN(2)) { REP(2) { phase2_group(F); phase2_pool(F); } SEAM(2); }
    if (IN(4)) { REP(4) phase4_group(F); SEAM(4); }
    if (IN(5)) { {
        pg8::DenseSched S; S.init((const bf16_t*)(F.ws + WS_YCAT), (const bf16_t*)(F.ws + WS_WOUT), T, D, D, F.G, (int)blockIdx.x, 1 + ((DUP_MASK >> 5) & 1));
        pg8::EpResidF32 E{F.in[I_X], (float*)(F.ws + WS_X1), D};
        pg8::gemm_phase(F.lds, S, E, F.wave); }
        SEAM(5);
    }
    if (IN(6)) { phase6_route(F, 1 + ((DUP_MASK >> 6) & 1)); __syncthreads(); { int par = 0; while (quant_pull(F, par, 1)) par ^= 1; } SEAM(6); }
    if (IN(7)) {
        const int ntiles = moe_tables(F);
        pg8::MoeSched<true, 8, 1> S; S.A = (const void*)(F.ws + WS_H2); S.Bt = (const void*)(F.ws + WS_WGU); S.K = D; S.setup(ntiles * 8, F.G, (int)blockIdx.x, 1 + ((DUP_MASK >> 7) & 1), false);
        S.cnt = (const LAS int*)(F.lds + LDS_CNT); S.tp = (const LAS int*)(F.lds + LDS_TP); S.te = (const LAS int*)(F.lds + LDS_TE); S.tok = (const LAS int*)(F.lds + LDS_TOK);
        build_row_tables<0>(F, S);
        pg8::EpGlu8 E{(signed char*)(F.ws + WS_ACT), F.in[I_BG], F.in[I_BU], (const float*)(F.ws + WS_SGU), (const LAS float*)(F.lds + LDS_TSC), S.nmine > 0 ? S.nmine : 1, 0, F.lds + LDS_EPI};
        pg8::gemm_phase<pg8::EpGlu8, pg8::MoeSched<true, 8, 1>, true, MOE_ALIGN>(F.lds, S, E, F.wave);
        { int par = 0; while (quant_pull(F, par, 2)) par ^= 1; }
        SEAM(7);
    }
    if (IN(8)) {
        const int ntiles = moe_tables(F);
        pg8::MoeSched<false, 4, 1> S; S.A = (const void*)(F.ws + WS_ACT); S.Bt = (const void*)(F.ws + WS_WD); S.K = FF; S.setup(ntiles * 4, F.G, (int)blockIdx.x, 1 + ((DUP_MASK >> 8) & 1), true);
        S.cnt = (const LAS int*)(F.lds + LDS_CNT); S.tp = (const LAS int*)(F.lds + LDS_TP); S.te = (const LAS int*)(F.lds + LDS_TE); S.tok = (const LAS int*)(F.lds + LDS_TOK);
        build_row_tables<1>(F, S);
        pg8::EpDown8 E{(unsigned char*)(F.ws + WS_YBUF), F.in[I_BD], (const float*)(F.ws + WS_SD), (const LAS int*)(F.lds + LDS_TOK), (const LAS float*)(F.lds + LDS_TSC), S.nmine > 0 ? S.nmine : 1, 0, F.lds + LDS_EPI};
        pg8::gemm_phase<pg8::EpDown8, pg8::MoeSched<false, 4, 1>, true, MOE_ALIGN>(F.lds, S, E, F.wave);
        SEAM(8);
    }
    if (IN(9)) { REP(9) phase9_final(F); }
#undef IN
#undef SEAM
}

extern "C" void kernel_launch(void* const* d_in, const int* in_sizes, int n_in, void* d_out, int out_size, void* d_ws, size_t ws_size, hipStream_t stream) {
    static int grid = 0;
    if (grid == 0) {
        if (n_in != 20 || in_sizes[0] != T * D || out_size != T * D || ws_size < WS_END) { fprintf(stderr, "kernel_launch: unexpected problem (n_in %d, ws %zu)\n", n_in, ws_size); grid = -1; return; }
        int dev = 0, cus = 0, per_cu = 0;
        if (hipGetDevice(&dev) != hipSuccess || hipDeviceGetAttribute(&cus, hipDeviceAttributeMultiprocessorCount, dev) != hipSuccess) { grid = -1; return; }
        if (hipFuncSetAttribute((const void*)mega, hipFuncAttributeMaxDynamicSharedMemorySize, LDS_BYTES) != hipSuccess) { fprintf(stderr, "kernel_launch: hipFuncSetAttribute failed\n"); grid = -1; return; }
        if (hipOccupancyMaxActiveBlocksPerMultiprocessor(&per_cu, (const void*)mega, NTHR, LDS_BYTES) != hipSuccess || per_cu < 1) fprintf(stderr, "kernel_launch: occupancy query reports %d\n", per_cu);
        (void)hipGetLastError();
        if (cus != 256) { fprintf(stderr, "kernel_launch: built for a 256-CU device (one 64-token routing block and one workgroup per CU); found %d CUs, nothing launched\n", cus); grid = -1; return; }
        grid = cus;
    }
    if (grid < 0) return;
    (void)hipMemsetAsync((char*)d_ws + WS_CTL, 0, CTL_ZERO_BYTES, stream);
    Args a{};
    for (int i = 0; i < 20; ++i) a.in[i] = (const float*)d_in[i];
    a.out = (float*)d_out; a.ws = (unsigned char*)d_ws;
    if (MK_N_LAUNCHES == 1) { a.ph_lo = 0; a.ph_hi = N_PHASES; hipLaunchKernelGGL(mega, dim3(grid), dim3(NTHR), LDS_BYTES, stream, a); }
    else for (int p = 0; p < N_PHASES; ++p) { a.ph_lo = p; a.ph_hi = p + 1; hipLaunchKernelGGL(mega, dim3(grid), dim3(NTHR), LDS_BYTES, stream, a); }
}
```

```cpp
#include <hip/hip_runtime.h>
#include <cstdio>
#include <cstdint>

#ifndef MK_N_LAUNCHES
#define MK_N_LAUNCHES 1
#endif
constexpr int N_PHASES = 10;
constexpr bool MOE_ALIGN = true;
#ifndef DUP_MASK
#define DUP_MASK 0
#endif
#define REP(k) for (int rep_ = 0; rep_ < 1 + ((DUP_MASK >> (k)) & 1); ++rep_)

constexpr int T = 16384, D = 1024, SEQ = 4096;
constexpr int NIN = 2568;
constexpr int NP = 2560;
constexpr int NE = 32, FF = 1024;
constexpr float EPS = 1e-5f;
constexpr int PC_V = 1024, PC_O = 1536, PC_U = 2048;

#define GAS __attribute__((address_space(1)))
#define LAS __attribute__((address_space(3)))
typedef unsigned short bf16_t;
typedef short bf16x8 __attribute__((ext_vector_type(8)));
typedef float f32x4 __attribute__((ext_vector_type(4)));
typedef unsigned u32x4 __attribute__((ext_vector_type(4)));
typedef unsigned u32x2 __attribute__((ext_vector_type(2)));

__device__ __forceinline__ unsigned cvt_pk_bf16(float lo, float hi) { unsigned r; asm volatile("v_cvt_pk_bf16_f32 %0, %1, %2" : "=v"(r) : "v"(lo), "v"(hi)); return r; }
__device__ __forceinline__ float bf2f(unsigned short b) { return __uint_as_float(((unsigned)b) << 16); }
__device__ __forceinline__ float bflo(unsigned w) { return __uint_as_float(w << 16); }
__device__ __forceinline__ float bfhi(unsigned w) { return __uint_as_float(w & 0xffff0000u); }
template <int CTRL> __device__ __forceinline__ float dpp_mov(float v) { return __builtin_bit_cast(float, __builtin_amdgcn_update_dpp(0, __builtin_bit_cast(int, v), CTRL, 0xF, 0xF, true)); }
__device__ __forceinline__ float wave_sum(float v) {
    v += dpp_mov<0xB1>(v);
    v += dpp_mov<0x4E>(v);
    v += dpp_mov<0x141>(v);
    v += dpp_mov<0x140>(v);
    const int vi = __builtin_bit_cast(int, v);
    return (__builtin_bit_cast(float, __builtin_amdgcn_readlane(vi, 0)) + __builtin_bit_cast(float, __builtin_amdgcn_readlane(vi, 16)))
         + (__builtin_bit_cast(float, __builtin_amdgcn_readlane(vi, 32)) + __builtin_bit_cast(float, __builtin_amdgcn_readlane(vi, 48)));
}
template <int CTRL, int ROWMASK> __device__ __forceinline__ float dpp_old(float old, float v) { return __builtin_bit_cast(float, __builtin_amdgcn_update_dpp(__builtin_bit_cast(int, old), __builtin_bit_cast(int, v), CTRL, ROWMASK, 0xF, false)); }
__device__ __forceinline__ float lane_bcast(float v, int l) { return __builtin_bit_cast(float, __builtin_amdgcn_readlane(__builtin_bit_cast(int, v), l)); }
__device__ __forceinline__ float row16_sum(float v) { v += dpp_mov<0xB1>(v); v += dpp_mov<0x4E>(v); v += dpp_mov<0x141>(v); v += dpp_mov<0x140>(v); return v; }
__device__ __forceinline__ float logsigmoidf_(float x) { return fminf(x, 0.f) - log1pf(expf(-fabsf(x))); }
__device__ __forceinline__ float sigmoidf_(float x) { return 1.f / (1.f + expf(-x)); }
__device__ __forceinline__ float fast_sigmoid(float x) { return __builtin_amdgcn_rcpf(1.0f + __builtin_amdgcn_exp2f(-1.44269504f * x)); }

__device__ __forceinline__ int flane() { return (int)__builtin_amdgcn_mbcnt_hi(~0u, __builtin_amdgcn_mbcnt_lo(~0u, 0u)); }
__device__ __forceinline__ int olane() { int v; asm volatile("v_mbcnt_lo_u32_b32 %0, -1, 0\n\tv_mbcnt_hi_u32_b32 %0, -1, %0" : "=v"(v)); return v; }

constexpr size_t MiB = 1u << 20;
constexpr size_t WS_CTL = 0, CTL_ZERO_BYTES = 1 * MiB;
constexpr size_t WS_WIN = 1 * MiB;
constexpr size_t WS_WOUT = 6 * MiB;
constexpr size_t WS_WGU = 8 * MiB;
constexpr size_t WS_WD = 72 * MiB;
constexpr size_t WS_SGU = 104 * MiB;
constexpr size_t WS_SD = WS_SGU + 512 * 1024;
constexpr size_t WS_X1 = 105 * MiB;
constexpr size_t WS_CST = 105 * MiB;
constexpr size_t WS_CIN = 137 * MiB;
constexpr size_t WS_ACT = 169 * MiB;
constexpr size_t WS_YBUF = 241 * MiB;
constexpr size_t WS_P = 169 * MiB;
constexpr size_t WS_XB = 249 * MiB;
constexpr size_t WS_YCAT = 281 * MiB;
constexpr size_t WS_H2 = 369 * MiB;
constexpr size_t WS_SM = 385 * MiB;
constexpr size_t WS_RS1 = WS_SM, WS_GATES = WS_SM + 64 * 1024, WS_NST = WS_GATES + 512 * 1024, WS_MLOC = WS_NST + 512 * 1024, WS_BTOT = WS_MLOC + 4096, WS_MIN = WS_BTOT + 4096, WS_SH = WS_SM + 1280 * 1024, WS_NIN = WS_SM + 2560 * 1024,
                 WS_POOLWT = WS_SM + 1536 * 1024, WS_GATEOF = WS_SM + 2 * MiB, WS_LIST = WS_SM + 3 * MiB, WS_LSC = WS_LIST + (size_t)NE * T * 4, WS_LGW = WS_LSC + (size_t)NE * T * 4, WS_END = WS_LGW + (size_t)NE * T * 4;
static_assert(WS_END <= 396 * MiB, "ws map");
constexpr float ACT_CLIP = 16.0f, ACT_Q = 127.0f / ACT_CLIP, ACT_SCALE = ACT_CLIP / 127.0f;
constexpr float Y_CLIP = 3.0f, Y_Q = 127.0f / Y_CLIP, Y_SCALE = Y_CLIP / 127.0f;
constexpr int CW_CNT = 64;
constexpr int CW_BAR = 4096;
constexpr int CW_QHEAD = 24;

constexpr int RING_BYTES = 131072;
constexpr int LDS_TOK = RING_BYTES;
constexpr int LDS_TSC = LDS_TOK + 10 * 1024;
constexpr int LDS_CNT = LDS_TSC + 10 * 1024;
constexpr int LDS_TP = LDS_CNT + 128;
constexpr int LDS_TE = LDS_TP + 192;
constexpr int LDS_P6 = 153600;
constexpr int LDS_EPI = 153600;
constexpr int LDS_BARW = 163776;
constexpr int LDS_BYTES = 163840;
static_assert(LDS_TE + 1280 <= LDS_P6 && LDS_P6 + 9728 <= LDS_BARW, "LDS map");
constexpr int WR_LANE_STRIDE = 2064;

#define XB_TMO      128
#define XB_XCNT(j)  (256  + 64 * (j))
#define XB_XSUB(j)  (1280 + 64 * (j))
#define XB_XGEN(j)  (2304 + 64 * (j))
#define XB_TOP      3328
#define XB_TOPGEN   3392
#define XCD_BAR_WORDS 3456
#define XB_SPIN_CAP (1u << 18)
__device__ __forceinline__ unsigned xb_ld(unsigned* p)              { return __hip_atomic_load(p, __ATOMIC_RELAXED, __HIP_MEMORY_SCOPE_AGENT); }
__device__ __forceinline__ unsigned xb_add(unsigned* p, unsigned v) { return __hip_atomic_fetch_add(p, v, __ATOMIC_RELAXED, __HIP_MEMORY_SCOPE_AGENT); }
__device__ __forceinline__ unsigned xb_xcc_id() { return (unsigned)__builtin_amdgcn_s_getreg((3 << 11) | 20) & 0xFu; }
#define XB_SPIN(cond, bar) do { unsigned _sp = 0; while (cond) { __builtin_amdgcn_s_sleep(1); \
    if ((++_sp & 255u) == 0u) { if (xb_ld(&(bar)[XB_TMO])) break; if (_sp > XB_SPIN_CAP) { atomicAdd(&(bar)[XB_TMO], 1u); break; } } } } while (0)
struct XcdBarrier { unsigned* bar; unsigned x; volatile LAS unsigned* st; };
__device__ __forceinline__ XcdBarrier xcd_barrier_post(unsigned* bar, volatile LAS unsigned* st) {
    XcdBarrier b; b.bar = bar; b.x = xb_xcc_id(); b.st = st;
    if (threadIdx.x == 0) (void)xb_add(&bar[XB_XCNT(b.x)], 1u);
    return b;
}
__device__ __forceinline__ void xcd_barrier_complete(unsigned* bar, unsigned x, unsigned& nloc, unsigned& nx) {
    const unsigned G = gridDim.x * gridDim.y * gridDim.z;
    unsigned sum, cnt, mine, sp = 0u;
    for (;;) {
        sum = 0u; cnt = 0u; mine = 0u;
#pragma unroll
        for (unsigned j = 0; j < 16; ++j) { const unsigned c = xb_ld(&bar[XB_XCNT(j)]); sum += c; cnt += (c > 0u) ? 1u : 0u; mine = (j == x) ? c : mine; }
        if (sum == G) break;
        __builtin_amdgcn_s_sleep(1);
        if ((++sp & 255u) == 0u) { if (xb_ld(&bar[XB_TMO])) break; if (sp > XB_SPIN_CAP) { atomicAdd(&bar[XB_TMO], 1u); break; } }
    }
    nloc = mine > 0u ? mine : 1u; nx = cnt > 0u ? cnt : 1u;
}
__device__ __forceinline__ void xcd_barrier(const XcdBarrier& b, const int wave) {
    asm volatile("s_waitcnt vmcnt(0)" ::: "memory");
    __syncthreads();
    if (wave == 0 && flane() == 0) {
        unsigned* bar = b.bar;
        __builtin_amdgcn_s_waitcnt(0);
        unsigned nloc = b.st[0], nx = b.st[1];
        if (nloc == 0u) { xcd_barrier_complete(bar, b.x, nloc, nx); b.st[0] = nloc; b.st[1] = nx; }
        const unsigned old = xb_add(&bar[XB_XSUB(b.x)], 1u);
        const unsigned gen = old / nloc;
        if (old + 1u == (gen + 1u) * nloc) {
            __builtin_amdgcn_fence(__ATOMIC_RELEASE, "agent");
            asm volatile("s_waitcnt vmcnt(0)" ::: "memory");
            const unsigned og = xb_add(&bar[XB_TOP], 1u);
            const unsigned tg = og / nx;
            if (og + 1u == (tg + 1u) * nx) xb_add(&bar[XB_TOPGEN], 1u);
            else XB_SPIN(xb_ld(&bar[XB_TOPGEN]) == tg, bar);
            __builtin_amdgcn_fence(__ATOMIC_ACQUIRE, "agent");
            xb_add(&bar[XB_XGEN(b.x)], 1u);
            asm volatile("s_waitcnt vmcnt(0)" ::: "memory");
        } else {
            XB_SPIN(xb_ld(&bar[XB_XGEN(b.x)]) == gen, bar);
            __builtin_amdgcn_fence(__ATOMIC_ACQUIRE, "agent");
            asm volatile("s_waitcnt vmcnt(0)" ::: "memory");
        }
    }
    __syncthreads();
}

namespace pg8 {
typedef int i32x4 __attribute__((ext_vector_type(4)));
constexpr int BM = 256, BK = 64, HALF = 128, HTB = HALF * BK * 2, STAGE_BYTES = 8 * HTB, NXCD = 8, WGM = 8;
__host__ __device__ __forceinline__ int lds_byte(int r, int c) { const int st = (r >> 4) * 2 + (c >> 5), rr = r & 15, cc = c & 31, ob = rr * 64 + cc * 2; return st * 1024 + (ob ^ (((ob >> 9) & 1) << 5)); }
__host__ __device__ __forceinline__ void stage_rc(int b, int& R, int& C) { const int st = b / 1024, sb = b % 1024, swz = sb ^ (((sb >> 9) & 1) << 5); R = (st >> 1) * 16 + swz / 64; C = (st & 1) * 32 + (swz % 64) / 2; }
__host__ __device__ __forceinline__ int perm32(int rho) { const int n = rho >> 4, i = rho & 15; return 8 * (i >> 2) + 4 * n + (i & 3); }

struct Unit { int pm, pn, e, nv, lbase, half; };

struct DenseSched {
    static constexpr bool GATHER = false; static constexpr int ESZ_ = 2;
    const bf16_t* A; const bf16_t* Bt; int K; int nM, nN, nwg, G, c, nmine, nrep, nfull, split;
    __device__ __forceinline__ void init(const bf16_t* A_, const bf16_t* Bt_, int M, int N, int K_, int G_, int c_, int nrep_) { A = A_; Bt = Bt_; K = K_; nM = M / BM; nN = N / BM; nwg = nM * nN; G = G_; c = c_; nrep = nrep_;
        nfull = (nwg / G) * G; const int rest = nwg - nfull; split = (rest > 0 && 2 * rest <= G) ? 1 : 0;
        const int ntot = split ? nfull + 2 * rest : nwg; nmine = ntot > c ? (ntot - c + G - 1) / G : 0; }
    __device__ __forceinline__ bool next(int i, Unit& u) const {
        if (i >= nmine * nrep) return false; const int L = (i % nmine) * G + c;
        int wgid = L, half = 0;
        if (split && L >= nfull) { wgid = nfull + ((L - nfull) >> 1); half = 1 + ((L - nfull) & 1); }
        { const int q = nwg / NXCD, r = nwg % NXCD, xcd = wgid % NXCD, off = wgid / NXCD; wgid = (xcd < r ? xcd * (q + 1) : r * (q + 1) + (xcd - r) * q) + off; }
        const int nig = WGM * nN, gid = wgid / nig, fm = gid * WGM, gsz = (nM - fm) < WGM ? (nM - fm) : WGM;
        u.pm = fm + ((wgid % nig) % gsz); u.pn = (wgid % nig) / gsz; u.e = 0; u.nv = 256; u.lbase = 0; u.half = half; return true;
    }
    __device__ __forceinline__ const char* a_ptr(const Unit& u) const { return (const char*)A + ((size_t)u.pm * BM + (u.half == 2 ? HALF : 0)) * (size_t)2 * K; }
    __device__ __forceinline__ const char* b_ptr(const Unit& u) const { return (const char*)Bt + (size_t)u.pn * (size_t)(BM * 2) * K; }
    __device__ __forceinline__ void a_voff(int, const int (&R)[2], const int (&C)[2], unsigned (&vA)[2][2]) const {
#pragma unroll
        for (int h = 0; h < 2; ++h)
#pragma unroll
            for (int i = 0; i < 2; ++i) vA[h][i] = (unsigned)((h * HALF + R[i]) * K + C[i]) * 2u;
    }
};
template <bool GATHER_, int NT  , int ESZ  >
struct MoeSched {
    static constexpr bool GATHER = GATHER_;
    static constexpr int ESZ_ = ESZ;
    const void* A; const void* Bt; int K; int G, c, nunits, nmine, nrep, nfull, split;
    const LAS int* cnt; const LAS int* tp; const LAS int* te; const LAS int* tok;
    __device__ __forceinline__ bool next(int i, Unit& u) const {
        if (i >= nmine * nrep) return false; const int L = (i % nmine) * G + c;
        int wg = L, half = 0;
        if (split && L >= nfull) { wg = nfull + ((L - nfull) >> 1); half = 1 + ((L - nfull) & 1); }
        const int q = nunits / NXCD, r = nunits % NXCD, xcd = wg % NXCD, off = wg / NXCD;
        const int w = (xcd < r ? xcd * (q + 1) : r * (q + 1) + (xcd - r) * q) + off;
        const int tt = w / NT; u.pm = tt; u.pn = w % NT; u.half = half;
        const int e = __builtin_amdgcn_readfirstlane(te[tt]); u.e = e; const int j = tt - __builtin_amdgcn_readfirstlane(tp[e]); const int left = __builtin_amdgcn_readfirstlane(cnt[e]) - j * 256; u.nv = left < 256 ? left : 256; u.lbase = e * T + j * 256; return true;
    }
    __device__ __forceinline__ void setup(int nunits_, int G_, int c_, int nrep_, bool allow_split) { nunits = nunits_; G = G_; c = c_; nrep = nrep_;
        nfull = (nunits / G) * G; const int rest = nunits - nfull; split = (allow_split && rest > 0 && 2 * rest <= G) ? 1 : 0;
        const int ntot = split ? nfull + 2 * rest : nunits; nmine = ntot > c ? (ntot - c + G - 1) / G : 0; }
    __device__ __forceinline__ const char* a_ptr(const Unit& u) const { return GATHER ? (const char*)A : (const char*)A + ((size_t)u.pm * BM + (u.half == 2 ? HALF : 0)) * (size_t)ESZ * K; }
    __device__ __forceinline__ const char* b_ptr(const Unit& u) const { return (const char*)Bt + ((size_t)u.e * NT + u.pn) * (size_t)(BM * ESZ) * K; }
    __device__ __forceinline__ void a_voff(int ui, const int (&R)[2], const int (&C)[2], unsigned (&vA)[2][2]) const {
#pragma unroll
        for (int h = 0; h < 2; ++h)
#pragma unroll
            for (int i = 0; i < 2; ++i) vA[h][i] = GATHER ? (unsigned)tok[(ui % nmine) * 256 + h * HALF + R[i]] + (unsigned)C[i] * 2u : (unsigned)((h * HALF + R[i]) * K * ESZ + C[i] * 2);
    }
};

struct EpRowScaleBf16 {
    static constexpr bool PERM = true; typedef f32x4 acc_t;
    bf16_t* O; int ldc; const float* rs; LAS unsigned char* epi;
    __device__ __forceinline__ void prefetch(const Unit& u, int slot, int wid) const {
        if (wid < 4) __builtin_amdgcn_global_load_lds((const unsigned*)(rs + u.pm * BM + (u.half == 2 ? HALF : 0) + ((wid * 64 + flane()) & (u.half ? 127 : 255))), (LAS unsigned*)(epi + slot * 2048 + wid * 256), 4, 0, 0); }
    __device__ __forceinline__ void operator()(const f32x4 (&acc)[2][2][4][2], const Unit& u, int wr, int wc, int fr, int fq, int slot) const {
        const int row0 = u.pm * BM + (u.half == 2 ? HALF : 0) + wr * 64 + fr, col0 = u.pn * BM + wc * 32 + 8 * fq;
        const __amdgpu_buffer_rsrc_t orsrc = __builtin_amdgcn_make_buffer_rsrc((void*)O, 0, T * NP * 2, 0x00020000);
        const LAS float* rsl = (const LAS float*)(epi + slot * 2048) + wr * 64 + fr;
#pragma unroll
        for (int ai = 0; ai < 2; ++ai) if (ai == 0 || u.half == 0)
#pragma unroll
            for (int m = 0; m < 4; ++m) { const int row = row0 + ai * HALF + m * 16; const float s = rsl[ai * HALF + m * 16]; const int boff = (row * ldc + col0) * 2;
#pragma unroll
                for (int bj = 0; bj < 2; ++bj) { const f32x4 v0 = acc[ai][bj][m][0] * s, v1 = acc[ai][bj][m][1] * s;
                    u32x4 w; w.x = cvt_pk_bf16(v0[0], v0[1]); w.y = cvt_pk_bf16(v0[2], v0[3]); w.z = cvt_pk_bf16(v1[0], v1[1]); w.w = cvt_pk_bf16(v1[2], v1[3]);
                    __builtin_amdgcn_raw_buffer_store_b128(w, orsrc, boff + bj * HALF * 2, 0, 16); } }
    }
};
struct EpResidF32 {
    static constexpr bool PERM = false; typedef f32x4 acc_t;
    const float* base; float* C; int ldc;
    __device__ __forceinline__ void prefetch(const Unit&, int, int) const {}
    __device__ __forceinline__ void operator()(const f32x4 (&acc)[2][2][4][2], const Unit& u, int wr, int wc, int fr, int fq, int) const {
        const int row0 = u.pm * BM + (u.half == 2 ? HALF : 0) + wr * 64 + fr, col0 = u.pn * BM + wc * 32 + 4 * fq;
#pragma unroll
        for (int ai = 0; ai < 2; ++ai) if (ai == 0 || u.half == 0)
#pragma unroll
            for (int m = 0; m < 4; ++m) { const size_t off = (size_t)(row0 + ai * HALF + m * 16) * ldc + col0;
#pragma unroll
                for (int bj = 0; bj < 2; ++bj)
#pragma unroll
                    for (int n = 0; n < 2; ++n) { const f32x4 bs = *(const f32x4*)(base + off + bj * HALF + n * 16); *(f32x4*)(C + off + bj * HALF + n * 16) = bs + acc[ai][bj][m][n]; } }
    }
};
__device__ __forceinline__ f32x4 i2f(const i32x4 v) { return (f32x4){(float)v.x, (float)v.y, (float)v.z, (float)v.w}; }
__device__ __forceinline__ unsigned q4(const float a, const float b, const float c, const float d) {
    unsigned w = __builtin_amdgcn_cvt_pk_u8_f32(a + 128.0f, 0, 0u); w = __builtin_amdgcn_cvt_pk_u8_f32(b + 128.0f, 1, w); w = __builtin_amdgcn_cvt_pk_u8_f32(c + 128.0f, 2, w); w = __builtin_amdgcn_cvt_pk_u8_f32(d + 128.0f, 3, w);
    return w ^ 0x80808080u; }
typedef float f32x2p __attribute__((ext_vector_type(2)));
__device__ __forceinline__ f32x2p swiglu_q2(f32x2p gate, f32x2p up) {
    f32x2p g, uu; g.x = fminf(gate.x, 7.0f); g.y = fminf(gate.y, 7.0f); uu.x = __builtin_amdgcn_fmed3f(up.x, -7.0f, 7.0f); uu.y = __builtin_amdgcn_fmed3f(up.y, -7.0f, 7.0f);
    const f32x2p a = g * (-1.702f * 1.44269504f); f32x2p e; e.x = __builtin_amdgcn_exp2f(a.x); e.y = __builtin_amdgcn_exp2f(a.y);
    const f32x2p d = e + 1.0f; f32x2p r; r.x = __builtin_amdgcn_rcpf(d.x); r.y = __builtin_amdgcn_rcpf(d.y);
    const f32x2p t = g * r, uq = uu * ACT_Q + ACT_Q;
    return t * uq + 128.0f;
}
__device__ __forceinline__ unsigned pk_u8x4(f32x2p a, f32x2p b) {
    unsigned w = __builtin_amdgcn_cvt_pk_u8_f32(a.x, 0, 0u); w = __builtin_amdgcn_cvt_pk_u8_f32(a.y, 1, w); w = __builtin_amdgcn_cvt_pk_u8_f32(b.x, 2, w); w = __builtin_amdgcn_cvt_pk_u8_f32(b.y, 3, w); return w ^ 0x80808080u; }
struct EpGlu8 {
    static constexpr bool PERM = true; typedef i32x4 acc_t;
    signed char* act; const float* bg; const float* bu; const float* sgu; const LAS float* tsc; int nmine; mutable int ui; LAS unsigned char* epi;
    __device__ __forceinline__ void prefetch(const Unit& u, int slot, int wid) const {
        const int arr = wid >> 1, j = ((wid & 1) << 6) + flane();
        const float* pb = (arr == 0 ? bg : bu) + u.e * FF + u.pn * HALF + j; const float* ps = sgu + (size_t)u.e * 2048 + u.pn * BM + (arr == 3 ? HALF : 0) + j;
        __builtin_amdgcn_global_load_lds((const unsigned*)(arr < 2 ? pb : ps), (LAS unsigned*)(epi + slot * 2048 + wid * 256), 4, 0, 0); }
    __device__ __forceinline__ void operator()(const i32x4 (&acc)[2][2][4][2], const Unit& u, int wr, int wc, int fr, int fq, int slot) const {
        const int c0 = u.pn * HALF + wc * 32 + 8 * fq;
        const LAS f32x4* ev = (const LAS f32x4*)(epi + slot * 2048 + (wc * 32 + 8 * fq) * 4);
        f32x2p bgv[4], buv[4], sgv[4], suv[4];
#pragma unroll
        for (int hq = 0; hq < 2; ++hq) { const f32x4 b = ev[hq], bu4 = ev[32 + hq], sg4 = ev[64 + hq], su4 = ev[96 + hq];
            bgv[2 * hq] = (f32x2p){b.x, b.y}; bgv[2 * hq + 1] = (f32x2p){b.z, b.w}; buv[2 * hq] = (f32x2p){bu4.x, bu4.y}; buv[2 * hq + 1] = (f32x2p){bu4.z, bu4.w};
            sgv[2 * hq] = (f32x2p){sg4.x, sg4.y}; sgv[2 * hq + 1] = (f32x2p){sg4.z, sg4.w}; suv[2 * hq] = (f32x2p){su4.x, su4.y}; suv[2 * hq + 1] = (f32x2p){su4.z, su4.w}; }
        const LAS float* ts = tsc + (ui % nmine) * 256;
        float sav[2][4];
#pragma unroll
        for (int ai = 0; ai < 2; ++ai)
#pragma unroll
            for (int m = 0; m < 4; ++m) sav[ai][m] = ts[ai * HALF + wr * 64 + m * 16 + fr];
        asm volatile("s_waitcnt lgkmcnt(0)" ::: "memory");
#pragma unroll 1
        for (int rep_ = 0; rep_ < 1 + ((DUP_MASK >> 11) & 1); ++rep_)
#pragma unroll
        for (int ai = 0; ai < 2; ++ai)
#pragma unroll
            for (int m = 0; m < 4; ++m) { const int r = ai * HALF + wr * 64 + m * 16 + fr; const float sa = sav[ai][m];
                f32x2p o[4];
#pragma unroll
                for (int q = 0; q < 4; ++q) { const i32x4 ga = acc[ai][0][m][q >> 1], ua = acc[ai][1][m][q >> 1];
                    f32x2p gf, uf; if (q & 1) { gf.x = (float)ga.z; gf.y = (float)ga.w; uf.x = (float)ua.z; uf.y = (float)ua.w; } else { gf.x = (float)ga.x; gf.y = (float)ga.y; uf.x = (float)ua.x; uf.y = (float)ua.y; }
                    o[q] = swiglu_q2(gf * (sgv[q] * sa) + bgv[q], uf * (suv[q] * sa) + buv[q]); }
                const unsigned w0 = pk_u8x4(o[0], o[1]), w1 = pk_u8x4(o[2], o[3]);
                *(u32x2*)(act + (size_t)(u.pm * BM + r) * FF + c0) = (u32x2){w0, w1}; }
        ++ui;
    }
};
struct EpDown8 {
    static constexpr bool PERM = true; typedef i32x4 acc_t;
    unsigned char* ybuf; const float* bd; const float* sd; const LAS int* tok; const LAS float* tsc; int nmine; mutable int ui; LAS unsigned char* epi;
    __device__ __forceinline__ void prefetch(const Unit& u, int slot, int wid) const {
        const int j = ((wid & 3) << 6) + flane();
        __builtin_amdgcn_global_load_lds((const unsigned*)((wid < 4 ? bd : sd) + u.e * D + u.pn * BM + j), (LAS unsigned*)(epi + slot * 2048 + wid * 256), 4, 0, 0); }
    __device__ __forceinline__ void operator()(const i32x4 (&acc)[2][2][4][2], const Unit& u, int wr, int wc, int fr, int fq, int slot) const {
        const int c0 = u.pn * BM + wc * 32 + 8 * fq;
        const LAS f32x4* ev = (const LAS f32x4*)(epi + slot * 2048 + (wc * 32 + 8 * fq) * 4);
        f32x4 bv[2][2], sv[2][2];
#pragma unroll
        for (int bj = 0; bj < 2; ++bj)
#pragma unroll
            for (int n = 0; n < 2; ++n) { bv[bj][n] = ev[bj * 32 + n]; sv[bj][n] = ev[64 + bj * 32 + n] * ACT_SCALE; }
        int av[2][4]; float gwv[2][4];
#pragma unroll
        for (int ai = 0; ai < 2; ++ai)
#pragma unroll
            for (int m = 0; m < 4; ++m) { const int r = (u.half == 2 ? HALF : 0) + ai * HALF + wr * 64 + m * 16 + fr; const int rc = r < 256 ? r : 255;
                av[ai][m] = tok[(ui % nmine) * 256 + rc]; gwv[ai][m] = tsc[(ui % nmine) * 256 + rc] * Y_Q; }
        asm volatile("s_waitcnt lgkmcnt(0)" ::: "memory");
#pragma unroll
        for (int ai = 0; ai < 2; ++ai) if (ai == 0 || u.half == 0)
#pragma unroll
            for (int m = 0; m < 4; ++m) { const int r = (u.half == 2 ? HALF : 0) + ai * HALF + wr * 64 + m * 16 + fr;
                if (r < u.nv) { const int a = av[ai][m]; const float gw = gwv[ai][m]; unsigned char* rowp = ybuf + (size_t)a * D + c0;
#pragma unroll
                    for (int bj = 0; bj < 2; ++bj) { const f32x4 v0 = (i2f(acc[ai][bj][m][0]) * sv[bj][0] + bv[bj][0]) * gw + 128.0f, v1 = (i2f(acc[ai][bj][m][1]) * sv[bj][1] + bv[bj][1]) * gw + 128.0f;
                        u32x2 w; w.x = pk_u8x4((f32x2p){v0[0], v0[1]}, (f32x2p){v0[2], v0[3]}) ^ 0x80808080u; w.y = pk_u8x4((f32x2p){v1[0], v1[1]}, (f32x2p){v1[2], v1[3]}) ^ 0x80808080u;
                        *(u32x2*)(rowp + bj * HALF) = w; } } }
        ++ui;
    }
};

template <class Epi, class Sched, bool I8 = false, bool ALIGN_EPI = true>
__device__ __forceinline__ void gemm_phase(LAS unsigned char* lds, const Sched& S, const Epi& E, const int wid  ) {
    static_assert(Sched::ESZ_ == (I8 ? 1 : 2), "element size");
    typedef typename Epi::acc_t acc_t;
    const int lane = flane(), tid = wid * 64 + lane, wr = wid >> 2, wc = wid & 3, fr = lane & 15, fq = lane >> 4;
    const int K = S.K, PITCH = K * (I8 ? 1 : 2), nt = PITCH / (BK * 2);
    unsigned voffB[2], vA[2][2]; int Rr[2], Cc[2];
#pragma unroll
    for (int i = 0; i < 2; ++i) { int R, C; stage_rc(tid * 16 + i * 8192, R, C); const int Rb = Epi::PERM ? ((R & ~31) + perm32(R & 31)) : R;
        voffB[i] = (unsigned)(Rb * PITCH + C * 2); Rr[i] = R; Cc[i] = C; }
    const size_t kstep = (size_t)(BK * 2);
    const size_t hstep = (size_t)HALF * PITCH;
    const unsigned ldsw = (unsigned)wid * 1024u;
    const int aoff = lds_byte(wr * 64 + fr, fq * 8), boff = lds_byte(wc * 32 + fr, fq * 8);
#define PG8_SA(b, h) (((b) * 2 + (h)) * HTB)
#define PG8_SB(b, h) ((4 + (b) * 2 + (h)) * HTB)
#define PG8_STAGE(bufoff, gbase, voff) do { _Pragma("unroll") for (int _i = 0; _i < 2; ++_i) \
        __builtin_amdgcn_global_load_lds((const unsigned*)((const char*)(gbase) + (voff)[_i]), (LAS unsigned*)(lds + (bufoff) + ldsw + _i * 8192), 16, 0, 0); } while (0)
#define PG8_LDA(dst, b, h) do { _Pragma("unroll") for (int m = 0; m < 4; ++m) _Pragma("unroll") for (int k = 0; k < 2; ++k) dst[m][k] = *(const LAS bf16x8*)(lds + PG8_SA(b, h) + aoff + m * 2048 + k * 1024); } while (0)
#define PG8_LDB(dst, b, h) do { _Pragma("unroll") for (int n = 0; n < 2; ++n) _Pragma("unroll") for (int k = 0; k < 2; ++k) dst[n][k] = *(const LAS bf16x8*)(lds + PG8_SB(b, h) + boff + n * 2048 + k * 1024); } while (0)
#define PG8_MMA(ai, bj, At, Bt) do { __builtin_amdgcn_s_setprio(1); _Pragma("unroll") for (int m = 0; m < 4; ++m) _Pragma("unroll") for (int n = 0; n < 2; ++n) _Pragma("unroll") for (int k = 0; k < 2; ++k) \
        { if constexpr (I8) acc[ai][bj][m][n] = __builtin_amdgcn_mfma_i32_16x16x64_i8(__builtin_bit_cast(i32x4, Bt[n][k]), __builtin_bit_cast(i32x4, At[m][k]), acc[ai][bj][m][n], 0, 0, 0); \
          else acc[ai][bj][m][n] = __builtin_amdgcn_mfma_f32_16x16x32_bf16(Bt[n][k], At[m][k], acc[ai][bj][m][n], 0, 0, 0); } __builtin_amdgcn_s_setprio(0); } while (0)
#define PG8_WAIT_V(n) asm volatile("s_waitcnt vmcnt(" #n ")" ::: "memory")
#define PG8_WAIT_L(n) asm volatile("s_waitcnt lgkmcnt(" #n ")" ::: "memory")
#define PG8_BAR __builtin_amdgcn_s_barrier()
#define PG8_SCHED __builtin_amdgcn_sched_barrier(0)
    Unit cur, nxt; int ui = 0;
    if (!S.next(0, cur)) return;
    S.a_voff(0, Rr, Cc, vA);
    acc_t acc[2][2][4][2];
#pragma unroll
    for (int a = 0; a < 2; ++a)
#pragma unroll
        for (int b = 0; b < 2; ++b)
#pragma unroll
            for (int m = 0; m < 4; ++m)
#pragma unroll
                for (int n = 0; n < 2; ++n) acc[a][b][m][n] = (acc_t){0, 0, 0, 0};
    bf16x8 At[4][2], B0[2][2], B1[2][2];
    const char* cA = S.a_ptr(cur); const char* cB = S.b_ptr(cur);
    PG8_STAGE(PG8_SB(0, 0), cB, voffB); PG8_STAGE(PG8_SB(0, 1), cB + hstep, voffB); PG8_STAGE(PG8_SA(0, 0), cA, vA[0]); PG8_STAGE(PG8_SA(0, 1), cA, vA[1]);
    if (wr == 1) PG8_BAR;
    PG8_WAIT_V(2); PG8_BAR;
    PG8_STAGE(PG8_SB(1, 0), cB + kstep, voffB); PG8_STAGE(PG8_SA(1, 0), cA + kstep, vA[0]); PG8_STAGE(PG8_SB(1, 1), cB + hstep + kstep, voffB);
    PG8_WAIT_V(6); PG8_BAR;
    for (;;) {
        const bool has_next = S.next(ui + 1, nxt);
        E.prefetch(cur, ui & 1, wid);
        const bool hu = __builtin_amdgcn_readfirstlane(cur.half) != 0;
        const char* nA = has_next ? S.a_ptr(nxt) : cA; const char* nB = has_next ? S.b_ptr(nxt) : cB;
        constexpr int KP = (I8 && ((DUP_MASK >> 22) & 1)) ? 2 : 1;
#pragma unroll 1
        for (int kp = 0; kp < KP; ++kp)
#pragma unroll 1
        for (int t = 0; t < nt; t += 2) {
            const bool lastk = (t == nt - 2), last = lastk && (kp == KP - 1);
            const char* a1 = cA + (size_t)(t + 1) * kstep;
            const char* a2 = lastk ? (last ? nA : cA) : cA + (size_t)(t + 2) * kstep; const char* b2 = lastk ? (last ? nB : cB) : cB + (size_t)(t + 2) * kstep;
#define PG8_ZB() do { if (KP == 2 && kp == 0) { _Pragma("unroll") for (int n = 0; n < 2; ++n) _Pragma("unroll") for (int k = 0; k < 2; ++k) { B0[n][k] = (bf16x8){0,0,0,0,0,0,0,0}; B1[n][k] = (bf16x8){0,0,0,0,0,0,0,0}; } } } while (0)
            const char* a3 = a2 + kstep; const char* b3 = b2 + kstep;
            PG8_LDB(B0, 0, 0); PG8_LDB(B1, 0, 1); PG8_SCHED; PG8_LDA(At, 0, 0); PG8_STAGE(PG8_SA(1, 1), a1, vA[1]);
            if (Sched::GATHER) { if (last && has_next) S.a_voff(ui + 1, Rr, Cc, vA); }
            PG8_WAIT_V(8); PG8_WAIT_L(0); PG8_ZB(); PG8_BAR; PG8_MMA(0, 0, At, B0); PG8_MMA(0, 1, At, B1); PG8_BAR; PG8_SCHED;
            if (!hu) PG8_LDA(At, 0, 1); PG8_STAGE(PG8_SB(0, 0), b2, voffB); PG8_STAGE(PG8_SB(0, 1), b2 + hstep, voffB); PG8_STAGE(PG8_SA(0, 0), a2, vA[0]);
            PG8_WAIT_V(8); PG8_WAIT_L(0); PG8_BAR; if (!hu) { PG8_MMA(1, 0, At, B0); PG8_MMA(1, 1, At, B1); } PG8_BAR; PG8_SCHED;
            PG8_LDB(B0, 1, 0); PG8_LDB(B1, 1, 1); PG8_SCHED; PG8_LDA(At, 1, 0); PG8_STAGE(PG8_SA(0, 1), a2, vA[1]);
            PG8_WAIT_V(8); PG8_WAIT_L(0); PG8_ZB(); PG8_BAR; PG8_MMA(0, 0, At, B0); PG8_MMA(0, 1, At, B1); PG8_BAR; PG8_SCHED;
            if (!hu) PG8_LDA(At, 1, 1); PG8_STAGE(PG8_SB(1, 0), b3, voffB); PG8_STAGE(PG8_SB(1, 1), b3 + hstep, voffB); PG8_STAGE(PG8_SA(1, 0), a3, vA[0]);
            PG8_WAIT_V(8); PG8_WAIT_L(0); PG8_BAR; if (!hu) { PG8_MMA(1, 0, At, B0); PG8_MMA(1, 1, At, B1); } PG8_BAR; PG8_SCHED;
        }
        if constexpr (ALIGN_EPI) { if (wr == 0) PG8_BAR; }
        E(acc, cur, wr, wc, fr, fq, ui & 1);
        if (!has_next) break;
#pragma unroll
        for (int a = 0; a < 2; ++a)
#pragma unroll
            for (int b = 0; b < 2; ++b)
#pragma unroll
                for (int m = 0; m < 4; ++m)
#pragma unroll
                    for (int n = 0; n < 2; ++n) acc[a][b][m][n] = (acc_t){0, 0, 0, 0};
        cur = nxt; cA = nA; cB = nB; ++ui;
        if constexpr (ALIGN_EPI) { if (wr == 1) PG8_BAR; }
    }
    PG8_WAIT_V(0);
    if constexpr (!ALIGN_EPI) { if (wr == 0) PG8_BAR; }
    PG8_BAR;
#undef PG8_SA
#undef PG8_ZB
#undef PG8_SB
#undef PG8_STAGE
#undef PG8_LDA
#undef PG8_LDB
#undef PG8_MMA
#undef PG8_WAIT_V
#undef PG8_WAIT_L
#undef PG8_BAR
#undef PG8_SCHED
}
}

constexpr int NWAVES = 8, NTHR = 512;
struct Frame {
    LAS unsigned char* lds;
    int wave, vcu, G;
    const float* in[20]; float* out; unsigned char* ws;
};
struct Args { const float* in[20]; float* out; unsigned char* ws; int ph_lo, ph_hi; };
enum { I_X = 0, I_N1G, I_WIN, I_IGB, I_FGB, I_CONVW, I_HNG, I_POOLW, I_POOLS, I_WOUT, I_N2G, I_WR, I_BR, I_WG, I_BG, I_WU, I_BU, I_WD, I_BD, I_NFG };

#define LDS_WAIT() asm volatile("s_waitcnt lgkmcnt(0)" ::: "memory")

constexpr int QITEMS = NE * 3 * 32;
constexpr int QEXTRA = ((DUP_MASK >> 13) & 1) * 1024;
constexpr int QSTATIC = 0; static_assert(QSTATIC == 0, "the two-queue pull assumes no static share");
__device__ __forceinline__ void quant_item(const Frame& F, const int it, const int par) {
    const int lane = flane();
    signed char* wgu_q = (signed char*)(F.ws + WS_WGU); signed char* wd_q = (signed char*)(F.ws + WS_WD); float* sgu = (float*)(F.ws + WS_SGU); float* sd = (float*)(F.ws + WS_SD);
    LAS float* scr = (LAS float*)(F.lds + F.wave * 12800);
    LAS unsigned* tile = (LAS unsigned*)(F.lds + F.wave * 12800 + 8704);
    LAS float* cmax = (LAS float*)(F.lds + 8 * 12800);
    const int rsub = lane >> 3, cg = lane & 7, nn = lane & 31, kh = lane >> 5, k0 = 128 * F.wave;
    const float* const p_wg = F.in[I_WG]; const float* const p_wu = F.in[I_WU]; const float* const p_wd = F.in[I_WD];
    const int e = it / 96, r2 = it % 96, which = r2 >> 5, nb = r2 & 31;
    const float* mat = (which == 0 ? p_wg : (which == 1 ? p_wu : p_wd)) + (size_t)e * D * FF;
    const __amdgpu_buffer_rsrc_t rsrc = __builtin_amdgcn_make_buffer_rsrc((void*)mat, 0, D * FF * 4, 0x00020000);
    const int voff = ((k0 + rsub) * 1024 + 32 * nb + 4 * cg) * 4;
    f32x4 v[16];
#pragma unroll
    for (int i = 0; i < 16; ++i) v[i] = __builtin_bit_cast(f32x4, __builtin_amdgcn_raw_buffer_load_b128(rsrc, voff, i * 32768, 2  ));
    f32x4 m4 = {0.f, 0.f, 0.f, 0.f};
#pragma unroll
    for (int i = 0; i < 16; ++i) { m4.x = fmaxf(m4.x, fabsf(v[i].x)); m4.y = fmaxf(m4.y, fabsf(v[i].y)); m4.z = fmaxf(m4.z, fabsf(v[i].z)); m4.w = fmaxf(m4.w, fabsf(v[i].w)); }
#pragma unroll
    for (int o = 8; o < 64; o <<= 1) { m4.x = fmaxf(m4.x, __shfl_xor(m4.x, o)); m4.y = fmaxf(m4.y, __shfl_xor(m4.y, o)); m4.z = fmaxf(m4.z, __shfl_xor(m4.z, o)); m4.w = fmaxf(m4.w, __shfl_xor(m4.w, o)); }
    if (rsub == 0) *(LAS f32x4*)(cmax + (par * 8 + F.wave) * 32 + 4 * cg) = m4;
    __syncthreads();
    float M = 0.f;
#pragma unroll
    for (int w = 0; w < 8; ++w) M = fmaxf(M, cmax[(par * 8 + w) * 32 + nn]);
    const float inv = M > 0.f ? 127.0f / M : 0.f;
    { const int col = 32 * nb + nn, rowi = (which == 2) ? col : 256 * (col >> 7) + 128 * which + (col & 127);
      if (F.wave == 0 && kh == 0) { if (which == 2) sd[e * D + rowi] = M > 0.f ? M * (1.0f / 127.0f) : 1.0f; else sgu[e * 2048 + rowi] = M > 0.f ? M * (1.0f / 127.0f) : 1.0f; } }
#pragma unroll
    for (int half = 0; half < 2; ++half) {
#pragma unroll
        for (int i = 0; i < 8; ++i) { LAS float* d = scr + (8 * i + rsub) * 33 + 4 * cg; const f32x4 x = v[8 * half + i]; d[0] = x.x; d[1] = x.y; d[2] = x.z; d[3] = x.w; }
        LDS_WAIT(); asm volatile("" ::: "memory");
#pragma unroll
        for (int j = 0; j < 8; ++j) { const LAS float* sp = scr + (32 * kh + 4 * j) * 33 + nn;
            const unsigned w = pg8::q4(sp[0] * inv, sp[33] * inv, sp[66] * inv, sp[99] * inv);
            const int word = 16 * half + 8 * kh + j; tile[nn * 32 + (word ^ nn)] = w; }
        LDS_WAIT(); asm volatile("" ::: "memory");
    }
    signed char* dst = (which == 2) ? wd_q + (size_t)e * D * 1024 : wgu_q + (size_t)e * 2048 * 1024;
#pragma unroll
    for (int pss = 0; pss < 4; ++pss) { const int n = pss * 8 + (lane >> 3), j4 = lane & 7; u32x4 w;
        w.x = tile[n * 32 + ((4 * j4 + 0) ^ n)]; w.y = tile[n * 32 + ((4 * j4 + 1) ^ n)]; w.z = tile[n * 32 + ((4 * j4 + 2) ^ n)]; w.w = tile[n * 32 + ((4 * j4 + 3) ^ n)];
        const int coln = 32 * nb + n, rown = (which == 2) ? coln : 256 * (coln >> 7) + 128 * which + (coln & 127);
        *(u32x4*)(dst + (size_t)rown * 1024 + k0 + 16 * j4) = w; }
    LDS_WAIT(); asm volatile("" ::: "memory");
}
__device__ __forceinline__ bool quant_pull(const Frame& F, const int par, const int nq) {
    LAS unsigned* qw = (LAS unsigned*)(F.lds + LDS_BARW) + 2;
    if (F.wave == 0 && flane() == 0) { unsigned* qh = (unsigned*)(F.ws + WS_CTL) + CW_QHEAD;
        unsigned q = (unsigned)atomicAdd(qh, 1u), it = 0xffffffffu;
        if (q < (unsigned)(NE * 64 + QEXTRA)) { q %= (unsigned)(NE * 64); it = (q >> 6) * 96u + (q & 63u); }
        else if (nq > 1) { q = (unsigned)atomicAdd(qh + 64, 1u); if (q < (unsigned)(NE * 32)) it = (q >> 5) * 96u + 64u + (q & 31u); }
        qw[par] = it; }
    __syncthreads();
    const unsigned it = qw[par];
    if (it == 0xffffffffu) return false;
    quant_item(F, (int)it, par);
    return true;
}
__device__ __forceinline__ void xcd_barrier_fill(const XcdBarrier& b, const Frame& F) {
    asm volatile("s_waitcnt vmcnt(0)" ::: "memory");
    __syncthreads();
    LAS unsigned* st = (LAS unsigned*)(F.lds + LDS_BARW);
    const bool t0 = (F.wave == 0 && flane() == 0);
    if (t0) {
        unsigned* bar = b.bar;
        __builtin_amdgcn_s_waitcnt(0);
        unsigned nloc = b.st[0], nx = b.st[1];
        if (nloc == 0u) { xcd_barrier_complete(bar, b.x, nloc, nx); b.st[0] = nloc; b.st[1] = nx; }
        const unsigned old = xb_add(&bar[XB_XSUB(b.x)], 1u);
        const unsigned gen = old / nloc;
        if (old + 1u == (gen + 1u) * nloc) {
            __builtin_amdgcn_fence(__ATOMIC_RELEASE, "agent");
            asm volatile("s_waitcnt vmcnt(0)" ::: "memory");
            const unsigned og = xb_add(&bar[XB_TOP], 1u);
            const unsigned tg = og / nx;
            if (og + 1u == (tg + 1u) * nx) xb_add(&bar[XB_TOPGEN], 1u);
            else XB_SPIN(xb_ld(&bar[XB_TOPGEN]) == tg, bar);
            __builtin_amdgcn_fence(__ATOMIC_ACQUIRE, "agent");
            xb_add(&bar[XB_XGEN(b.x)], 1u);
            asm volatile("s_waitcnt vmcnt(0)" ::: "memory");
            st[2] = 0xffffffffu;
        } else { st[2] = 0u; st[3] = gen; }
    }
    __syncthreads();
    if (st[2] != 0xffffffffu) {
        const unsigned gen = st[3];
        LAS unsigned* rw = (LAS unsigned*)(F.lds + LDS_BARW + 32);
        __syncthreads();
        int par = 0;
        for (;;) {
            if (t0) rw[par] = (xb_ld(&b.bar[XB_XGEN(b.x)]) != gen) ? 1u : 0u;
            __syncthreads();
            if (rw[par]) break;
            if (!quant_pull(F, par, 2)) { if (t0) XB_SPIN(xb_ld(&b.bar[XB_XGEN(b.x)]) == gen, b.bar); break; }
            par ^= 1;
        }
        if (t0) { __builtin_amdgcn_fence(__ATOMIC_ACQUIRE, "agent"); asm volatile("s_waitcnt vmcnt(0)" ::: "memory"); }
    }
    __syncthreads();
}

__device__ __forceinline__ void p0_item_load(const float* __restrict__ W, int ldw, int col0, int k0, int lane, float (&wv)[32]) {
#pragma unroll
    for (int i = 0; i < 32; ++i) wv[i] = W[(size_t)(k0 + 2 * i + (lane >> 5)) * ldw + col0 + (lane & 31)];
}
__device__ __forceinline__ void p0_item_finish(const float (&wv)[32], const float* __restrict__ gk, bf16_t* wt, int k0, LAS float* scr, int lane) {
    const int c = lane & 7;
    f32x4 g0 = {1.f, 1.f, 1.f, 1.f}, g1 = {1.f, 1.f, 1.f, 1.f};
    if (gk) { g0 = *(const f32x4*)(gk + k0 + 8 * c); g1 = *(const f32x4*)(gk + k0 + 8 * c + 4); }
#pragma unroll
    for (int i = 0; i < 32; ++i) scr[(2 * i + (lane >> 5)) * 33 + (lane & 31)] = wv[i];
    LDS_WAIT(); asm volatile("" ::: "memory");
#pragma unroll
    for (int j = 0; j < 4; ++j) { const int n = (lane >> 3) + 8 * j; const LAS float* sp = scr + (8 * c) * 33 + n;
        u32x4 o; o.x = cvt_pk_bf16(sp[0 * 33] * g0.x, sp[1 * 33] * g0.y); o.y = cvt_pk_bf16(sp[2 * 33] * g0.z, sp[3 * 33] * g0.w); o.z = cvt_pk_bf16(sp[4 * 33] * g1.x, sp[5 * 33] * g1.y); o.w = cvt_pk_bf16(sp[6 * 33] * g1.z, sp[7 * 33] * g1.w);
        *(u32x4*)(wt + (size_t)n * 1024 + k0 + 8 * c) = o; }
    LDS_WAIT(); asm volatile("" ::: "memory");
}
#define P0_ITEM_OF(it_, W_, gk_, wt_, ldw_, col0_, k0_) \
    const bool in_ = (it_) < 16 * (NP / 32); const int q_ = in_ ? (it_) : (it_) - 16 * (NP / 32), nbk_ = in_ ? (NP / 32) : 32, kb_ = q_ / nbk_, nb_ = q_ % nbk_, n0_ = 32 * nb_; \
    const float* W_ = in_ ? p_win : p_wout; const float* gk_ = in_ ? p_g : nullptr; bf16_t* wt_ = (in_ ? win_t : wout_t) + (size_t)n0_ * 1024; \
    const int ldw_ = in_ ? NIN : D, col0_ = (in_ && n0_ >= 2048) ? n0_ + 8 : n0_, k0_ = 64 * kb_
__device__ __forceinline__ void phase0(Frame& F) {
    const int lane = flane(), tid = F.wave * 64 + lane;
    const int gw = F.vcu * NWAVES + F.wave, NGW = F.G * NWAVES;
    constexpr int NITEMS = 16 * (NP / 32) + 16 * 32;
    const int pi = blockIdx.x * NTHR + tid; float pwv = 0.f; const float* pw = F.in[I_POOLW];
    if (pi < 4 * 128 * 128) { const int g = pi >> 14, d = (pi >> 7) & 127, cc = pi & 127; pwv = pw[(g * 128 + cc) * 128 + d]; }
    const float* const p_win = F.in[I_WIN]; const float* const p_wout = F.in[I_WOUT]; const float* const p_g = F.in[I_N1G];
    bf16_t* const win_t = (bf16_t*)(F.ws + WS_WIN); bf16_t* const wout_t = (bf16_t*)(F.ws + WS_WOUT);
    float wv[32]; const bool have_item = gw < NITEMS; const int it_first = have_item ? gw : 0;
    P0_ITEM_OF(it_first, iW, igk, iwt, ildw, icol0, ik0);
    if (have_item) p0_item_load(iW, ildw, icol0, ik0, lane, wv);
    {
        LAS float* wgl = (LAS float*)(F.lds + 98304);
        const float* w_in = F.in[I_WIN]; const float* g1 = F.in[I_N1G];
        { float gwv[2][8], gg[2];
#pragma unroll
          for (int t = 0; t < 2; ++t) { const int sidx = tid + t * NTHR, j = sidx >> 8, q = (sidx >> 6) & 3, l = sidx & 63, k = 256 * j + 4 * l + q; gg[t] = g1[k];
#pragma unroll
              for (int i = 0; i < 8; ++i) gwv[t][i] = w_in[(size_t)k * NIN + 2048 + i]; }
#pragma unroll
          for (int t = 0; t < 2; ++t)
#pragma unroll
              for (int i = 0; i < 8; ++i) wgl[(tid + t * NTHR) * 8 + i] = gwv[t][i] * gg[t]; }
        __syncthreads();
        bf16_t* xb = (bf16_t*)(F.ws + WS_XB); float* rs1 = (float*)(F.ws + WS_RS1); float* gates = (float*)(F.ws + WS_GATES);
        const float* x = F.in[I_X];
        f32x4 nx[4];
        if (gw < T) { const f32x4* xr = (const f32x4*)(x + (size_t)gw * D) + lane;
#pragma unroll
            for (int j = 0; j < 4; ++j) nx[j] = xr[64 * j]; }
        for (int row = gw; row < T; row += NGW) {
            f32x4 v[4]; float ss = 0.f; float ga[8];
#pragma unroll
            for (int j = 0; j < 4; ++j) v[j] = nx[j];
            if (row + NGW < T) { const f32x4* xr = (const f32x4*)(x + (size_t)(row + NGW) * D) + lane;
#pragma unroll
                for (int j = 0; j < 4; ++j) nx[j] = xr[64 * j]; }
#pragma unroll
            for (int i = 0; i < 8; ++i) ga[i] = 0.f;
#pragma unroll
            for (int j = 0; j < 4; ++j) ss += (v[j].x * v[j].x + v[j].y * v[j].y) + (v[j].z * v[j].z + v[j].w * v[j].w);
#pragma unroll
            for (int j = 0; j < 4; ++j)
#pragma unroll
                for (int q = 0; q < 4; ++q) { const LAS f32x4* wp = (const LAS f32x4*)(wgl + (256 * j + 64 * q + lane) * 8); const f32x4 w0 = wp[0], w1 = wp[1]; const float xv = v[j][q];
                    ga[0] += xv * w0.x; ga[1] += xv * w0.y; ga[2] += xv * w0.z; ga[3] += xv * w0.w; ga[4] += xv * w1.x; ga[5] += xv * w1.y; ga[6] += xv * w1.z; ga[7] += xv * w1.w; }
            const float rs = rsqrtf(wave_sum(ss) * (1.f / D) + EPS);
            float mine = 0.f;
#pragma unroll
            for (int i = 0; i < 8; ++i) { const float sm = wave_sum(ga[i]); mine = (lane == i) ? sm : mine; }
            if (lane < 8) gates[(size_t)row * 8 + lane] = mine * rs;
            if (lane == 0) rs1[row] = rs;
            u32x2* o8 = (u32x2*)(xb + (size_t)row * D) + lane;
#pragma unroll
            for (int j = 0; j < 4; ++j) { u32x2 o; o.x = cvt_pk_bf16(v[j].x, v[j].y); o.y = cvt_pk_bf16(v[j].z, v[j].w); o8[64 * j] = o; }
        }
    }
    {
        LAS float* scr = (LAS float*)(F.lds + F.wave * 8704);
        if (have_item) p0_item_finish(wv, igk, iwt, ik0, scr, lane);
        for (int it = gw + NGW; it < NITEMS; it += NGW) { P0_ITEM_OF(it, tW, tgk, twt, tldw, tcol0, tk0); p0_item_load(tW, tldw, tcol0, tk0, lane, wv); p0_item_finish(wv, tgk, twt, tk0, scr, lane); }
    }
    if (pi < 4 * 128 * 128) { bf16_t* pwt = (bf16_t*)(F.ws + WS_POOLWT); pwt[pi] = (bf16_t)(cvt_pk_bf16(pwv, 0.f) & 0xffffu); }
    for (int i = pi + F.G * NTHR; i < 4 * 128 * 128; i += F.G * NTHR) { const int g = i >> 14, d = (i >> 7) & 127, cc = i & 127; ((bf16_t*)(F.ws + WS_POOLWT))[i] = (bf16_t)(cvt_pk_bf16(pw[(g * 128 + cc) * 128 + d], 0.f) & 0xffffu); }
    __syncthreads();
#pragma unroll 1
    for (int j = 0; j < QSTATIC * (1 + (DUP_MASK & 1)); ++j) quant_item(F, F.vcu + (j % (QSTATIC > 0 ? QSTATIC : 1)) * F.G, j & 1);
}

typedef short s16x4 __attribute__((ext_vector_type(4)));
typedef float f32x16 __attribute__((ext_vector_type(16)));
typedef float f32x8 __attribute__((ext_vector_type(8)));
typedef float f32x2 __attribute__((ext_vector_type(2)));
typedef __bf16 bfv8 __attribute__((ext_vector_type(8)));
typedef __bf16 bfv2 __attribute__((ext_vector_type(2)));
#define MFMA32(a, b, c) __builtin_amdgcn_mfma_f32_32x32x16_bf16((a), (b), (c), 0, 0, 0)
__device__ __forceinline__ bf16x8 pack8(float a0, float a1, float a2, float a3, float a4, float a5, float a6, float a7) {
    const f32x8 f = {a0, a1, a2, a3, a4, a5, a6, a7}; return __builtin_bit_cast(bf16x8, __builtin_convertvector(f, bfv8)); }
__device__ __forceinline__ unsigned pack2(float a, float b) { const f32x2 f = {a, b}; return __builtin_bit_cast(unsigned, __builtin_convertvector(f, bfv2)); }
__device__ __forceinline__ unsigned img_off(unsigned row, unsigned ch) { return 256u * row + 16u * (ch ^ (((row & 3u) << 2) | ((row >> 2) & 3u))); }
__device__ __forceinline__ bf16x8 img_rr(const LAS unsigned char* img, unsigned row0, unsigned lane, unsigned s) { return *(const LAS bf16x8*)(img + img_off(row0 + (lane & 31u), 2u * s + (lane >> 5))); }
__device__ __forceinline__ bf16x8 img_trn(const LAS unsigned char* img, unsigned k0, unsigned lane, unsigned c) {
    const unsigned h = lane >> 5, blk = (lane >> 4) & 1u, q = (lane & 15u) >> 2, p = lane & 3u, ch = 4u * c + 2u * blk + (p >> 1), sub = 8u * (p & 1u);
    const s16x4 lo = __builtin_amdgcn_ds_read_tr16_b64_v4i16((LAS s16x4*)(img + img_off(k0 + 8u * h + q, ch) + sub));
    const s16x4 hi = __builtin_amdgcn_ds_read_tr16_b64_v4i16((LAS s16x4*)(img + img_off(k0 + 8u * h + 4u + q, ch) + sub));
    return __builtin_shufflevector(lo, hi, 0, 1, 2, 3, 4, 5, 6, 7); }
__device__ __forceinline__ bf16x8 img_trp(const LAS unsigned char* img, unsigned k0, unsigned lane, unsigned c) {
    const unsigned h = lane >> 5, blk = (lane >> 4) & 1u, q = (lane & 15u) >> 2, p = lane & 3u, ch = 4u * c + 2u * blk + (p >> 1), sub = 8u * (p & 1u);
    const s16x4 lo = __builtin_amdgcn_ds_read_tr16_b64_v4i16((LAS s16x4*)(img + img_off(k0 + 4u * h + q, ch) + sub));
    const s16x4 hi = __builtin_amdgcn_ds_read_tr16_b64_v4i16((LAS s16x4*)(img + img_off(k0 + 8u + 4u * h + q, ch) + sub));
    return __builtin_shufflevector(lo, hi, 0, 1, 2, 3, 4, 5, 6, 7); }
__device__ __forceinline__ float wave_scan_add(float v, int) {
    v += dpp_old<0x111, 0xF>(0.f, v); v += dpp_old<0x112, 0xF>(0.f, v); v += dpp_old<0x114, 0xF>(0.f, v); v += dpp_old<0x118, 0xF>(0.f, v);
    v += dpp_old<0x142, 0xA>(0.f, v); v += dpp_old<0x143, 0xC>(0.f, v);
    return v; }
__device__ __forceinline__ float wave_scan_max(float v, int) {
    constexpr float NI = -3.0e38f;
    v = fmaxf(v, dpp_old<0x111, 0xF>(NI, v)); v = fmaxf(v, dpp_old<0x112, 0xF>(NI, v)); v = fmaxf(v, dpp_old<0x114, 0xF>(NI, v)); v = fmaxf(v, dpp_old<0x118, 0xF>(NI, v));
    v = fmaxf(v, dpp_old<0x142, 0xA>(NI, v)); v = fmaxf(v, dpp_old<0x143, 0xC>(NI, v));
    return v; }
__device__ __forceinline__ float wave_max(float v) {
    v = fmaxf(v, dpp_mov<0xB1>(v)); v = fmaxf(v, dpp_mov<0x4E>(v)); v = fmaxf(v, dpp_mov<0x141>(v)); v = fmaxf(v, dpp_mov<0x140>(v));
    return fmaxf(fmaxf(lane_bcast(v, 0), lane_bcast(v, 16)), fmaxf(lane_bcast(v, 32), lane_bcast(v, 48))); }
__device__ __forceinline__ void unpack8(const u32x4 w, float (&f)[8]) { f[0] = bflo(w.x); f[1] = bfhi(w.x); f[2] = bflo(w.y); f[3] = bfhi(w.y); f[4] = bflo(w.z); f[5] = bfhi(w.z); f[6] = bflo(w.w); f[7] = bfhi(w.w); }
__device__ __forceinline__ void conv2rows(const u32x4 (&pre)[5], const float (&cw)[4][8], float (&out)[2][8]) {
    float pf[5][8];
#pragma unroll
    for (int i = 0; i < 5; ++i) unpack8(pre[i], pf[i]);
#pragma unroll
    for (int rr = 0; rr < 2; ++rr)
#pragma unroll
        for (int e = 0; e < 8; ++e) { float a = 0.f;
#pragma unroll
            for (int j = 0; j < 4; ++j) a += pf[rr + j][e] * cw[j][e];
            out[rr][e] = a * fast_sigmoid(a); }
}
__device__ __forceinline__ void load_pre5(const bf16_t* __restrict__ P, int tok0, int c, int l0, int col, u32x4 (&pre)[5]) {
#pragma unroll
    for (int i = 0; i < 5; ++i) { const int l = l0 - 3 + i; pre[i] = (c * 64 + l >= 0) ? *(const u32x4*)(P + (size_t)(tok0 + l) * NP + col) : (u32x4){0u, 0u, 0u, 0u}; }
}
__device__ __forceinline__ void load_cw(const float* __restrict__ conv_w, int ch, float (&cw)[4][8]) {
#pragma unroll
    for (int j = 0; j < 4; ++j) { const f32x4 a = *(const f32x4*)(conv_w + j * 1024 + ch), b = *(const f32x4*)(conv_w + j * 1024 + ch + 4);
        cw[j][0] = a.x; cw[j][1] = a.y; cw[j][2] = a.z; cw[j][3] = a.w; cw[j][4] = b.x; cw[j][5] = b.y; cw[j][6] = b.z; cw[j][7] = b.w; }
}
constexpr float KSCALE = 0.08838834764831845f;

__device__ __forceinline__ void phase2_group(Frame& F) {
    const bf16_t* P = (const bf16_t*)(F.ws + WS_P); const float* gates = (const float*)(F.ws + WS_GATES); const float* conv_w = F.in[I_CONVW];
    u32x4* Cloc = (u32x4*)(F.ws + WS_CST); u32x4* Ctot = (u32x4*)(F.ws + WS_CIN); float* nst = (float*)(F.ws + WS_NST); float* mloc = (float*)(F.ws + WS_MLOC); float* btot = (float*)(F.ws + WS_BTOT);
    float* ntot = (float*)(F.ws + WS_NIN); float* mgrp = (float*)(F.ws + WS_MIN);
    LAS unsigned char* IMG_WK = F.lds; LAS unsigned char* IMG_V = F.lds + 16384; LAS float* s_w = (LAS float*)(F.lds + 32768);
    const int lane = flane(), wave = F.wave, tid = wave * 64 + lane, d8 = tid & 15, lq = tid >> 4, l0 = 2 * lq;
    u32x4 pre[5], vv[2]; float g_i = 0.f, g_f = 0.f;
#define P2_LOAD(uu) do { const int c_ = (uu) & 63, h_ = ((uu) >> 6) & 3, b_ = (uu) >> 8, tok0_ = b_ * SEQ + c_ * 64; \
        load_pre5(P, tok0_, c_, l0, 512 + h_ * 128 + 8 * d8, pre); \
        _Pragma("unroll") for (int rr = 0; rr < 2; ++rr) vv[rr] = *(const u32x4*)(P + (size_t)(tok0_ + l0 + rr) * NP + PC_V + h_ * 128 + 8 * d8); \
        if (wave == 0) { const float* pr_ = gates + (size_t)(tok0_ + lane) * 8; g_i = pr_[h_]; g_f = pr_[4 + h_]; } } while (0)
    for (int up = blockIdx.x; up < 256; up += F.G) {
        const int u0 = (up >> 4) * 64 + 4 * (up & 15), h = (up >> 4) & 3;
        P2_LOAD(u0);
        float cw[4][8]; load_cw(conv_w, 512 + h * 128 + 8 * d8, cw);
        const int a = wave >> 1, b0 = 2 * (wave & 1), r = lane & 31, hh = lane >> 5;
        f32x16 ct0, ct1, cn;
#pragma unroll
        for (int i = 0; i < 16; ++i) { ct0[i] = 0.f; ct1[i] = 0.f; cn[i] = 0.f; }
        float mg = -1e30f, Bg = 0.f;
#pragma unroll 1
        for (int cc = 0; cc < 4; ++cc) {
            const int u = u0 + cc;
            LAS float* sw = s_w + 128 * (cc & 1);
            if (wave == 0) { const float ig = g_i + F.in[I_IGB][h]; const float lf = logsigmoidf_(g_f + F.in[I_FGB][h]);
                const float bb = wave_scan_add(lf, lane); const float bt = lane_bcast(bb, 63); const float g = bt - bb + ig; const float m = wave_max(g);
                sw[lane] = expf(g - m); if (lane == 0) { mloc[u] = m; btot[u] = bt; sw[64] = m; sw[65] = bt; } }
            __syncthreads();
            const float ml = sw[64], bt = sw[65];
            { float kc[2][8]; conv2rows(pre, cw, kc);
#pragma unroll
              for (int rr = 0; rr < 2; ++rr) { const float w = sw[l0 + rr] * KSCALE;
                  *(LAS bf16x8*)(IMG_WK + img_off(l0 + rr, d8)) = pack8(kc[rr][0] * w, kc[rr][1] * w, kc[rr][2] * w, kc[rr][3] * w, kc[rr][4] * w, kc[rr][5] * w, kc[rr][6] * w, kc[rr][7] * w);
                  *(LAS u32x4*)(IMG_V + img_off(l0 + rr, d8)) = vv[rr]; } }
            __syncthreads();
            if (cc < 3) P2_LOAD(u + 1);
            f32x16 acc0, acc1, accn;
#pragma unroll
            for (int i = 0; i < 16; ++i) { acc0[i] = 0.f; acc1[i] = 0.f; accn[i] = 0.f; }
            const bf16x8 ones = {(short)0x3F80, (short)0x3F80, (short)0x3F80, (short)0x3F80, (short)0x3F80, (short)0x3F80, (short)0x3F80, (short)0x3F80};
#pragma unroll
            for (int ks = 0; ks < 4; ++ks) { const bf16x8 A = img_trn(IMG_WK, 16 * ks, lane, a);
                acc0 = MFMA32(A, img_trn(IMG_V, 16 * ks, lane, b0), acc0); acc1 = MFMA32(A, img_trn(IMG_V, 16 * ks, lane, b0 + 1), acc1);
                if (b0 == 0) accn = MFMA32(A, ones, accn); }
            if (b0 == 0 && r == 0) {
#pragma unroll
                for (int i = 0; i < 16; ++i) nst[(size_t)u * 128 + 32 * a + (i & 3) + 8 * (i >> 2) + 4 * hh] = accn[i]; }
            { u32x4* dst = Cloc + ((size_t)u * 8 + wave) * 256 + lane;
#pragma unroll
              for (int q = 0; q < 2; ++q) {
                  dst[q * 64] = (u32x4){pack2(acc0[8 * q], acc0[8 * q + 1]), pack2(acc0[8 * q + 2], acc0[8 * q + 3]), pack2(acc0[8 * q + 4], acc0[8 * q + 5]), pack2(acc0[8 * q + 6], acc0[8 * q + 7])};
                  dst[(2 + q) * 64] = (u32x4){pack2(acc1[8 * q], acc1[8 * q + 1]), pack2(acc1[8 * q + 2], acc1[8 * q + 3]), pack2(acc1[8 * q + 4], acc1[8 * q + 5]), pack2(acc1[8 * q + 6], acc1[8 * q + 7])}; } }
            { const float mn = fmaxf(bt + mg, ml), so = __expf(bt + mg - mn), sl = __expf(ml - mn);
#pragma unroll
              for (int i = 0; i < 16; ++i) { ct0[i] = so * ct0[i] + sl * acc0[i]; ct1[i] = so * ct1[i] + sl * acc1[i]; cn[i] = so * cn[i] + sl * accn[i]; }
              mg = mn; Bg += bt; }
        }
        { u32x4* dst = Ctot + ((size_t)up * 8 + wave) * 256 + lane;
#pragma unroll
          for (int q = 0; q < 2; ++q) {
              dst[q * 64] = (u32x4){pack2(ct0[8 * q], ct0[8 * q + 1]), pack2(ct0[8 * q + 2], ct0[8 * q + 3]), pack2(ct0[8 * q + 4], ct0[8 * q + 5]), pack2(ct0[8 * q + 6], ct0[8 * q + 7])};
              dst[(2 + q) * 64] = (u32x4){pack2(ct1[8 * q], ct1[8 * q + 1]), pack2(ct1[8 * q + 2], ct1[8 * q + 3]), pack2(ct1[8 * q + 4], ct1[8 * q + 5]), pack2(ct1[8 * q + 6], ct1[8 * q + 7])}; } }
        if (b0 == 0 && r == 0) {
#pragma unroll
            for (int i = 0; i < 16; ++i) ntot[(size_t)up * 128 + 32 * a + (i & 3) + 8 * (i >> 2) + 4 * hh] = cn[i]; }
        if (tid == 0) { mgrp[up] = mg; mgrp[256 + up] = Bg; }
        __syncthreads();
    }
#undef P2_LOAD
}
__device__ __forceinline__ void phase2_pool(Frame& F) {
    const bf16_t* P = (const bf16_t*)(F.ws + WS_P); bf16_t* ycat = (bf16_t*)(F.ws + WS_YCAT); const bf16_t* pwt = (const bf16_t*)(F.ws + WS_POOLWT); const float* pool_scale = F.in[I_POOLS];
    LAS unsigned char* IMG_PL = F.lds; LAS unsigned char* IMG_PW = F.lds + 16384; LAS unsigned char* STG = F.lds + 49152;
    const int lane = flane(), wave = F.wave, tid = wave * 64 + lane, d8 = tid & 15, lq = tid >> 4, l0 = 2 * lq;
    for (int u = blockIdx.x; u < 1024; u += F.G) {
        const int tok0 = (u >> 2) * 64, gi = u & 3, w = 2 << gi;
#pragma unroll
        for (int i = 0; i < 4; ++i) { const int idx = tid + i * NTHR, d = idx >> 4, j = idx & 15;
            *(LAS u32x4*)(IMG_PW + img_off(d, j)) = *(const u32x4*)(pwt + ((size_t)gi * 128 + d) * 128 + j * 8); }
        {
            const int s1 = ((tok0 + l0 + 1) & (SEQ - 1));
            const bf16_t* base = P + (size_t)(tok0 + l0 + 1) * NP + PC_U + gi * 128 + 8 * d8;
            u32x4 rw[17];
#pragma unroll
            for (int j = 0; j < 17; ++j) { int jj = j < w ? j : w; jj = jj < s1 ? jj : s1; rw[j] = *(const u32x4*)(base - (size_t)jj * NP); }
            float sum[8], cur0[8], cur1[8], old[8], f[8];
#pragma unroll
            for (int e = 0; e < 8; ++e) sum[e] = 0.f;
#pragma unroll
            for (int j = 2; j < 16; ++j) { const bool on = (j < w) && (s1 - j >= 0); unpack8(rw[j], f);
#pragma unroll
                for (int e = 0; e < 8; ++e) sum[e] += on ? f[e] : 0.f; }
            unpack8(rw[1], cur0); unpack8(rw[0], cur1);
            { const u32x4 ro = (w == 2) ? rw[2] : ((w == 4) ? rw[4] : ((w == 8) ? rw[8] : rw[16])); unpack8(ro, old); const bool on = (s1 - w >= 0);
#pragma unroll
              for (int e = 0; e < 8; ++e) old[e] = on ? old[e] : 0.f; }
            const int s0 = s1 - 1; const float ic0 = 1.f / (float)((s0 + 1 < w) ? s0 + 1 : w), ic1 = 1.f / (float)((s1 + 1 < w) ? s1 + 1 : w);
            float p0[8], p1[8];
#pragma unroll
            for (int e = 0; e < 8; ++e) { const float mid = sum[e] + cur0[e];
                p0[e] = (mid + old[e]) * ic0 - cur0[e]; p1[e] = (mid + cur1[e]) * ic1 - cur1[e]; }
            *(LAS bf16x8*)(IMG_PL + img_off(l0, d8)) = pack8(p0[0], p0[1], p0[2], p0[3], p0[4], p0[5], p0[6], p0[7]);
            *(LAS bf16x8*)(IMG_PL + img_off(l0 + 1, d8)) = pack8(p1[0], p1[1], p1[2], p1[3], p1[4], p1[5], p1[6], p1[7]);
        }
        __syncthreads();
        { const int wi = wave >> 2, wj = wave & 3, r = lane & 31, hh = lane >> 5;
          f32x16 acc;
#pragma unroll
          for (int i = 0; i < 16; ++i) acc[i] = 0.f;
#pragma unroll
          for (int sx = 0; sx < 8; ++sx) acc = MFMA32(img_rr(IMG_PL, 32 * wi, lane, sx), img_rr(IMG_PW, 32 * wj, lane, sx), acc);
          const int d = 32 * wj + r; const float sc = pool_scale[gi * 128 + d];
#pragma unroll
          for (int i = 0; i < 16; ++i) { const int l = 32 * wi + (i & 3) + 8 * (i >> 2) + 4 * hh;
              *(LAS unsigned short*)(STG + l * 256 + 2 * (d ^ ((l & 15) << 3))) = (unsigned short)(pack2(acc[i] * sc, 0.f) & 0xffffu); } }
        __syncthreads();
#pragma unroll
        for (int i = 0; i < 2; ++i) { const int idx = tid + i * NTHR, l = idx >> 4, j = idx & 15;
            *(u32x4*)(ycat + (size_t)(tok0 + l) * D + 512 + gi * 128 + j * 8) = *(const LAS u32x4*)(STG + l * 256 + ((j ^ (l & 15)) << 4)); }
        __syncthreads();
    }
}
__device__ __forceinline__ void state_axpy(f32x16& C0, f32x16& C1, const float so, const float sl, const u32x4 (&t)[4]) {
#pragma unroll
    for (int q = 0; q < 2; ++q) { float f[8]; unpack8(t[q], f);
#pragma unroll
        for (int e = 0; e < 8; ++e) C0[8 * q + e] = so * C0[8 * q + e] + sl * f[e];
        unpack8(t[2 + q], f);
#pragma unroll
        for (int e = 0; e < 8; ++e) C1[8 * q + e] = so * C1[8 * q + e] + sl * f[e]; }
}
__device__ __forceinline__ void phase4_group(Frame& F) {
    const bf16_t* P = (const bf16_t*)(F.ws + WS_P); const float* gates = (const float*)(F.ws + WS_GATES); const float* conv_w = F.in[I_CONVW]; const float* head_norm_g = F.in[I_HNG];
    const u32x4* Cloc = (const u32x4*)(F.ws + WS_CST); const u32x4* Ctot = (const u32x4*)(F.ws + WS_CIN); const float* nst = (const float*)(F.ws + WS_NST);
    const float* mloc = (const float*)(F.ws + WS_MLOC); const float* btot = (const float*)(F.ws + WS_BTOT); const float* ntot = (const float*)(F.ws + WS_NIN); const float* mgrp = (const float*)(F.ws + WS_MIN);
    bf16_t* ycat = (bf16_t*)(F.ws + WS_YCAT);
    LAS unsigned char* IMG_Q = F.lds; LAS unsigned char* IMG_K = F.lds + 16384; LAS unsigned char* IMG_V = F.lds + 32768; LAS unsigned char* IMG_C = F.lds + 49152;
    LAS float* HB = (LAS float*)(F.lds + 81920);
    LAS unsigned char* RAWQ = F.lds + 115712; LAS unsigned char* RAWK = RAWQ + 17408;
    LAS float* s_c = (LAS float*)(F.lds + 150528); LAS float* s_M = s_c + 64; LAS float* s_int = s_M + 64; LAS float* s_edn = s_int + 64; LAS float* s_qn = s_edn + 64; LAS float* s_rd = s_qn + 64;
    LAS float* s_n = s_rd + 256;
    const int lane = flane(), wave = F.wave, tid = wave * 64 + lane, d8 = tid & 15, lq = tid >> 4, l0 = 2 * lq;
#define P4_DMA_RAW(uu) do { const int c_ = (uu) & 63, h_ = ((uu) >> 6) & 3, b_ = (uu) >> 8, tok0_ = b_ * SEQ + c_ * 64; \
        _Pragma("unroll") for (int i = 0; i < 3; ++i) { const int pc = 8 * i + wave; if (pc < 17) { const int rr_ = pc * 4 + (lane >> 4); int tk = tok0_ - 3 + rr_; tk = tk < 0 ? 0 : (tk > T - 1 ? T - 1 : tk); \
            const char* src_ = (const char*)(P + (size_t)tk * NP + h_ * 128) + (lane & 15) * 16; \
            __builtin_amdgcn_global_load_lds((const unsigned*)src_, (LAS unsigned*)(RAWQ + pc * 1024), 16, 0, 0); \
            __builtin_amdgcn_global_load_lds((const unsigned*)(src_ + 1024), (LAS unsigned*)(RAWK + pc * 1024), 16, 0, 0); } } } while (0)
#define P4_DMA_V(uu) do { const int c_ = (uu) & 63, h_ = ((uu) >> 6) & 3, b_ = (uu) >> 8, tok0_ = b_ * SEQ + c_ * 64; const unsigned ol_ = (unsigned)olane(); \
        _Pragma("unroll") for (int i = 0; i < 2; ++i) { const unsigned d = (unsigned)((8 * i + wave) * 64) + ol_, row = d >> 4, sl = d & 15u, j = sl ^ (((row & 3u) << 2) | ((row >> 2) & 3u)); \
            __builtin_amdgcn_global_load_lds((const unsigned*)((const char*)(P + (size_t)(tok0_ + row) * NP + PC_V + h_ * 128) + j * 16), (LAS unsigned*)(IMG_V + (8 * i + wave) * 1024), 16, 0, 0); } } while (0)
    float g_i = 0.f, g_f = 0.f;
#define P4_GATES(uu) do { if (wave == 0) { const int c_ = (uu) & 63, h_ = ((uu) >> 6) & 3, b_ = (uu) >> 8; const float* pr_ = gates + (size_t)(b_ * SEQ + c_ * 64 + lane) * 8; g_i = pr_[h_]; g_f = pr_[4 + h_]; } } while (0)
    const int ca = wave >> 1, cb0 = 2 * (wave & 1), cr = lane & 31, chh = lane >> 5;
    {
        const int up = blockIdx.x; const int bh = up >> 4, g = up & 15, h = bh & 3, b = bh >> 2, u0 = bh * 64 + 4 * g;
        P4_DMA_RAW(u0); P4_DMA_V(u0); P4_GATES(u0);
        f32x16 C0, C1;
#pragma unroll
        for (int i = 0; i < 16; ++i) { C0[i] = 0.f; C1[i] = 0.f; }
        float m = 0.f, nv = 0.f;
        float mgv = -1e30f, Bgv = 0.f;
        if (lane < g) { mgv = mgrp[bh * 16 + lane]; Bgv = mgrp[256 + bh * 16 + lane]; }
#pragma unroll 1
        for (int j0 = 0; j0 < g; j0 += 8) {
            u32x4 t[8][4]; float nt[8];
#pragma unroll
            for (int jj = 0; jj < 8; ++jj) { const int j = (j0 + jj < g) ? j0 + jj : g - 1; const u32x4* src = Ctot + ((size_t)(bh * 16 + j) * 8 + wave) * 256 + lane;
#pragma unroll
                for (int q = 0; q < 4; ++q) t[jj][q] = src[q * 64];
                nt[jj] = (tid < 128) ? ntot[(size_t)(bh * 16 + j) * 128 + tid] : 0.f; }
#pragma unroll
            for (int jj = 0; jj < 8; ++jj) { const float mgj = lane_bcast(mgv, j0 + jj), Bgj = lane_bcast(Bgv, j0 + jj);
                const float mn = fmaxf(Bgj + m, mgj), so = __expf(Bgj + m - mn), sl = __expf(mgj - mn);
                state_axpy(C0, C1, so, sl, t[jj]); nv = so * nv + sl * nt[jj]; m = mn; }
        }
#pragma unroll
        for (int bb = 0; bb < 2; ++bb) { const unsigned dv = 32 * (cb0 + bb) + cr;
#pragma unroll
            for (int gq = 0; gq < 4; ++gq) { u32x2 w;
                if (bb == 0) { w.x = pack2(C0[4 * gq], C0[4 * gq + 1]); w.y = pack2(C0[4 * gq + 2], C0[4 * gq + 3]); } else { w.x = pack2(C1[4 * gq], C1[4 * gq + 1]); w.y = pack2(C1[4 * gq + 2], C1[4 * gq + 3]); }
                *(LAS u32x2*)(IMG_C + img_off(dv, 4 * ca + gq) + 8 * chh) = w; } }
#pragma unroll 1
        for (int cc = 0; cc < 4; ++cc) {
            const int u = u0 + cc, c = 4 * g + cc, tok0 = b * SEQ + c * 64;
            if (tid < 128) s_n[tid] = nv;
            float cwq[4][8], cwk[4][8]; load_cw(conv_w, h * 128 + 8 * d8, cwq); load_cw(conv_w, 512 + h * 128 + 8 * d8, cwk);
            asm volatile("s_waitcnt vmcnt(0)" ::: "memory");
            __syncthreads();
            if (wave == 0) { const float ig = g_i + F.in[I_IGB][h]; const float lf = logsigmoidf_(g_f + F.in[I_FGB][h]);
                const float bb = wave_scan_add(lf, lane); const float cc_ = ig - bb; const float M = fmaxf(m, wave_scan_max(cc_, lane));
                s_c[lane] = cc_; s_M[lane] = M; s_int[lane] = expf(m - M); s_edn[lane] = expf(-bb - M); }
            { u32x4 preq[5], prek[5];
              const f32x4 n0 = *(const LAS f32x4*)(s_n + 8 * d8), n1 = *(const LAS f32x4*)(s_n + 8 * d8 + 4);
#pragma unroll
              for (int i = 0; i < 5; ++i) { const bool ok = (c * 64 + l0 - 3 + i) >= 0; const u32x4 zq = *(const LAS u32x4*)(RAWQ + (l0 + i) * 256 + d8 * 16), zk = *(const LAS u32x4*)(RAWK + (l0 + i) * 256 + d8 * 16);
                  preq[i] = ok ? zq : (u32x4){0u, 0u, 0u, 0u}; prek[i] = ok ? zk : (u32x4){0u, 0u, 0u, 0u}; }
              float qc[2][8], kc[2][8]; conv2rows(preq, cwq, qc); conv2rows(prek, cwk, kc);
#pragma unroll
              for (int rr = 0; rr < 2; ++rr) {
                  *(LAS bf16x8*)(IMG_Q + img_off(l0 + rr, d8)) = pack8(qc[rr][0], qc[rr][1], qc[rr][2], qc[rr][3], qc[rr][4], qc[rr][5], qc[rr][6], qc[rr][7]);
                  *(LAS bf16x8*)(IMG_K + img_off(l0 + rr, d8)) = pack8(kc[rr][0] * KSCALE, kc[rr][1] * KSCALE, kc[rr][2] * KSCALE, kc[rr][3] * KSCALE, kc[rr][4] * KSCALE, kc[rr][5] * KSCALE, kc[rr][6] * KSCALE, kc[rr][7] * KSCALE);
                  float qn = (qc[rr][0] * n0.x + qc[rr][1] * n0.y) + (qc[rr][2] * n0.z + qc[rr][3] * n0.w) + (qc[rr][4] * n1.x + qc[rr][5] * n1.y) + (qc[rr][6] * n1.z + qc[rr][7] * n1.w);
                  qn = row16_sum(qn);
                  if (d8 == 0) s_qn[l0 + rr] = qn; } }
            __syncthreads();
            const bool more = (cc < 3);
            if (more) { P4_DMA_RAW(u + 1); P4_GATES(u + 1); }
            {
                const int wi = wave >> 2, wj = wave & 3, r = lane & 31, hh = lane >> 5, lcol = 32 * wi + r;
                const float Ml = s_M[lcol];
                bf16x8 pa[2][2]; float dsum = 0.f;
                bf16x8 qf[8];
#pragma unroll
                for (int sx = 0; sx < 8; ++sx) qf[sx] = img_rr(IMG_Q, 32 * wi, lane, sx);
#pragma unroll
                for (int rb = 0; rb < 2; ++rb) {
                    if (rb <= wi) {
                        f32x16 sa;
#pragma unroll
                        for (int i = 0; i < 16; ++i) sa[i] = 0.f;
                        { bf16x8 kf[8];
#pragma unroll
                          for (int sx = 0; sx < 8; ++sx) kf[sx] = img_rr(IMG_K, 32 * rb, lane, sx);
#pragma unroll
                          for (int sx = 0; sx < 8; ++sx) sa = MFMA32(kf[sx], qf[sx], sa); }
                        float pv[16];
#pragma unroll
                        for (int gq = 0; gq < 4; ++gq) { const f32x4 c4 = *(const LAS f32x4*)(s_c + 32 * rb + 8 * gq + 4 * hh);
#pragma unroll
                            for (int j = 0; j < 4; ++j) { const int rrow = 32 * rb + 8 * gq + 4 * hh + j; const float e = __expf(c4[j] - Ml);
                                const float v = (rrow <= lcol) ? sa[4 * gq + j] * e : 0.f; pv[4 * gq + j] = v; dsum += v; } }
                        pa[rb][0] = pack8(pv[0], pv[1], pv[2], pv[3], pv[4], pv[5], pv[6], pv[7]);
                        pa[rb][1] = pack8(pv[8], pv[9], pv[10], pv[11], pv[12], pv[13], pv[14], pv[15]);
                    }
                }
                dsum += __shfl_xor(dsum, 32);
                { const float den = dsum + s_int[lcol] * s_qn[lcol]; const float rd = 1.0f / fmaxf(fabsf(den), s_edn[lcol]); if (hh == 0) s_rd[wave * 32 + r] = rd; }
                f32x16 z, z2;
#pragma unroll
                for (int i = 0; i < 16; ++i) { z[i] = 0.f; z2[i] = 0.f; }
#pragma unroll
                for (int rb = 0; rb < 2; ++rb) if (rb <= wi) {
#pragma unroll
                    for (int sx = 0; sx < 2; ++sx) z = MFMA32(pa[rb][sx], img_trp(IMG_V, 32 * rb + 16 * sx, lane, wj), z); }
                { bf16x8 cf[8];
#pragma unroll
                  for (int sx = 0; sx < 8; ++sx) cf[sx] = img_rr(IMG_C, 32 * wj, lane, sx);
#pragma unroll
                  for (int sx = 0; sx < 8; ++sx) z2 = MFMA32(qf[sx], cf[sx], z2); }
#pragma unroll
                for (int gq = 0; gq < 4; ++gq) { const f32x4 rd4 = *(const LAS f32x4*)(s_rd + wave * 32 + 8 * gq + 4 * hh), in4 = *(const LAS f32x4*)(s_int + 32 * wi + 8 * gq + 4 * hh);
#pragma unroll
                    for (int j = 0; j < 4; ++j) HB[(32 * wi + 8 * gq + 4 * hh + j) * 132 + 32 * wj + r] = (z[4 * gq + j] + in4[j] * z2[4 * gq + j]) * rd4[j]; }
            }
            unsigned owc[8];
#pragma unroll
            for (int i = 0; i < 8; ++i) owc[i] = *(const unsigned*)(P + (size_t)(tok0 + wave * 8 + i) * NP + PC_O + h * 128 + 2 * lane);
            __syncthreads();
            u32x4 cl[4] = {{0u, 0u, 0u, 0u}, {0u, 0u, 0u, 0u}, {0u, 0u, 0u, 0u}, {0u, 0u, 0u, 0u}}; float nl = 0.f, ml = 0.f, bt = 0.f;
            if (more) { P4_DMA_V(u + 1);
                const u32x4* src = Cloc + ((size_t)u * 8 + wave) * 256 + olane();
#pragma unroll
                for (int q = 0; q < 4; ++q) cl[q] = src[q * 64];
                if (tid < 128) nl = nst[(size_t)u * 128 + tid];
                ml = mloc[u]; bt = btot[u]; }
            const f32x2 gg = *(const f32x2*)(head_norm_g + h * 128 + 2 * lane);
#pragma unroll
            for (int i = 0; i < 8; ++i) { const int l = wave * 8 + i; const f32x2 hv = *(const LAS f32x2*)(HB + l * 132 + 2 * lane);
                const float mu = wave_sum(hv.x + hv.y) * (1.f / 128.f); const float e0 = hv.x - mu, e1 = hv.y - mu;
                const float var = wave_sum(e0 * e0 + e1 * e1) * (1.f / 128.f); const float rstd = rsqrtf(var + EPS);
                *(unsigned*)(ycat + (size_t)(tok0 + l) * D + h * 128 + 2 * lane) = pack2(fast_sigmoid(bflo(owc[i])) * e0 * rstd * gg.x, fast_sigmoid(bfhi(owc[i])) * e1 * rstd * gg.y); }
            if (more) { const float mn = fmaxf(bt + m, ml), so = __expf(bt + m - mn), sl = __expf(ml - mn);
                const int ol = olane(), ocr = ol & 31, ochh = ol >> 5;
#pragma unroll
                for (int bb = 0; bb < 2; ++bb) { const unsigned dv = 32 * (cb0 + bb) + ocr;
#pragma unroll
                    for (int gq = 0; gq < 4; ++gq) { LAS u32x2* pp = (LAS u32x2*)(IMG_C + img_off(dv, 4 * ca + gq) + 8 * ochh); const u32x2 w = *pp;
                        const u32x4 cw4 = cl[2 * bb + (gq >> 1)]; const unsigned c0 = (gq & 1) ? cw4.z : cw4.x, c1 = (gq & 1) ? cw4.w : cw4.y;
                        u32x2 o; o.x = pack2(so * bflo(w.x) + sl * bflo(c0), so * bfhi(w.x) + sl * bfhi(c0)); o.y = pack2(so * bflo(w.y) + sl * bflo(c1), so * bfhi(w.y) + sl * bfhi(c1));
                        *pp = o; } }
                nv = so * nv + sl * nl; m = mn; }
        }
        asm volatile("s_waitcnt vmcnt(0)" ::: "memory");
        __syncthreads();
    }
#undef P4_DMA_RAW
#undef P4_DMA_V
#undef P4_GATES
}

__device__ __forceinline__ void phase6_route(Frame& F, const int probe_rep) {
    const int lane = flane(), wave = F.wave, tid = wave * 64 + lane;
    const float* x1 = (const float*)(F.ws + WS_X1); const float* g2 = F.in[I_N2G]; const float* w_router = F.in[I_WR]; const float* b_router = F.in[I_BR];
    signed char* h2 = (signed char*)(F.ws + WS_H2); float* shv = (float*)(F.ws + WS_SH); int* cnt0 = (int*)(F.ws + WS_CTL) + CW_CNT; int* list0 = (int*)(F.ws + WS_LIST); float* gate_of = (float*)(F.ws + WS_GATEOF);
    LAS unsigned char* WH = F.lds; LAS unsigned char* WL = F.lds + 65536;
    LAS float* LG = (LAS float*)(F.lds + LDS_TOK);
    LAS float* RST = LG + 64 * 33;
    LAS float* s_rs = RST + 256;
    LAS int* hist = (LAS int*)(F.lds + LDS_P6); LAS int* base = hist + 64; LAS int* s_e = base + 64; LAS int* s_t = s_e + 1024; LAS float* s_g = (LAS float*)(s_t + 256); LAS float* s_sh = s_g + 256;
    float* lsc = (float*)(F.ws + WS_LSC); float* lgw = (float*)(F.ws + WS_LGW);
    { const int e = tid & 31, kg = tid >> 5;
#pragma unroll 2
      for (int i = 0; i < 8; ++i) { const int c = kg + 16 * i; float w[8], wl[8];
#pragma unroll
          for (int j = 0; j < 8; ++j) { const int k = 8 * c + j; w[j] = w_router[(size_t)k * NE + e] * g2[k]; }
          const bf16x8 hi = pack8(w[0], w[1], w[2], w[3], w[4], w[5], w[6], w[7]);
#pragma unroll
          for (int j = 0; j < 8; ++j) wl[j] = w[j] - bf2f((unsigned short)hi[j]);
          const unsigned off = (unsigned)e * 2048u + 16u * (unsigned)(c ^ (e & 15));
          *(LAS bf16x8*)(WH + off) = hi; *(LAS bf16x8*)(WL + off) = pack8(wl[0], wl[1], wl[2], wl[3], wl[4], wl[5], wl[6], wl[7]); } }
    if (tid < 64) hist[tid] = 0;
    __syncthreads();
    const int t0 = 64 * F.vcu;
    const __amdgpu_buffer_rsrc_t x1rsrc = __builtin_amdgcn_make_buffer_rsrc((void*)x1, 0, T * D * 4, 0x00020000);
#pragma unroll 1
    for (int rep = 0; rep < probe_rep; ++rep) {
        {
            const int tb = wave >> 2, kq = wave & 3, r = lane & 31, h = lane >> 5;
            const int voff = (r * 1024 + 8 * h) * 4, sbase = ((t0 + 32 * tb) * 1024 + 256 * kq) * 4;
            f32x16 acc;
#pragma unroll
            for (int i = 0; i < 16; ++i) acc[i] = 0.f;
            float ss = 0.f;
#pragma unroll
            for (int sb = 0; sb < 16; sb += 8) {
                f32x4 xa[8][2];
#pragma unroll
                for (int sx = 0; sx < 8; ++sx) { xa[sx][0] = __builtin_bit_cast(f32x4, __builtin_amdgcn_raw_buffer_load_b128(x1rsrc, voff, sbase + (sb + sx) * 64, 0));
                    xa[sx][1] = __builtin_bit_cast(f32x4, __builtin_amdgcn_raw_buffer_load_b128(x1rsrc, voff, sbase + (sb + sx) * 64 + 16, 0)); }
#pragma unroll
                for (int sx = 0; sx < 8; ++sx) { const f32x4 p = xa[sx][0], q = xa[sx][1];
                    ss += ((p.x * p.x + p.y * p.y) + (p.z * p.z + p.w * p.w)) + ((q.x * q.x + q.y * q.y) + (q.z * q.z + q.w * q.w));
                    const bf16x8 ah = pack8(p.x, p.y, p.z, p.w, q.x, q.y, q.z, q.w);
                    const bf16x8 al = pack8(p.x - bf2f((unsigned short)ah[0]), p.y - bf2f((unsigned short)ah[1]), p.z - bf2f((unsigned short)ah[2]), p.w - bf2f((unsigned short)ah[3]),
                                            q.x - bf2f((unsigned short)ah[4]), q.y - bf2f((unsigned short)ah[5]), q.z - bf2f((unsigned short)ah[6]), q.w - bf2f((unsigned short)ah[7]));
                    const unsigned boff = (unsigned)r * 2048u + 16u * (unsigned)((32 * kq + 2 * (sb + sx) + h) ^ (r & 15));
                    const bf16x8 bh = *(const LAS bf16x8*)(WH + boff), bl = *(const LAS bf16x8*)(WL + boff);
                    acc = MFMA32(ah, bh, acc); acc = MFMA32(ah, bl, acc); acc = MFMA32(al, bh, acc); }
            }
            ss += __shfl_xor(ss, 32);
            if (h == 0) RST[(32 * tb + r) * 4 + kq] = ss;
#pragma unroll 1
            for (int q = 0; q < 4; ++q) {
                if (kq == q) {
#pragma unroll
                    for (int i = 0; i < 16; ++i) { LAS float* pp = LG + (32 * tb + (i & 3) + 8 * (i >> 2) + 4 * h) * 33 + r; *pp = (q == 0 ? 0.f : *pp) + acc[i]; } }
                __syncthreads();
            }
        }
        LAS int* hist_ = hist + 32 * rep;
        if (wave == 0) {
            const int t = t0 + lane;
            const float rs = rsqrtf(((RST[lane * 4] + RST[lane * 4 + 1]) + (RST[lane * 4 + 2] + RST[lane * 4 + 3])) * (1.f / D) + EPS);
            s_rs[lane] = rs;
            float lg[32];
#pragma unroll
            for (int e = 0; e < 32; ++e) lg[e] = LG[lane * 33 + e] * rs + b_router[e];
            int bi[4]; float bv[4];
#pragma unroll
            for (int k = 0; k < 4; ++k) { float best = -INFINITY; int bb = 0;
#pragma unroll
                for (int e = 0; e < 32; ++e) if (lg[e] > best) { best = lg[e]; bb = e; }
#pragma unroll
                for (int e = 0; e < 32; ++e) if (e == bb) lg[e] = -INFINITY;
                bi[k] = bb; bv[k] = best; }
            float ex[4], se = 0.f;
#pragma unroll
            for (int k = 0; k < 4; ++k) { ex[k] = expf(bv[k] - bv[0]); se += ex[k]; }
#pragma unroll
            for (int k = 0; k < 4; ++k) { const int lr = __hip_atomic_fetch_add(hist_ + bi[k], 1, __ATOMIC_RELAXED, __HIP_MEMORY_SCOPE_WORKGROUP);
                s_e[lane * 4 + k] = bi[k] | (lr << 8); s_g[lane * 4 + k] = ex[k] / se; }
            s_t[lane] = t;
        }
        __syncthreads();
        int nbase = 0;
        if (tid < 32) { const int n = hist_[tid]; nbase = n ? atomicAdd(cnt0 + (rep ? 8128 : 0) + tid * 64, n) : 0; }
        if (rep == 0) {
            f32x4 gg[4], nx[4];
#pragma unroll
            for (int j = 0; j < 4; ++j) { gg[j] = *(const f32x4*)(g2 + 256 * j + 4 * lane); nx[j] = ((const f32x4*)(x1 + (size_t)(t0 + wave * 8) * D) + lane)[64 * j]; }
#pragma unroll 1
            for (int i = 0; i < 8; ++i) {
                const int li = wave * 8 + i, t = t0 + li; const float rs = s_rs[li];
                f32x4 hv[4]; float hmax = 0.f;
#pragma unroll
                for (int j = 0; j < 4; ++j) { hv[j] = nx[j] * gg[j];
                    hmax = fmaxf(fmaxf(hmax, fmaxf(fabsf(hv[j].x), fabsf(hv[j].y))), fmaxf(fabsf(hv[j].z), fabsf(hv[j].w))); }
                if (i < 7) { const f32x4* xr = (const f32x4*)(x1 + (size_t)(t + 1) * D) + lane;
#pragma unroll
                    for (int j = 0; j < 4; ++j) nx[j] = xr[64 * j]; }
                hmax = wave_max(hmax);
                const float qi = hmax > 0.f ? 127.0f / hmax : 0.f; unsigned* o4 = (unsigned*)(h2 + (size_t)t * D) + lane;
#pragma unroll
                for (int j = 0; j < 4; ++j) { const f32x4 hq = hv[j] * qi; o4[64 * j] = pg8::q4(hq.x, hq.y, hq.z, hq.w); }
                if (lane == 0) { const float shval = hmax > 0.f ? hmax * rs * (1.0f / 127.0f) : 1.0f; shv[t] = shval; s_sh[li] = shval; }
            }
        }
        if (tid < 32) base[tid] = nbase;
        __syncthreads();
        if (tid < 256) { const int li = tid >> 2, k = tid & 3, t = s_t[li]; const int ew = s_e[tid], e = ew & 255, lr = ew >> 8; int* list = rep ? (int*)(F.ws + WS_ACT) : list0;
            list[e * T + base[e] + lr] = t * 4 + k;
            if (!rep) { gate_of[t * 4 + k] = s_g[tid]; lsc[e * T + base[e] + lr] = s_sh[li]; lgw[e * T + base[e] + lr] = s_g[tid]; } }
        __syncthreads();
    }
}

__device__ __forceinline__ int moe_tables(Frame& F) {
    LAS int* lcnt = (LAS int*)(F.lds + LDS_CNT); LAS int* ltp = (LAS int*)(F.lds + LDS_TP); LAS int* lte = (LAS int*)(F.lds + LDS_TE);
    const int* cnt = (const int*)(F.ws + WS_CTL) + CW_CNT;
    const int lane = flane();
    if (F.wave == 0) {
        const int c = lane < NE ? cnt[lane * 64] : 0, nt = (c + 255) >> 8;
        const int incl = (int)wave_scan_add((float)nt, lane);
        const int excl = incl - nt;
        if (lane < NE) { lcnt[lane] = c; ltp[lane] = excl; for (int j = 0; j < nt; ++j) lte[excl + j] = lane; }
        if (lane == NE - 1) ltp[NE] = incl;
    }
    __syncthreads();
    return ltp[NE];
}
template <int MODE, class Sched>
__device__ __forceinline__ void build_row_tables(Frame& F, const Sched& S) {
    const int* list = (const int*)(F.ws + WS_LIST); const float* vals = (const float*)(F.ws + (MODE == 0 ? WS_LSC : WS_LGW));
    LAS int* tok = (LAS int*)(F.lds + LDS_TOK); LAS float* tsc = (LAS float*)(F.lds + LDS_TSC);
    const int tid = F.wave * 64 + flane(); const int nent = (S.nmine < 10 ? S.nmine : 10) * 256;
    int a[5]; float v[5];
#pragma unroll
    for (int k = 0; k < 5; ++k) { const int idx = tid + k * NTHR; a[k] = -1; v[k] = 0.f;
        if (idx < nent) { pg8::Unit u; S.next(idx >> 8, u); const int r = idx & 255; if (r < u.nv) { a[k] = list[u.lbase + r]; v[k] = vals[u.lbase + r]; } } }
#pragma unroll
    for (int k = 0; k < 5; ++k) { const int idx = tid + k * NTHR; if (idx < nent) { tok[idx] = a[k] < 0 ? 0 : (MODE == 0 ? (a[k] >> 2) * D : a[k]); tsc[idx] = v[k]; } }
    __syncthreads();
}

__device__ __forceinline__ void phase9_final(Frame& F) {
    const float* x1 = (const float*)(F.ws + WS_X1); const unsigned char* ybuf = (const unsigned char*)(F.ws + WS_YBUF); const float* gf = F.in[I_NFG]; float* out = F.out;
    const int gw = F.vcu * NWAVES + F.wave, NGW = F.G * NWAVES, lane = flane();
    f32x4 gg[4];
#pragma unroll
    for (int j = 0; j < 4; ++j) gg[j] = *(const f32x4*)(gf + 256 * j + 4 * lane);
    for (int t = gw; t < T; t += 2 * NGW) {
        f32x4 v[2][4]; unsigned y[2][4][4];
#pragma unroll
        for (int q = 0; q < 2; ++q) { const int tq = (t + q * NGW < T) ? t + q * NGW : t; const f32x4* xr = (const f32x4*)(x1 + (size_t)tq * D) + lane;
#pragma unroll
            for (int j = 0; j < 4; ++j) v[q][j] = xr[64 * j];
#pragma unroll
            for (int k = 0; k < 4; ++k) { const unsigned* yr = (const unsigned*)(ybuf + (size_t)(tq * 4 + k) * D) + lane;
#pragma unroll
                for (int j = 0; j < 4; ++j) y[q][k][j] = yr[64 * j]; } }
#pragma unroll
        for (int q = 0; q < 2; ++q) { if (t + q * NGW < T) {
#pragma unroll
            for (int j = 0; j < 4; ++j) { f32x4 sb = {0.f, 0.f, 0.f, 0.f};
#pragma unroll
                for (int k = 0; k < 4; ++k) { const unsigned yy = y[q][k][j]; sb.x += (float)(yy & 255u); sb.y += (float)((yy >> 8) & 255u); sb.z += (float)((yy >> 16) & 255u); sb.w += (float)(yy >> 24); }
                v[q][j] = v[q][j] + (sb - 512.0f) * Y_SCALE; }
            float ss = 0.f;
#pragma unroll
            for (int j = 0; j < 4; ++j) ss += (v[q][j].x * v[q][j].x + v[q][j].y * v[q][j].y) + (v[q][j].z * v[q][j].z + v[q][j].w * v[q][j].w);
            const float rs = rsqrtf(wave_sum(ss) * (1.f / D) + EPS);
            f32x4* orow = (f32x4*)(out + (size_t)(t + q * NGW) * D) + lane;
#pragma unroll
            for (int j = 0; j < 4; ++j) orow[64 * j] = v[q][j] * rs * gg[j]; } }
    }
}

__global__ void __launch_bounds__(NTHR, 2) mega(Args args) {
    extern __shared__ __attribute__((aligned(16))) unsigned char lds_raw[];
    Frame F;
    F.lds = (LAS unsigned char*)lds_raw;
    F.wave = __builtin_amdgcn_readfirstlane((int)threadIdx.x >> 6);
    F.G = gridDim.x; { const int bx = blockIdx.x; F.vcu = (F.G % 8 == 0) ? (bx % 8) * (F.G / 8) + bx / 8 : bx; }
#pragma unroll
    for (int i = 0; i < 20; ++i) F.in[i] = args.in[i];
    F.out = args.out; F.ws = args.ws;
    if (threadIdx.x < 16) ((LAS unsigned*)(F.lds + LDS_BARW))[threadIdx.x] = 0u;
    __syncthreads();
    unsigned* ctl = (unsigned*)(F.ws + WS_CTL);
    XcdBarrier bar; bar.bar = ctl + CW_BAR; bar.x = 0; bar.st = nullptr;
    if (MK_N_LAUNCHES == 1) bar = xcd_barrier_post(ctl + CW_BAR, (volatile LAS unsigned*)(F.lds + LDS_BARW));
    const int lo = args.ph_lo, hi = args.ph_hi;
#define IN(k) (lo <= (k) && (k) < hi)
#define SEAM(k) do { if (IN(k) && IN((k) + 1)) { if ((k) <= 6) xcd_barrier_fill(bar, F); else xcd_barrier(bar, F.wave); if ((DUP_MASK >> 10) & 1) xcd_barrier(bar, F.wave); } } while (0)

    if (IN(0)) { REP(0) phase0(F); SEAM(0); }
    if (IN(1)) { {
        pg8::DenseSched S; S.init((const bf16_t*)(F.ws + WS_XB), (const bf16_t*)(F.ws + WS_WIN), T, NP, D, F.G, (int)blockIdx.x, 1 + ((DUP_MASK >> 1) & 1));
        pg8::EpRowScaleBf16 E{(bf16_t*)(F.ws + WS_P), NP, (const float*)(F.ws + WS_RS1), F.lds + LDS_EPI};
        pg8::gemm_phase(F.lds, S, E, F.wave); }
        SEAM(1);
    }
    if (IN(2)) { REP(2) { phase2_group(F); phase2_pool(F); } SEAM(2); }
    if (IN(4)) { REP(4) phase4_group(F); SEAM(4); }
    if (IN(5)) { {
        pg8::DenseSched S; S.init((const bf16_t*)(F.ws + WS_YCAT), (const bf16_t*)(F.ws + WS_WOUT), T, D, D, F.G, (int)blockIdx.x, 1 + ((DUP_MASK >> 5) & 1));
        pg8::EpResidF32 E{F.in[I_X], (float*)(F.ws + WS_X1), D};
        pg8::gemm_phase(F.lds, S, E, F.wave); }
        SEAM(5);
    }
    if (IN(6)) { phase6_route(F, 1 + ((DUP_MASK >> 6) & 1)); __syncthreads(); { int par = 0; while (quant_pull(F, par, 1)) par ^= 1; } SEAM(6); }
    if (IN(7)) {
        const int ntiles = moe_tables(F);
        pg8::MoeSched<true, 8, 1> S; S.A = (const void*)(F.ws + WS_H2); S.Bt = (const void*)(F.ws + WS_WGU); S.K = D; S.setup(ntiles * 8, F.G, (int)blockIdx.x, 1 + ((DUP_MASK >> 7) & 1), false);
        S.cnt = (const LAS int*)(F.lds + LDS_CNT); S.tp = (const LAS int*)(F.lds + LDS_TP); S.te = (const LAS int*)(F.lds + LDS_TE); S.tok = (const LAS int*)(F.lds + LDS_TOK);
        build_row_tables<0>(F, S);
        pg8::EpGlu8 E{(signed char*)(F.ws + WS_ACT), F.in[I_BG], F.in[I_BU], (const float*)(F.ws + WS_SGU), (const LAS float*)(F.lds + LDS_TSC), S.nmine > 0 ? S.nmine : 1, 0, F.lds + LDS_EPI};
        pg8::gemm_phase<pg8::EpGlu8, pg8::MoeSched<true, 8, 1>, true, MOE_ALIGN>(F.lds, S, E, F.wave);
        { int par = 0; while (quant_pull(F, par, 2)) par ^= 1; }
        SEAM(7);
    }
    if (IN(8)) {
        const int ntiles = IN(7) ? ((const LAS int*)(F.lds + LDS_TP))[NE] : moe_tables(F);
        pg8::MoeSched<false, 4, 1> S; S.A = (const void*)(F.ws + WS_ACT); S.Bt = (const void*)(F.ws + WS_WD); S.K = FF; S.setup(ntiles * 4, F.G, (int)blockIdx.x, 1 + ((DUP_MASK >> 8) & 1), true);
        S.cnt = (const LAS int*)(F.lds + LDS_CNT); S.tp = (const LAS int*)(F.lds + LDS_TP); S.te = (const LAS int*)(F.lds + LDS_TE); S.tok = (const LAS int*)(F.lds + LDS_TOK);
        build_row_tables<1>(F, S);
        pg8::EpDown8 E{(unsigned char*)(F.ws + WS_YBUF), F.in[I_BD], (const float*)(F.ws + WS_SD), (const LAS int*)(F.lds + LDS_TOK), (const LAS float*)(F.lds + LDS_TSC), S.nmine > 0 ? S.nmine : 1, 0, F.lds + LDS_EPI};
        pg8::gemm_phase<pg8::EpDown8, pg8::MoeSched<false, 4, 1>, true, MOE_ALIGN>(F.lds, S, E, F.wave);
        SEAM(8);
    }
    if (IN(9)) { REP(9) phase9_final(F); }
#undef IN
#undef SEAM
}

extern "C" void kernel_launch(void* const* d_in, const int* in_sizes, int n_in, void* d_out, int out_size, void* d_ws, size_t ws_size, hipStream_t stream) {
    static int grid = 0;
    if (grid == 0) {
        if (n_in != 20 || in_sizes[0] != T * D || out_size != T * D || ws_size < WS_END) { fprintf(stderr, "kernel_launch: unexpected problem (n_in %d, ws %zu)\n", n_in, ws_size); grid = -1; return; }
        int dev = 0, cus = 0, per_cu = 0;
        if (hipGetDevice(&dev) != hipSuccess || hipDeviceGetAttribute(&cus, hipDeviceAttributeMultiprocessorCount, dev) != hipSuccess) { grid = -1; return; }
        if (hipFuncSetAttribute((const void*)mega, hipFuncAttributeMaxDynamicSharedMemorySize, LDS_BYTES) != hipSuccess) { fprintf(stderr, "kernel_launch: hipFuncSetAttribute failed\n"); grid = -1; return; }
        if (hipOccupancyMaxActiveBlocksPerMultiprocessor(&per_cu, (const void*)mega, NTHR, LDS_BYTES) != hipSuccess || per_cu < 1) fprintf(stderr, "kernel_launch: occupancy query reports %d\n", per_cu);
        (void)hipGetLastError();
        if (cus != 256) { fprintf(stderr, "kernel_launch: built for a 256-CU device (one 64-token routing block and one workgroup per CU); found %d CUs, nothing launched\n", cus); grid = -1; return; }
        grid = cus;
    }
    if (grid < 0) return;
    (void)hipMemsetAsync((char*)d_ws + WS_CTL, 0, CTL_ZERO_BYTES, stream);
    Args a{};
    for (int i = 0; i < 20; ++i) a.in[i] = (const float*)d_in[i];
    a.out = (float*)d_out; a.ws = (unsigned char*)d_ws;
    if (MK_N_LAUNCHES == 1) { a.ph_lo = 0; a.ph_hi = N_PHASES; hipLaunchKernelGGL(mega, dim3(grid), dim3(NTHR), LDS_BYTES, stream, a); }
    else for (int p = 0; p < N_PHASES; ++p) { a.ph_lo = p; a.ph_hi = p + 1; hipLaunchKernelGGL(mega, dim3(grid), dim3(NTHR), LDS_BYTES, stream, a); }
}
```

```cpp
#include <hip/hip_runtime.h>
#include <cstdio>
#include <cstdint>

#ifndef MK_N_LAUNCHES
#define MK_N_LAUNCHES 1
#endif
constexpr int N_PHASES = 10;
constexpr bool MOE_ALIGN = true;
#ifndef DUP_MASK
#define DUP_MASK 0
#endif
#define REP(k) for (int rep_ = 0; rep_ < 1 + ((DUP_MASK >> (k)) & 1); ++rep_)

constexpr int T = 16384, D = 1024, SEQ = 4096;
constexpr int NIN = 2568;
constexpr int NP = 2560;
constexpr int NE = 32, FF = 1024;
constexpr float EPS = 1e-5f;
constexpr int PC_V = 1024, PC_O = 1536, PC_U = 2048;

#define GAS __attribute__((address_space(1)))
#define LAS __attribute__((address_space(3)))
typedef unsigned short bf16_t;
typedef short bf16x8 __attribute__((ext_vector_type(8)));
typedef float f32x4 __attribute__((ext_vector_type(4)));
typedef unsigned u32x4 __attribute__((ext_vector_type(4)));
typedef unsigned u32x2 __attribute__((ext_vector_type(2)));

__device__ __forceinline__ unsigned cvt_pk_bf16(float lo, float hi) { unsigned r; asm volatile("v_cvt_pk_bf16_f32 %0, %1, %2" : "=v"(r) : "v"(lo), "v"(hi)); return r; }
__device__ __forceinline__ float bf2f(unsigned short b) { return __uint_as_float(((unsigned)b) << 16); }
__device__ __forceinline__ float bflo(unsigned w) { return __uint_as_float(w << 16); }
__device__ __forceinline__ float bfhi(unsigned w) { return __uint_as_float(w & 0xffff0000u); }
template <int CTRL> __device__ __forceinline__ float dpp_mov(float v) { return __builtin_bit_cast(float, __builtin_amdgcn_update_dpp(0, __builtin_bit_cast(int, v), CTRL, 0xF, 0xF, true)); }
__device__ __forceinline__ float wave_sum(float v) {
    v += dpp_mov<0xB1>(v);
    v += dpp_mov<0x4E>(v);
    v += dpp_mov<0x141>(v);
    v += dpp_mov<0x140>(v);
    const int vi = __builtin_bit_cast(int, v);
    return (__builtin_bit_cast(float, __builtin_amdgcn_readlane(vi, 0)) + __builtin_bit_cast(float, __builtin_amdgcn_readlane(vi, 16)))
         + (__builtin_bit_cast(float, __builtin_amdgcn_readlane(vi, 32)) + __builtin_bit_cast(float, __builtin_amdgcn_readlane(vi, 48)));
}
template <int CTRL, int ROWMASK> __device__ __forceinline__ float dpp_old(float old, float v) { return __builtin_bit_cast(float, __builtin_amdgcn_update_dpp(__builtin_bit_cast(int, old), __builtin_bit_cast(int, v), CTRL, ROWMASK, 0xF, false)); }
__device__ __forceinline__ float lane_bcast(float v, int l) { return __builtin_bit_cast(float, __builtin_amdgcn_readlane(__builtin_bit_cast(int, v), l)); }
__device__ __forceinline__ float row16_sum(float v) { v += dpp_mov<0xB1>(v); v += dpp_mov<0x4E>(v); v += dpp_mov<0x141>(v); v += dpp_mov<0x140>(v); return v; }
__device__ __forceinline__ float logsigmoidf_(float x) { return fminf(x, 0.f) - log1pf(expf(-fabsf(x))); }
__device__ __forceinline__ float sigmoidf_(float x) { return 1.f / (1.f + expf(-x)); }
__device__ __forceinline__ float fast_sigmoid(float x) { return __builtin_amdgcn_rcpf(1.0f + __builtin_amdgcn_exp2f(-1.44269504f * x)); }

__device__ __forceinline__ int flane() { return (int)__builtin_amdgcn_mbcnt_hi(~0u, __builtin_amdgcn_mbcnt_lo(~0u, 0u)); }
__device__ __forceinline__ int olane() { int v; asm volatile("v_mbcnt_lo_u32_b32 %0, -1, 0\n\tv_mbcnt_hi_u32_b32 %0, -1, %0" : "=v"(v)); return v; }

constexpr size_t MiB = 1u << 20;
constexpr size_t WS_CTL = 0, CTL_ZERO_BYTES = 1 * MiB;
constexpr size_t WS_WIN = 1 * MiB;
constexpr size_t WS_WOUT = 6 * MiB;
constexpr size_t WS_WGU = 8 * MiB;
constexpr size_t WS_WD = 72 * MiB;
constexpr size_t WS_SGU = 104 * MiB;
constexpr size_t WS_SD = WS_SGU + 512 * 1024;
constexpr size_t WS_X1 = 105 * MiB;
constexpr size_t WS_CST = 105 * MiB;
constexpr size_t WS_CIN = 137 * MiB;
constexpr size_t WS_ACT = 169 * MiB;
constexpr size_t WS_YBUF = 241 * MiB;
constexpr size_t WS_P = 169 * MiB;
constexpr size_t WS_XB = 249 * MiB;
constexpr size_t WS_YCAT = 281 * MiB;
constexpr size_t WS_H2 = 369 * MiB;
constexpr size_t WS_SM = 385 * MiB;
constexpr size_t WS_RS1 = WS_SM, WS_GATES = WS_SM + 64 * 1024, WS_NST = WS_GATES + 512 * 1024, WS_MLOC = WS_NST + 512 * 1024, WS_BTOT = WS_MLOC + 4096, WS_MIN = WS_BTOT + 4096, WS_SH = WS_SM + 1280 * 1024, WS_NIN = WS_SM + 2560 * 1024,
                 WS_POOLWT = WS_SM + 1536 * 1024, WS_GATEOF = WS_SM + 2 * MiB, WS_LIST = WS_SM + 3 * MiB, WS_LSC = WS_LIST + (size_t)NE * T * 4, WS_LGW = WS_LSC + (size_t)NE * T * 4, WS_END = WS_LGW + (size_t)NE * T * 4;
static_assert(WS_END <= 396 * MiB, "ws map");
constexpr float ACT_CLIP = 16.0f, ACT_Q = 127.0f / ACT_CLIP, ACT_SCALE = ACT_CLIP / 127.0f;
constexpr float Y_CLIP = 3.0f, Y_Q = 127.0f / Y_CLIP, Y_SCALE = Y_CLIP / 127.0f;
constexpr int CW_CNT = 64;
constexpr int CW_BAR = 4096;
constexpr int CW_QHEAD = 24;

constexpr int RING_BYTES = 131072;
constexpr int LDS_TOK = RING_BYTES;
constexpr int LDS_TSC = LDS_TOK + 10 * 1024;
constexpr int LDS_CNT = LDS_TSC + 10 * 1024;
constexpr int LDS_TP = LDS_CNT + 128;
constexpr int LDS_TE = LDS_TP + 192;
constexpr int LDS_P6 = 153600;
constexpr int LDS_EPI = 153600;
constexpr int LDS_BARW = 163776;
constexpr int LDS_BYTES = 163840;
static_assert(LDS_TE + 1280 <= LDS_P6 && LDS_P6 + 9728 <= LDS_BARW, "LDS map");
constexpr int WR_LANE_STRIDE = 2064;

#define XB_TMO      128
#define XB_XCNT(j)  (256  + 64 * (j))
#define XB_XSUB(j)  (1280 + 64 * (j))
#define XB_XGEN(j)  (2304 + 64 * (j))
#define XB_TOP      3328
#define XB_TOPGEN   3392
#define XCD_BAR_WORDS 3456
#define XB_SPIN_CAP (1u << 18)
__device__ __forceinline__ unsigned xb_ld(unsigned* p)              { return __hip_atomic_load(p, __ATOMIC_RELAXED, __HIP_MEMORY_SCOPE_AGENT); }
__device__ __forceinline__ unsigned xb_add(unsigned* p, unsigned v) { return __hip_atomic_fetch_add(p, v, __ATOMIC_RELAXED, __HIP_MEMORY_SCOPE_AGENT); }
__device__ __forceinline__ unsigned xb_xcc_id() { return (unsigned)__builtin_amdgcn_s_getreg((3 << 11) | 20) & 0xFu; }
#define XB_SPIN(cond, bar) do { unsigned _sp = 0; while (cond) { __builtin_amdgcn_s_sleep(1); \
    if ((++_sp & 255u) == 0u) { if (xb_ld(&(bar)[XB_TMO])) break; if (_sp > XB_SPIN_CAP) { atomicAdd(&(bar)[XB_TMO], 1u); break; } } } } while (0)
struct XcdBarrier { unsigned* bar; unsigned x; volatile LAS unsigned* st; };
__device__ __forceinline__ XcdBarrier xcd_barrier_post(unsigned* bar, volatile LAS unsigned* st) {
    XcdBarrier b; b.bar = bar; b.x = xb_xcc_id(); b.st = st;
    if (threadIdx.x == 0) (void)xb_add(&bar[XB_XCNT(b.x)], 1u);
    return b;
}
__device__ __forceinline__ void xcd_barrier_complete(unsigned* bar, unsigned x, unsigned& nloc, unsigned& nx) {
    const unsigned G = gridDim.x * gridDim.y * gridDim.z;
    unsigned sum, cnt, mine, sp = 0u;
    for (;;) {
        sum = 0u; cnt = 0u; mine = 0u;
#pragma unroll
        for (unsigned j = 0; j < 16; ++j) { const unsigned c = xb_ld(&bar[XB_XCNT(j)]); sum += c; cnt += (c > 0u) ? 1u : 0u; mine = (j == x) ? c : mine; }
        if (sum == G) break;
        __builtin_amdgcn_s_sleep(1);
        if ((++sp & 255u) == 0u) { if (xb_ld(&bar[XB_TMO])) break; if (sp > XB_SPIN_CAP) { atomicAdd(&bar[XB_TMO], 1u); break; } }
    }
    nloc = mine > 0u ? mine : 1u; nx = cnt > 0u ? cnt : 1u;
}
__device__ __forceinline__ void xcd_barrier(const XcdBarrier& b, const int wave) {
    asm volatile("s_waitcnt vmcnt(0)" ::: "memory");
    __syncthreads();
    if (wave == 0 && flane() == 0) {
        unsigned* bar = b.bar;
        __builtin_amdgcn_s_waitcnt(0);
        unsigned nloc = b.st[0], nx = b.st[1];
        if (nloc == 0u) { xcd_barrier_complete(bar, b.x, nloc, nx); b.st[0] = nloc; b.st[1] = nx; }
        const unsigned old = xb_add(&bar[XB_XSUB(b.x)], 1u);
        const unsigned gen = old / nloc;
        if (old + 1u == (gen + 1u) * nloc) {
            __builtin_amdgcn_fence(__ATOMIC_RELEASE, "agent");
            asm volatile("s_waitcnt vmcnt(0)" ::: "memory");
            const unsigned og = xb_add(&bar[XB_TOP], 1u);
            const unsigned tg = og / nx;
            if (og + 1u == (tg + 1u) * nx) xb_add(&bar[XB_TOPGEN], 1u);
            else XB_SPIN(xb_ld(&bar[XB_TOPGEN]) == tg, bar);
            __builtin_amdgcn_fence(__ATOMIC_ACQUIRE, "agent");
            xb_add(&bar[XB_XGEN(b.x)], 1u);
            asm volatile("s_waitcnt vmcnt(0)" ::: "memory");
        } else {
            XB_SPIN(xb_ld(&bar[XB_XGEN(b.x)]) == gen, bar);
            __builtin_amdgcn_fence(__ATOMIC_ACQUIRE, "agent");
            asm volatile("s_waitcnt vmcnt(0)" ::: "memory");
        }
    }
    __syncthreads();
}

namespace pg8 {
typedef int i32x4 __attribute__((ext_vector_type(4)));
constexpr int BM = 256, BK = 64, HALF = 128, HTB = HALF * BK * 2, STAGE_BYTES = 8 * HTB, NXCD = 8, WGM = 8;
__host__ __device__ __forceinline__ int lds_byte(int r, int c) { const int st = (r >> 4) * 2 + (c >> 5), rr = r & 15, cc = c & 31, ob = rr * 64 + cc * 2; return st * 1024 + (ob ^ (((ob >> 9) & 1) << 5)); }
__host__ __device__ __forceinline__ void stage_rc(int b, int& R, int& C) { const int st = b / 1024, sb = b % 1024, swz = sb ^ (((sb >> 9) & 1) << 5); R = (st >> 1) * 16 + swz / 64; C = (st & 1) * 32 + (swz % 64) / 2; }
__host__ __device__ __forceinline__ int perm32(int rho) { const int n = rho >> 4, i = rho & 15; return 8 * (i >> 2) + 4 * n + (i & 3); }

struct Unit { int pm, pn, e, nv, lbase, half; };

struct DenseSched {
    static constexpr bool GATHER = false; static constexpr int ESZ_ = 2;
    const bf16_t* A; const bf16_t* Bt; int K; int nM, nN, nwg, G, c, nmine, nrep, nfull, split;
    __device__ __forceinline__ void init(const bf16_t* A_, const bf16_t* Bt_, int M, int N, int K_, int G_, int c_, int nrep_) { A = A_; Bt = Bt_; K = K_; nM = M / BM; nN = N / BM; nwg = nM * nN; G = G_; c = c_; nrep = nrep_;
        nfull = (nwg / G) * G; const int rest = nwg - nfull; split = (rest > 0 && 2 * rest <= G) ? 1 : 0;
        const int ntot = split ? nfull + 2 * rest : nwg; nmine = ntot > c ? (ntot - c + G - 1) / G : 0; }
    __device__ __forceinline__ bool next(int i, Unit& u) const {
        if (i >= nmine * nrep) return false; const int L = (i % nmine) * G + c;
        int wgid = L, half = 0;
        if (split && L >= nfull) { wgid = nfull + ((L - nfull) >> 1); half = 1 + ((L - nfull) & 1); }
        { const int q = nwg / NXCD, r = nwg % NXCD, xcd = wgid % NXCD, off = wgid / NXCD; wgid = (xcd < r ? xcd * (q + 1) : r * (q + 1) + (xcd - r) * q) + off; }
        const int nig = WGM * nN, gid = wgid / nig, fm = gid * WGM, gsz = (nM - fm) < WGM ? (nM - fm) : WGM;
        u.pm = fm + ((wgid % nig) % gsz); u.pn = (wgid % nig) / gsz; u.e = 0; u.nv = 256; u.lbase = 0; u.half = half; return true;
    }
    __device__ __forceinline__ const char* a_ptr(const Unit& u) const { return (const char*)A + ((size_t)u.pm * BM + (u.half == 2 ? HALF : 0)) * (size_t)2 * K; }
    __device__ __forceinline__ const char* b_ptr(const Unit& u) const { return (const char*)Bt + (size_t)u.pn * (size_t)(BM * 2) * K; }
    __device__ __forceinline__ void a_voff(int, const int (&R)[2], const int (&C)[2], unsigned (&vA)[2][2]) const {
#pragma unroll
        for (int h = 0; h < 2; ++h)
#pragma unroll
            for (int i = 0; i < 2; ++i) vA[h][i] = (unsigned)((h * HALF + R[i]) * K + C[i]) * 2u;
    }
};
template <bool GATHER_, int NT  , int ESZ  >
struct MoeSched {
    static constexpr bool GATHER = GATHER_;
    static constexpr int ESZ_ = ESZ;
    const void* A; const void* Bt; int K; int G, c, nunits, nmine, nrep, nfull, split;
    const LAS int* cnt; const LAS int* tp; const LAS int* te; const LAS int* tok;
    __device__ __forceinline__ bool next(int i, Unit& u) const {
        if (i >= nmine * nrep) return false; const int L = (i % nmine) * G + c;
        int wg = L, half = 0;
        if (split && L >= nfull) { wg = nfull + ((L - nfull) >> 1); half = 1 + ((L - nfull) & 1); }
        const int q = nunits / NXCD, r = nunits % NXCD, xcd = wg % NXCD, off = wg / NXCD;
        const int w = (xcd < r ? xcd * (q + 1) : r * (q + 1) + (xcd - r) * q) + off;
        const int tt = w / NT; u.pm = tt; u.pn = w % NT; u.half = half;
        const int e = __builtin_amdgcn_readfirstlane(te[tt]); u.e = e; const int j = tt - __builtin_amdgcn_readfirstlane(tp[e]); const int left = __builtin_amdgcn_readfirstlane(cnt[e]) - j * 256; u.nv = left < 256 ? left : 256; u.lbase = e * T + j * 256; return true;
    }
    __device__ __forceinline__ void setup(int nunits_, int G_, int c_, int nrep_, bool allow_split) { nunits = nunits_; G = G_; c = c_; nrep = nrep_;
        nfull = (nunits / G) * G; const int rest = nunits - nfull; split = (allow_split && rest > 0 && 2 * rest <= G) ? 1 : 0;
        const int ntot = split ? nfull + 2 * rest : nunits; nmine = ntot > c ? (ntot - c + G - 1) / G : 0; }
    __device__ __forceinline__ const char* a_ptr(const Unit& u) const { return GATHER ? (const char*)A : (const char*)A + ((size_t)u.pm * BM + (u.half == 2 ? HALF : 0)) * (size_t)ESZ * K; }
    __device__ __forceinline__ const char* b_ptr(const Unit& u) const { return (const char*)Bt + ((size_t)u.e * NT + u.pn) * (size_t)(BM * ESZ) * K; }
    __device__ __forceinline__ void a_voff(int ui, const int (&R)[2], const int (&C)[2], unsigned (&vA)[2][2]) const {
#pragma unroll
        for (int h = 0; h < 2; ++h)
#pragma unroll
            for (int i = 0; i < 2; ++i) vA[h][i] = GATHER ? (unsigned)tok[(ui % nmine) * 256 + h * HALF + R[i]] + (unsigned)C[i] * 2u : (unsigned)((h * HALF + R[i]) * K * ESZ + C[i] * 2);
    }
};

struct EpRowScaleBf16 {
    static constexpr bool PERM = true; typedef f32x4 acc_t;
    bf16_t* O; int ldc; const float* rs; LAS unsigned char* epi;
    __device__ __forceinline__ void prefetch(const Unit& u, int slot, int wid) const {
        if (wid < 4) __builtin_amdgcn_global_load_lds((const unsigned*)(rs + u.pm * BM + (u.half == 2 ? HALF : 0) + ((wid * 64 + flane()) & (u.half ? 127 : 255))), (LAS unsigned*)(epi + slot * 2048 + wid * 256), 4, 0, 0); }
    __device__ __forceinline__ void operator()(const f32x4 (&acc)[2][2][4][2], const Unit& u, int wr, int wc, int fr, int fq, int slot) const {
        const int row0 = u.pm * BM + (u.half == 2 ? HALF : 0) + wr * 64 + fr, col0 = u.pn * BM + wc * 32 + 8 * fq;
        const __amdgpu_buffer_rsrc_t orsrc = __builtin_amdgcn_make_buffer_rsrc((void*)O, 0, T * NP * 2, 0x00020000);
        const LAS float* rsl = (const LAS float*)(epi + slot * 2048) + wr * 64 + fr;
#pragma unroll
        for (int ai = 0; ai < 2; ++ai) if (ai == 0 || u.half == 0)
#pragma unroll
            for (int m = 0; m < 4; ++m) { const int row = row0 + ai * HALF + m * 16; const float s = rsl[ai * HALF + m * 16]; const int boff = (row * ldc + col0) * 2;
#pragma unroll
                for (int bj = 0; bj < 2; ++bj) { const f32x4 v0 = acc[ai][bj][m][0] * s, v1 = acc[ai][bj][m][1] * s;
                    u32x4 w; w.x = cvt_pk_bf16(v0[0], v0[1]); w.y = cvt_pk_bf16(v0[2], v0[3]); w.z = cvt_pk_bf16(v1[0], v1[1]); w.w = cvt_pk_bf16(v1[2], v1[3]);
                    __builtin_amdgcn_raw_buffer_store_b128(w, orsrc, boff + bj * HALF * 2, 0, 16); } }
    }
};
struct EpResidF32 {
    static constexpr bool PERM = false; typedef f32x4 acc_t;
    const float* base; float* C; int ldc;
    __device__ __forceinline__ void prefetch(const Unit&, int, int) const {}
    __device__ __forceinline__ void operator()(const f32x4 (&acc)[2][2][4][2], const Unit& u, int wr, int wc, int fr, int fq, int) const {
        const int row0 = u.pm * BM + (u.half == 2 ? HALF : 0) + wr * 64 + fr, col0 = u.pn * BM + wc * 32 + 4 * fq;
#pragma unroll
        for (int ai = 0; ai < 2; ++ai) if (ai == 0 || u.half == 0)
#pragma unroll
            for (int m = 0; m < 4; ++m) { const size_t off = (size_t)(row0 + ai * HALF + m * 16) * ldc + col0;
#pragma unroll
                for (int bj = 0; bj < 2; ++bj)
#pragma unroll
                    for (int n = 0; n < 2; ++n) { const f32x4 bs = *(const f32x4*)(base + off + bj * HALF + n * 16); *(f32x4*)(C + off + bj * HALF + n * 16) = bs + acc[ai][bj][m][n]; } }
    }
};
struct EpResidBf16 {
    static constexpr bool PERM = true; typedef f32x4 acc_t;
    const float* base; bf16_t* C; int ldc;
    __device__ __forceinline__ void prefetch(const Unit&, int, int) const {}
    __device__ __forceinline__ void operator()(const f32x4 (&acc)[2][2][4][2], const Unit& u, int wr, int wc, int fr, int fq, int) const {
        const int row0 = u.pm * BM + (u.half == 2 ? HALF : 0) + wr * 64 + fr, col0 = u.pn * BM + wc * 32 + 8 * fq;
#pragma unroll
        for (int ai = 0; ai < 2; ++ai) if (ai == 0 || u.half == 0)
#pragma unroll
            for (int m = 0; m < 4; ++m) { const size_t off = (size_t)(row0 + ai * HALF + m * 16) * ldc + col0;
#pragma unroll
                for (int bj = 0; bj < 2; ++bj) { const f32x4 b0 = *(const f32x4*)(base + off + bj * HALF), b1 = *(const f32x4*)(base + off + bj * HALF + 4);
                    const f32x4 v0 = b0 + acc[ai][bj][m][0], v1 = b1 + acc[ai][bj][m][1];
                    u32x4 w; w.x = cvt_pk_bf16(v0[0], v0[1]); w.y = cvt_pk_bf16(v0[2], v0[3]); w.z = cvt_pk_bf16(v1[0], v1[1]); w.w = cvt_pk_bf16(v1[2], v1[3]);
                    *(u32x4*)(C + off + bj * HALF) = w; } }
    }
};
__device__ __forceinline__ f32x4 i2f(const i32x4 v) { return (f32x4){(float)v.x, (float)v.y, (float)v.z, (float)v.w}; }
__device__ __forceinline__ unsigned q4(const float a, const float b, const float c, const float d) {
    unsigned w = __builtin_amdgcn_cvt_pk_u8_f32(a + 128.0f, 0, 0u); w = __builtin_amdgcn_cvt_pk_u8_f32(b + 128.0f, 1, w); w = __builtin_amdgcn_cvt_pk_u8_f32(c + 128.0f, 2, w); w = __builtin_amdgcn_cvt_pk_u8_f32(d + 128.0f, 3, w);
    return w ^ 0x80808080u; }
typedef float f32x2p __attribute__((ext_vector_type(2)));
__device__ __forceinline__ f32x2p swiglu_q2(f32x2p gate, f32x2p up) {
    f32x2p g, uu; g.x = fminf(gate.x, 7.0f); g.y = fminf(gate.y, 7.0f); uu.x = __builtin_amdgcn_fmed3f(up.x, -7.0f, 7.0f); uu.y = __builtin_amdgcn_fmed3f(up.y, -7.0f, 7.0f);
    const f32x2p a = g * (-1.702f * 1.44269504f); f32x2p e; e.x = __builtin_amdgcn_exp2f(a.x); e.y = __builtin_amdgcn_exp2f(a.y);
    const f32x2p d = e + 1.0f; f32x2p r; r.x = __builtin_amdgcn_rcpf(d.x); r.y = __builtin_amdgcn_rcpf(d.y);
    const f32x2p t = g * r, uq = uu * ACT_Q + ACT_Q;
    return t * uq + 128.0f;
}
__device__ __forceinline__ unsigned pk_u8x4(f32x2p a, f32x2p b) {
    unsigned w = __builtin_amdgcn_cvt_pk_u8_f32(a.x, 0, 0u); w = __builtin_amdgcn_cvt_pk_u8_f32(a.y, 1, w); w = __builtin_amdgcn_cvt_pk_u8_f32(b.x, 2, w); w = __builtin_amdgcn_cvt_pk_u8_f32(b.y, 3, w); return w ^ 0x80808080u; }
struct EpGlu8 {
    static constexpr bool PERM = true; typedef i32x4 acc_t;
    signed char* act; const float* bg; const float* bu; const float* sgu; const LAS float* tsc; int nmine; mutable int ui; LAS unsigned char* epi;
    __device__ __forceinline__ void prefetch(const Unit& u, int slot, int wid) const {
        const int arr = wid >> 1, j = ((wid & 1) << 6) + flane();
        const float* pb = (arr == 0 ? bg : bu) + u.e * FF + u.pn * HALF + j; const float* ps = sgu + (size_t)u.e * 2048 + u.pn * BM + (arr == 3 ? HALF : 0) + j;
        __builtin_amdgcn_global_load_lds((const unsigned*)(arr < 2 ? pb : ps), (LAS unsigned*)(epi + slot * 2048 + wid * 256), 4, 0, 0); }
    __device__ __forceinline__ void operator()(const i32x4 (&acc)[2][2][4][2], const Unit& u, int wr, int wc, int fr, int fq, int slot) const {
        const int c0 = u.pn * HALF + wc * 32 + 8 * fq;
        const LAS f32x4* ev = (const LAS f32x4*)(epi + slot * 2048 + (wc * 32 + 8 * fq) * 4);
        f32x2p bgv[4], buv[4], sgv[4], suv[4];
#pragma unroll
        for (int hq = 0; hq < 2; ++hq) { const f32x4 b = ev[hq], bu4 = ev[32 + hq], sg4 = ev[64 + hq], su4 = ev[96 + hq];
            bgv[2 * hq] = (f32x2p){b.x, b.y}; bgv[2 * hq + 1] = (f32x2p){b.z, b.w}; buv[2 * hq] = (f32x2p){bu4.x, bu4.y}; buv[2 * hq + 1] = (f32x2p){bu4.z, bu4.w};
            sgv[2 * hq] = (f32x2p){sg4.x, sg4.y}; sgv[2 * hq + 1] = (f32x2p){sg4.z, sg4.w}; suv[2 * hq] = (f32x2p){su4.x, su4.y}; suv[2 * hq + 1] = (f32x2p){su4.z, su4.w}; }
        const LAS float* ts = tsc + (ui % nmine) * 256;
        float sav[2][4];
#pragma unroll
        for (int ai = 0; ai < 2; ++ai)
#pragma unroll
            for (int m = 0; m < 4; ++m) sav[ai][m] = ts[ai * HALF + wr * 64 + m * 16 + fr];
        asm volatile("s_waitcnt lgkmcnt(0)" ::: "memory");
#pragma unroll 1
        for (int rep_ = 0; rep_ < 1 + ((DUP_MASK >> 11) & 1); ++rep_)
#pragma unroll
        for (int ai = 0; ai < 2; ++ai)
#pragma unroll
            for (int m = 0; m < 4; ++m) { const int r = ai * HALF + wr * 64 + m * 16 + fr; const float sa = sav[ai][m];
                f32x2p o[4];
#pragma unroll
                for (int q = 0; q < 4; ++q) { const i32x4 ga = acc[ai][0][m][q >> 1], ua = acc[ai][1][m][q >> 1];
                    f32x2p gf, uf; if (q & 1) { gf.x = (float)ga.z; gf.y = (float)ga.w; uf.x = (float)ua.z; uf.y = (float)ua.w; } else { gf.x = (float)ga.x; gf.y = (float)ga.y; uf.x = (float)ua.x; uf.y = (float)ua.y; }
                    o[q] = swiglu_q2(gf * (sgv[q] * sa) + bgv[q], uf * (suv[q] * sa) + buv[q]); }
                const unsigned w0 = pk_u8x4(o[0], o[1]), w1 = pk_u8x4(o[2], o[3]);
                *(u32x2*)(act + (size_t)(u.pm * BM + r) * FF + c0) = (u32x2){w0, w1}; }
        ++ui;
    }
};
struct EpDown8 {
    static constexpr bool PERM = true; typedef i32x4 acc_t;
    unsigned char* ybuf; const float* bd; const float* sd; const LAS int* tok; const LAS float* tsc; int nmine; mutable int ui; LAS unsigned char* epi;
    __device__ __forceinline__ void prefetch(const Unit& u, int slot, int wid) const {
        const int j = ((wid & 3) << 6) + flane();
        __builtin_amdgcn_global_load_lds((const unsigned*)((wid < 4 ? bd : sd) + u.e * D + u.pn * BM + j), (LAS unsigned*)(epi + slot * 2048 + wid * 256), 4, 0, 0); }
    __device__ __forceinline__ void operator()(const i32x4 (&acc)[2][2][4][2], const Unit& u, int wr, int wc, int fr, int fq, int slot) const {
        const int c0 = u.pn * BM + wc * 32 + 8 * fq;
        const LAS f32x4* ev = (const LAS f32x4*)(epi + slot * 2048 + (wc * 32 + 8 * fq) * 4);
        f32x4 bv[2][2], sv[2][2];
#pragma unroll
        for (int bj = 0; bj < 2; ++bj)
#pragma unroll
            for (int n = 0; n < 2; ++n) { bv[bj][n] = ev[bj * 32 + n]; sv[bj][n] = ev[64 + bj * 32 + n] * ACT_SCALE; }
        int av[2][4]; float gwv[2][4];
#pragma unroll
        for (int ai = 0; ai < 2; ++ai)
#pragma unroll
            for (int m = 0; m < 4; ++m) { const int r = (u.half == 2 ? HALF : 0) + ai * HALF + wr * 64 + m * 16 + fr; const int rc = r < 256 ? r : 255;
                av[ai][m] = tok[(ui % nmine) * 256 + rc]; gwv[ai][m] = tsc[(ui % nmine) * 256 + rc] * Y_Q; }
        asm volatile("s_waitcnt lgkmcnt(0)" ::: "memory");
#pragma unroll
        for (int ai = 0; ai < 2; ++ai) if (ai == 0 || u.half == 0)
#pragma unroll
            for (int m = 0; m < 4; ++m) { const int r = (u.half == 2 ? HALF : 0) + ai * HALF + wr * 64 + m * 16 + fr;
                if (r < u.nv) { const int a = av[ai][m]; const float gw = gwv[ai][m]; unsigned char* rowp = ybuf + (size_t)a * D + c0;
#pragma unroll
                    for (int bj = 0; bj < 2; ++bj) { const f32x4 v0 = (i2f(acc[ai][bj][m][0]) * sv[bj][0] + bv[bj][0]) * gw + 128.0f, v1 = (i2f(acc[ai][bj][m][1]) * sv[bj][1] + bv[bj][1]) * gw + 128.0f;
                        u32x2 w; w.x = pk_u8x4((f32x2p){v0[0], v0[1]}, (f32x2p){v0[2], v0[3]}) ^ 0x80808080u; w.y = pk_u8x4((f32x2p){v1[0], v1[1]}, (f32x2p){v1[2], v1[3]}) ^ 0x80808080u;
                        *(u32x2*)(rowp + bj * HALF) = w; } } }
        ++ui;
    }
};

template <class Epi, class Sched, bool I8 = false, bool ALIGN_EPI = true>
__device__ __forceinline__ void gemm_phase(LAS unsigned char* lds, const Sched& S, const Epi& E, const int wid  ) {
    static_assert(Sched::ESZ_ == (I8 ? 1 : 2), "element size");
    typedef typename Epi::acc_t acc_t;
    const int lane = flane(), tid = wid * 64 + lane, wr = wid >> 2, wc = wid & 3, fr = lane & 15, fq = lane >> 4;
    const int K = S.K, PITCH = K * (I8 ? 1 : 2), nt = PITCH / (BK * 2);
    unsigned voffB[2], vA[2][2]; int Rr[2], Cc[2];
#pragma unroll
    for (int i = 0; i < 2; ++i) { int R, C; stage_rc(tid * 16 + i * 8192, R, C); const int Rb = Epi::PERM ? ((R & ~31) + perm32(R & 31)) : R;
        voffB[i] = (unsigned)(Rb * PITCH + C * 2); Rr[i] = R; Cc[i] = C; }
    const size_t kstep = (size_t)(BK * 2);
    const size_t hstep = (size_t)HALF * PITCH;
    const unsigned ldsw = (unsigned)wid * 1024u;
    const int aoff = lds_byte(wr * 64 + fr, fq * 8), boff = lds_byte(wc * 32 + fr, fq * 8);
#define PG8_SA(b, h) (((b) * 2 + (h)) * HTB)
#define PG8_SB(b, h) ((4 + (b) * 2 + (h)) * HTB)
#define PG8_STAGE(bufoff, gbase, voff) do { _Pragma("unroll") for (int _i = 0; _i < 2; ++_i) \
        __builtin_amdgcn_global_load_lds((const unsigned*)((const char*)(gbase) + (voff)[_i]), (LAS unsigned*)(lds + (bufoff) + ldsw + _i * 8192), 16, 0, 0); } while (0)
#define PG8_LDA(dst, b, h) do { _Pragma("unroll") for (int m = 0; m < 4; ++m) _Pragma("unroll") for (int k = 0; k < 2; ++k) dst[m][k] = *(const LAS bf16x8*)(lds + PG8_SA(b, h) + aoff + m * 2048 + k * 1024); } while (0)
#define PG8_LDB(dst, b, h) do { _Pragma("unroll") for (int n = 0; n < 2; ++n) _Pragma("unroll") for (int k = 0; k < 2; ++k) dst[n][k] = *(const LAS bf16x8*)(lds + PG8_SB(b, h) + boff + n * 2048 + k * 1024); } while (0)
#define PG8_MMA(ai, bj, At, Bt) do { __builtin_amdgcn_s_setprio(1); _Pragma("unroll") for (int m = 0; m < 4; ++m) _Pragma("unroll") for (int n = 0; n < 2; ++n) _Pragma("unroll") for (int k = 0; k < 2; ++k) \
        { if constexpr (I8) acc[ai][bj][m][n] = __builtin_amdgcn_mfma_i32_16x16x64_i8(__builtin_bit_cast(i32x4, Bt[n][k]), __builtin_bit_cast(i32x4, At[m][k]), acc[ai][bj][m][n], 0, 0, 0); \
          else acc[ai][bj][m][n] = __builtin_amdgcn_mfma_f32_16x16x32_bf16(Bt[n][k], At[m][k], acc[ai][bj][m][n], 0, 0, 0); } __builtin_amdgcn_s_setprio(0); } while (0)
#define PG8_WAIT_V(n) asm volatile("s_waitcnt vmcnt(" #n ")" ::: "memory")
#define PG8_WAIT_L(n) asm volatile("s_waitcnt lgkmcnt(" #n ")" ::: "memory")
#define PG8_BAR __builtin_amdgcn_s_barrier()
#define PG8_SCHED __builtin_amdgcn_sched_barrier(0)
    Unit cur, nxt; int ui = 0;
    if (!S.next(0, cur)) return;
    S.a_voff(0, Rr, Cc, vA);
    acc_t acc[2][2][4][2];
#pragma unroll
    for (int a = 0; a < 2; ++a)
#pragma unroll
        for (int b = 0; b < 2; ++b)
#pragma unroll
            for (int m = 0; m < 4; ++m)
#pragma unroll
                for (int n = 0; n < 2; ++n) acc[a][b][m][n] = (acc_t){0, 0, 0, 0};
    bf16x8 At[4][2], B0[2][2], B1[2][2];
    const char* cA = S.a_ptr(cur); const char* cB = S.b_ptr(cur);
    PG8_STAGE(PG8_SB(0, 0), cB, voffB); PG8_STAGE(PG8_SB(0, 1), cB + hstep, voffB); PG8_STAGE(PG8_SA(0, 0), cA, vA[0]); PG8_STAGE(PG8_SA(0, 1), cA, vA[1]);
    if (wr == 1) PG8_BAR;
    PG8_WAIT_V(2); PG8_BAR;
    PG8_STAGE(PG8_SB(1, 0), cB + kstep, voffB); PG8_STAGE(PG8_SA(1, 0), cA + kstep, vA[0]); PG8_STAGE(PG8_SB(1, 1), cB + hstep + kstep, voffB);
    PG8_WAIT_V(6); PG8_BAR;
    for (;;) {
        const bool has_next = S.next(ui + 1, nxt);
        E.prefetch(cur, ui & 1, wid);
        const bool hu = __builtin_amdgcn_readfirstlane(cur.half) != 0;
        const char* nA = has_next ? S.a_ptr(nxt) : cA; const char* nB = has_next ? S.b_ptr(nxt) : cB;
        constexpr int KP = (I8 && ((DUP_MASK >> 22) & 1)) ? 2 : 1;
#pragma unroll 1
        for (int kp = 0; kp < KP; ++kp)
#pragma unroll 1
        for (int t = 0; t < nt; t += 2) {
            const bool lastk = (t == nt - 2), last = lastk && (kp == KP - 1);
            const char* a1 = cA + (size_t)(t + 1) * kstep;
            const char* a2 = lastk ? (last ? nA : cA) : cA + (size_t)(t + 2) * kstep; const char* b2 = lastk ? (last ? nB : cB) : cB + (size_t)(t + 2) * kstep;
#define PG8_ZB() do { if (KP == 2 && kp == 0) { _Pragma("unroll") for (int n = 0; n < 2; ++n) _Pragma("unroll") for (int k = 0; k < 2; ++k) { B0[n][k] = (bf16x8){0,0,0,0,0,0,0,0}; B1[n][k] = (bf16x8){0,0,0,0,0,0,0,0}; } } } while (0)
            const char* a3 = a2 + kstep; const char* b3 = b2 + kstep;
            PG8_LDB(B0, 0, 0); PG8_LDB(B1, 0, 1); PG8_SCHED; PG8_LDA(At, 0, 0); PG8_STAGE(PG8_SA(1, 1), a1, vA[1]);
            if (Sched::GATHER) { if (last && has_next) S.a_voff(ui + 1, Rr, Cc, vA); }
            PG8_WAIT_V(8); PG8_WAIT_L(0); PG8_ZB(); PG8_BAR; PG8_MMA(0, 0, At, B0); PG8_MMA(0, 1, At, B1); PG8_BAR; PG8_SCHED;
            if (!hu) PG8_LDA(At, 0, 1); PG8_STAGE(PG8_SB(0, 0), b2, voffB); PG8_STAGE(PG8_SB(0, 1), b2 + hstep, voffB); PG8_STAGE(PG8_SA(0, 0), a2, vA[0]);
            PG8_WAIT_V(8); PG8_WAIT_L(0); PG8_BAR; if (!hu) { PG8_MMA(1, 0, At, B0); PG8_MMA(1, 1, At, B1); } PG8_BAR; PG8_SCHED;
            PG8_LDB(B0, 1, 0); PG8_LDB(B1, 1, 1); PG8_SCHED; PG8_LDA(At, 1, 0); PG8_STAGE(PG8_SA(0, 1), a2, vA[1]);
            PG8_WAIT_V(8); PG8_WAIT_L(0); PG8_ZB(); PG8_BAR; PG8_MMA(0, 0, At, B0); PG8_MMA(0, 1, At, B1); PG8_BAR; PG8_SCHED;
            if (!hu) PG8_LDA(At, 1, 1); PG8_STAGE(PG8_SB(1, 0), b3, voffB); PG8_STAGE(PG8_SB(1, 1), b3 + hstep, voffB); PG8_STAGE(PG8_SA(1, 0), a3, vA[0]);
            PG8_WAIT_V(8); PG8_WAIT_L(0); PG8_BAR; if (!hu) { PG8_MMA(1, 0, At, B0); PG8_MMA(1, 1, At, B1); } PG8_BAR; PG8_SCHED;
        }
        if constexpr (ALIGN_EPI) { if (wr == 0) PG8_BAR; }
        E(acc, cur, wr, wc, fr, fq, ui & 1);
        if (!has_next) break;
#pragma unroll
        for (int a = 0; a < 2; ++a)
#pragma unroll
            for (int b = 0; b < 2; ++b)
#pragma unroll
                for (int m = 0; m < 4; ++m)
#pragma unroll
                    for (int n = 0; n < 2; ++n) acc[a][b][m][n] = (acc_t){0, 0, 0, 0};
        cur = nxt; cA = nA; cB = nB; ++ui;
        if constexpr (ALIGN_EPI) { if (wr == 1) PG8_BAR; }
    }
    PG8_WAIT_V(0);
    if constexpr (!ALIGN_EPI) { if (wr == 0) PG8_BAR; }
    PG8_BAR;
#undef PG8_SA
#undef PG8_ZB
#undef PG8_SB
#undef PG8_STAGE
#undef PG8_LDA
#undef PG8_LDB
#undef PG8_MMA
#undef PG8_WAIT_V
#undef PG8_WAIT_L
#undef PG8_BAR
#undef PG8_SCHED
}
}

constexpr int NWAVES = 8, NTHR = 512;
struct Frame {
    LAS unsigned char* lds;
    int wave, vcu, G;
    const float* in[20]; float* out; unsigned char* ws;
};
struct Args { const float* in[20]; float* out; unsigned char* ws; int ph_lo, ph_hi; };
enum { I_X = 0, I_N1G, I_WIN, I_IGB, I_FGB, I_CONVW, I_HNG, I_POOLW, I_POOLS, I_WOUT, I_N2G, I_WR, I_BR, I_WG, I_BG, I_WU, I_BU, I_WD, I_BD, I_NFG };

#define LDS_WAIT() asm volatile("s_waitcnt lgkmcnt(0)" ::: "memory")

constexpr int QITEMS = NE * 3 * 32;
constexpr int QEXTRA = ((DUP_MASK >> 13) & 1) * 1024;
constexpr int QSTATIC = 0; static_assert(QSTATIC == 0, "the two-queue pull assumes no static share");
__device__ __forceinline__ void quant_item(const Frame& F, const int it, const int par) {
    const int lane = flane();
    signed char* wgu_q = (signed char*)(F.ws + WS_WGU); signed char* wd_q = (signed char*)(F.ws + WS_WD); float* sgu = (float*)(F.ws + WS_SGU); float* sd = (float*)(F.ws + WS_SD);
    LAS float* scr = (LAS float*)(F.lds + F.wave * 12800);
    LAS unsigned* tile = (LAS unsigned*)(F.lds + F.wave * 12800 + 8704);
    LAS float* cmax = (LAS float*)(F.lds + 8 * 12800);
    const int rsub = lane >> 3, cg = lane & 7, nn = lane & 31, kh = lane >> 5, k0 = 128 * F.wave;
    const float* const p_wg = F.in[I_WG]; const float* const p_wu = F.in[I_WU]; const float* const p_wd = F.in[I_WD];
    const int e = it / 96, r2 = it % 96, which = r2 >> 5, nb = r2 & 31;
    const float* mat = (which == 0 ? p_wg : (which == 1 ? p_wu : p_wd)) + (size_t)e * D * FF;
    const __amdgpu_buffer_rsrc_t rsrc = __builtin_amdgcn_make_buffer_rsrc((void*)mat, 0, D * FF * 4, 0x00020000);
    const int voff = ((k0 + rsub) * 1024 + 32 * nb + 4 * cg) * 4;
    f32x4 v[16];
#pragma unroll
    for (int i = 0; i < 16; ++i) v[i] = __builtin_bit_cast(f32x4, __builtin_amdgcn_raw_buffer_load_b128(rsrc, voff, i * 32768, 2  ));
    f32x4 m4 = {0.f, 0.f, 0.f, 0.f};
#pragma unroll
    for (int i = 0; i < 16; ++i) { m4.x = fmaxf(m4.x, fabsf(v[i].x)); m4.y = fmaxf(m4.y, fabsf(v[i].y)); m4.z = fmaxf(m4.z, fabsf(v[i].z)); m4.w = fmaxf(m4.w, fabsf(v[i].w)); }
#pragma unroll
    for (int o = 8; o < 64; o <<= 1) { m4.x = fmaxf(m4.x, __shfl_xor(m4.x, o)); m4.y = fmaxf(m4.y, __shfl_xor(m4.y, o)); m4.z = fmaxf(m4.z, __shfl_xor(m4.z, o)); m4.w = fmaxf(m4.w, __shfl_xor(m4.w, o)); }
    if (rsub == 0) *(LAS f32x4*)(cmax + (par * 8 + F.wave) * 32 + 4 * cg) = m4;
    __syncthreads();
    float M = 0.f;
#pragma unroll
    for (int w = 0; w < 8; ++w) M = fmaxf(M, cmax[(par * 8 + w) * 32 + nn]);
    const float inv = M > 0.f ? 127.0f / M : 0.f;
    { const int col = 32 * nb + nn, rowi = (which == 2) ? col : 256 * (col >> 7) + 128 * which + (col & 127);
      if (F.wave == 0 && kh == 0) { if (which == 2) sd[e * D + rowi] = M > 0.f ? M * (1.0f / 127.0f) : 1.0f; else sgu[e * 2048 + rowi] = M > 0.f ? M * (1.0f / 127.0f) : 1.0f; } }
#pragma unroll
    for (int half = 0; half < 2; ++half) {
#pragma unroll
        for (int i = 0; i < 8; ++i) { LAS float* d = scr + (8 * i + rsub) * 33 + 4 * cg; const f32x4 x = v[8 * half + i]; d[0] = x.x; d[1] = x.y; d[2] = x.z; d[3] = x.w; }
        LDS_WAIT(); asm volatile("" ::: "memory");
#pragma unroll
        for (int j = 0; j < 8; ++j) { const LAS float* sp = scr + (32 * kh + 4 * j) * 33 + nn;
            const unsigned w = pg8::q4(sp[0] * inv, sp[33] * inv, sp[66] * inv, sp[99] * inv);
            const int word = 16 * half + 8 * kh + j; tile[nn * 32 + (word ^ nn)] = w; }
        LDS_WAIT(); asm volatile("" ::: "memory");
    }
    signed char* dst = (which == 2) ? wd_q + (size_t)e * D * 1024 : wgu_q + (size_t)e * 2048 * 1024;
#pragma unroll
    for (int pss = 0; pss < 4; ++pss) { const int n = pss * 8 + (lane >> 3), j4 = lane & 7; u32x4 w;
        w.x = tile[n * 32 + ((4 * j4 + 0) ^ n)]; w.y = tile[n * 32 + ((4 * j4 + 1) ^ n)]; w.z = tile[n * 32 + ((4 * j4 + 2) ^ n)]; w.w = tile[n * 32 + ((4 * j4 + 3) ^ n)];
        const int coln = 32 * nb + n, rown = (which == 2) ? coln : 256 * (coln >> 7) + 128 * which + (coln & 127);
        *(u32x4*)(dst + (size_t)rown * 1024 + k0 + 16 * j4) = w; }
    LDS_WAIT(); asm volatile("" ::: "memory");
}
__device__ __forceinline__ bool quant_pull(const Frame& F, const int par, const int nq) {
    LAS unsigned* qw = (LAS unsigned*)(F.lds + LDS_BARW) + 2;
    if (F.wave == 0 && flane() == 0) { unsigned* qh = (unsigned*)(F.ws + WS_CTL) + CW_QHEAD;
        unsigned q = (unsigned)atomicAdd(qh, 1u), it = 0xffffffffu;
        if (q < (unsigned)(NE * 64 + QEXTRA)) { q %= (unsigned)(NE * 64); it = (q >> 6) * 96u + (q & 63u); }
        else if (nq > 1) { q = (unsigned)atomicAdd(qh + 64, 1u); if (q < (unsigned)(NE * 32)) it = (q >> 5) * 96u + 64u + (q & 31u); }
        qw[par] = it; }
    __syncthreads();
    const unsigned it = qw[par];
    if (it == 0xffffffffu) return false;
    quant_item(F, (int)it, par);
    return true;
}
__device__ __forceinline__ void xcd_barrier_fill(const XcdBarrier& b, const Frame& F) {
    asm volatile("s_waitcnt vmcnt(0)" ::: "memory");
    __syncthreads();
    LAS unsigned* st = (LAS unsigned*)(F.lds + LDS_BARW);
    const bool t0 = (F.wave == 0 && flane() == 0);
    if (t0) {
        unsigned* bar = b.bar;
        __builtin_amdgcn_s_waitcnt(0);
        unsigned nloc = b.st[0], nx = b.st[1];
        if (nloc == 0u) { xcd_barrier_complete(bar, b.x, nloc, nx); b.st[0] = nloc; b.st[1] = nx; }
        const unsigned old = xb_add(&bar[XB_XSUB(b.x)], 1u);
        const unsigned gen = old / nloc;
        if (old + 1u == (gen + 1u) * nloc) {
            __builtin_amdgcn_fence(__ATOMIC_RELEASE, "agent");
            asm volatile("s_waitcnt vmcnt(0)" ::: "memory");
            const unsigned og = xb_add(&bar[XB_TOP], 1u);
            const unsigned tg = og / nx;
            if (og + 1u == (tg + 1u) * nx) xb_add(&bar[XB_TOPGEN], 1u);
            else XB_SPIN(xb_ld(&bar[XB_TOPGEN]) == tg, bar);
            __builtin_amdgcn_fence(__ATOMIC_ACQUIRE, "agent");
            xb_add(&bar[XB_XGEN(b.x)], 1u);
            asm volatile("s_waitcnt vmcnt(0)" ::: "memory");
            st[2] = 0xffffffffu;
        } else { st[2] = 0u; st[3] = gen; }
    }
    __syncthreads();
    if (st[2] != 0xffffffffu) {
        const unsigned gen = st[3];
        LAS unsigned* rw = (LAS unsigned*)(F.lds + LDS_BARW + 32);
        __syncthreads();
        int par = 0;
        for (;;) {
            if (t0) rw[par] = (xb_ld(&b.bar[XB_XGEN(b.x)]) != gen) ? 1u : 0u;
            __syncthreads();
            if (rw[par]) break;
            if (!quant_pull(F, par, 2)) { if (t0) XB_SPIN(xb_ld(&b.bar[XB_XGEN(b.x)]) == gen, b.bar); break; }
            par ^= 1;
        }
        if (t0) { __builtin_amdgcn_fence(__ATOMIC_ACQUIRE, "agent"); asm volatile("s_waitcnt vmcnt(0)" ::: "memory"); }
    }
    __syncthreads();
}

__device__ __forceinline__ void p0_item_load(const float* __restrict__ W, int ldw, int col0, int k0, int lane, float (&wv)[32]) {
#pragma unroll
    for (int i = 0; i < 32; ++i) wv[i] = W[(size_t)(k0 + 2 * i + (lane >> 5)) * ldw + col0 + (lane & 31)];
}
__device__ __forceinline__ void p0_item_finish(const float (&wv)[32], const float* __restrict__ gk, bf16_t* wt, int k0, LAS float* scr, int lane) {
    const int c = lane & 7;
    f32x4 g0 = {1.f, 1.f, 1.f, 1.f}, g1 = {1.f, 1.f, 1.f, 1.f};
    if (gk) { g0 = *(const f32x4*)(gk + k0 + 8 * c); g1 = *(const f32x4*)(gk + k0 + 8 * c + 4); }
#pragma unroll
    for (int i = 0; i < 32; ++i) scr[(2 * i + (lane >> 5)) * 33 + (lane & 31)] = wv[i];
    LDS_WAIT(); asm volatile("" ::: "memory");
#pragma unroll
    for (int j = 0; j < 4; ++j) { const int n = (lane >> 3) + 8 * j; const LAS float* sp = scr + (8 * c) * 33 + n;
        u32x4 o; o.x = cvt_pk_bf16(sp[0 * 33] * g0.x, sp[1 * 33] * g0.y); o.y = cvt_pk_bf16(sp[2 * 33] * g0.z, sp[3 * 33] * g0.w); o.z = cvt_pk_bf16(sp[4 * 33] * g1.x, sp[5 * 33] * g1.y); o.w = cvt_pk_bf16(sp[6 * 33] * g1.z, sp[7 * 33] * g1.w);
        *(u32x4*)(wt + (size_t)n * 1024 + k0 + 8 * c) = o; }
    LDS_WAIT(); asm volatile("" ::: "memory");
}
#define P0_ITEM_OF(it_, W_, gk_, wt_, ldw_, col0_, k0_) \
    const bool in_ = (it_) < 16 * (NP / 32); const int q_ = in_ ? (it_) : (it_) - 16 * (NP / 32), nbk_ = in_ ? (NP / 32) : 32, kb_ = q_ / nbk_, nb_ = q_ % nbk_, n0_ = 32 * nb_; \
    const float* W_ = in_ ? p_win : p_wout; const float* gk_ = in_ ? p_g : nullptr; bf16_t* wt_ = (in_ ? win_t : wout_t) + (size_t)n0_ * 1024; \
    const int ldw_ = in_ ? NIN : D, col0_ = (in_ && n0_ >= 2048) ? n0_ + 8 : n0_, k0_ = 64 * kb_
__device__ __forceinline__ void phase0(Frame& F) {
    const int lane = flane(), tid = F.wave * 64 + lane;
    const int gw = F.vcu * NWAVES + F.wave, NGW = F.G * NWAVES;
    constexpr int NITEMS = 16 * (NP / 32) + 16 * 32;
    const int pi = blockIdx.x * NTHR + tid; float pwv = 0.f; const float* pw = F.in[I_POOLW];
    if (pi < 4 * 128 * 128) { const int g = pi >> 14, d = (pi >> 7) & 127, cc = pi & 127; pwv = pw[(g * 128 + cc) * 128 + d]; }
    const float* const p_win = F.in[I_WIN]; const float* const p_wout = F.in[I_WOUT]; const float* const p_g = F.in[I_N1G];
    bf16_t* const win_t = (bf16_t*)(F.ws + WS_WIN); bf16_t* const wout_t = (bf16_t*)(F.ws + WS_WOUT);
    float wv[32]; const bool have_item = gw < NITEMS; const int it_first = have_item ? gw : 0;
    P0_ITEM_OF(it_first, iW, igk, iwt, ildw, icol0, ik0);
    if (have_item) p0_item_load(iW, ildw, icol0, ik0, lane, wv);
    {
        LAS float* wgl = (LAS float*)(F.lds + 98304);
        const float* w_in = F.in[I_WIN]; const float* g1 = F.in[I_N1G];
        { float gwv[2][8], gg[2];
#pragma unroll
          for (int t = 0; t < 2; ++t) { const int sidx = tid + t * NTHR, j = sidx >> 8, q = (sidx >> 6) & 3, l = sidx & 63, k = 256 * j + 4 * l + q; gg[t] = g1[k];
#pragma unroll
              for (int i = 0; i < 8; ++i) gwv[t][i] = w_in[(size_t)k * NIN + 2048 + i]; }
#pragma unroll
          for (int t = 0; t < 2; ++t)
#pragma unroll
              for (int i = 0; i < 8; ++i) wgl[(tid + t * NTHR) * 8 + i] = gwv[t][i] * gg[t]; }
        __syncthreads();
        bf16_t* xb = (bf16_t*)(F.ws + WS_XB); float* rs1 = (float*)(F.ws + WS_RS1); float* gates = (float*)(F.ws + WS_GATES);
        const float* x = F.in[I_X];
        f32x4 nx[4];
        if (gw < T) { const f32x4* xr = (const f32x4*)(x + (size_t)gw * D) + lane;
#pragma unroll
            for (int j = 0; j < 4; ++j) nx[j] = xr[64 * j]; }
        for (int row = gw; row < T; row += NGW) {
            f32x4 v[4]; float ss = 0.f; float ga[8];
#pragma unroll
            for (int j = 0; j < 4; ++j) v[j] = nx[j];
            if (row + NGW < T) { const f32x4* xr = (const f32x4*)(x + (size_t)(row + NGW) * D) + lane;
#pragma unroll
                for (int j = 0; j < 4; ++j) nx[j] = xr[64 * j]; }
#pragma unroll
            for (int i = 0; i < 8; ++i) ga[i] = 0.f;
#pragma unroll
            for (int j = 0; j < 4; ++j) ss += (v[j].x * v[j].x + v[j].y * v[j].y) + (v[j].z * v[j].z + v[j].w * v[j].w);
#pragma unroll
            for (int j = 0; j < 4; ++j)
#pragma unroll
                for (int q = 0; q < 4; ++q) { const LAS f32x4* wp = (const LAS f32x4*)(wgl + (256 * j + 64 * q + lane) * 8); const f32x4 w0 = wp[0], w1 = wp[1]; const float xv = v[j][q];
                    ga[0] += xv * w0.x; ga[1] += xv * w0.y; ga[2] += xv * w0.z; ga[3] += xv * w0.w; ga[4] += xv * w1.x; ga[5] += xv * w1.y; ga[6] += xv * w1.z; ga[7] += xv * w1.w; }
            const float rs = rsqrtf(wave_sum(ss) * (1.f / D) + EPS);
            float mine = 0.f;
#pragma unroll
            for (int i = 0; i < 8; ++i) { const float sm = wave_sum(ga[i]); mine = (lane == i) ? sm : mine; }
            if (lane < 8) gates[(size_t)row * 8 + lane] = mine * rs;
            if (lane == 0) rs1[row] = rs;
            u32x2* o8 = (u32x2*)(xb + (size_t)row * D) + lane;
#pragma unroll
            for (int j = 0; j < 4; ++j) { u32x2 o; o.x = cvt_pk_bf16(v[j].x, v[j].y); o.y = cvt_pk_bf16(v[j].z, v[j].w); o8[64 * j] = o; }
        }
    }
    {
        LAS float* scr = (LAS float*)(F.lds + F.wave * 8704);
        if (have_item) p0_item_finish(wv, igk, iwt, ik0, scr, lane);
        for (int it = gw + NGW; it < NITEMS; it += NGW) { P0_ITEM_OF(it, tW, tgk, twt, tldw, tcol0, tk0); p0_item_load(tW, tldw, tcol0, tk0, lane, wv); p0_item_finish(wv, tgk, twt, tk0, scr, lane); }
    }
    if (pi < 4 * 128 * 128) { bf16_t* pwt = (bf16_t*)(F.ws + WS_POOLWT); pwt[pi] = (bf16_t)(cvt_pk_bf16(pwv, 0.f) & 0xffffu); }
    for (int i = pi + F.G * NTHR; i < 4 * 128 * 128; i += F.G * NTHR) { const int g = i >> 14, d = (i >> 7) & 127, cc = i & 127; ((bf16_t*)(F.ws + WS_POOLWT))[i] = (bf16_t)(cvt_pk_bf16(pw[(g * 128 + cc) * 128 + d], 0.f) & 0xffffu); }
    __syncthreads();
#pragma unroll 1
    for (int j = 0; j < QSTATIC * (1 + (DUP_MASK & 1)); ++j) quant_item(F, F.vcu + (j % (QSTATIC > 0 ? QSTATIC : 1)) * F.G, j & 1);
}

typedef short s16x4 __attribute__((ext_vector_type(4)));
typedef float f32x16 __attribute__((ext_vector_type(16)));
typedef float f32x8 __attribute__((ext_vector_type(8)));
typedef float f32x2 __attribute__((ext_vector_type(2)));
typedef __bf16 bfv8 __attribute__((ext_vector_type(8)));
typedef __bf16 bfv2 __attribute__((ext_vector_type(2)));
#define MFMA32(a, b, c) __builtin_amdgcn_mfma_f32_32x32x16_bf16((a), (b), (c), 0, 0, 0)
__device__ __forceinline__ bf16x8 pack8(float a0, float a1, float a2, float a3, float a4, float a5, float a6, float a7) {
    const f32x8 f = {a0, a1, a2, a3, a4, a5, a6, a7}; return __builtin_bit_cast(bf16x8, __builtin_convertvector(f, bfv8)); }
__device__ __forceinline__ unsigned pack2(float a, float b) { const f32x2 f = {a, b}; return __builtin_bit_cast(unsigned, __builtin_convertvector(f, bfv2)); }
__device__ __forceinline__ unsigned img_off(unsigned row, unsigned ch) { return 256u * row + 16u * (ch ^ (((row & 3u) << 2) | ((row >> 2) & 3u))); }
__device__ __forceinline__ bf16x8 img_rr(const LAS unsigned char* img, unsigned row0, unsigned lane, unsigned s) { return *(const LAS bf16x8*)(img + img_off(row0 + (lane & 31u), 2u * s + (lane >> 5))); }
__device__ __forceinline__ bf16x8 img_trn(const LAS unsigned char* img, unsigned k0, unsigned lane, unsigned c) {
    const unsigned h = lane >> 5, blk = (lane >> 4) & 1u, q = (lane & 15u) >> 2, p = lane & 3u, ch = 4u * c + 2u * blk + (p >> 1), sub = 8u * (p & 1u);
    const s16x4 lo = __builtin_amdgcn_ds_read_tr16_b64_v4i16((LAS s16x4*)(img + img_off(k0 + 8u * h + q, ch) + sub));
    const s16x4 hi = __builtin_amdgcn_ds_read_tr16_b64_v4i16((LAS s16x4*)(img + img_off(k0 + 8u * h + 4u + q, ch) + sub));
    return __builtin_shufflevector(lo, hi, 0, 1, 2, 3, 4, 5, 6, 7); }
__device__ __forceinline__ bf16x8 img_trp(const LAS unsigned char* img, unsigned k0, unsigned lane, unsigned c) {
    const unsigned h = lane >> 5, blk = (lane >> 4) & 1u, q = (lane & 15u) >> 2, p = lane & 3u, ch = 4u * c + 2u * blk + (p >> 1), sub = 8u * (p & 1u);
    const s16x4 lo = __builtin_amdgcn_ds_read_tr16_b64_v4i16((LAS s16x4*)(img + img_off(k0 + 4u * h + q, ch) + sub));
    const s16x4 hi = __builtin_amdgcn_ds_read_tr16_b64_v4i16((LAS s16x4*)(img + img_off(k0 + 8u + 4u * h + q, ch) + sub));
    return __builtin_shufflevector(lo, hi, 0, 1, 2, 3, 4, 5, 6, 7); }
__device__ __forceinline__ float wave_scan_add(float v, int) {
    v += dpp_old<0x111, 0xF>(0.f, v); v += dpp_old<0x112, 0xF>(0.f, v); v += dpp_old<0x114, 0xF>(0.f, v); v += dpp_old<0x118, 0xF>(0.f, v);
    v += dpp_old<0x142, 0xA>(0.f, v); v += dpp_old<0x143, 0xC>(0.f, v);
    return v; }
__device__ __forceinline__ float wave_scan_max(float v, int) {
    constexpr float NI = -3.0e38f;
    v = fmaxf(v, dpp_old<0x111, 0xF>(NI, v)); v = fmaxf(v, dpp_old<0x112, 0xF>(NI, v)); v = fmaxf(v, dpp_old<0x114, 0xF>(NI, v)); v = fmaxf(v, dpp_old<0x118, 0xF>(NI, v));
    v = fmaxf(v, dpp_old<0x142, 0xA>(NI, v)); v = fmaxf(v, dpp_old<0x143, 0xC>(NI, v));
    return v; }
__device__ __forceinline__ float wave_max(float v) {
    v = fmaxf(v, dpp_mov<0xB1>(v)); v = fmaxf(v, dpp_mov<0x4E>(v)); v = fmaxf(v, dpp_mov<0x141>(v)); v = fmaxf(v, dpp_mov<0x140>(v));
    return fmaxf(fmaxf(lane_bcast(v, 0), lane_bcast(v, 16)), fmaxf(lane_bcast(v, 32), lane_bcast(v, 48))); }
__device__ __forceinline__ void unpack8(const u32x4 w, float (&f)[8]) { f[0] = bflo(w.x); f[1] = bfhi(w.x); f[2] = bflo(w.y); f[3] = bfhi(w.y); f[4] = bflo(w.z); f[5] = bfhi(w.z); f[6] = bflo(w.w); f[7] = bfhi(w.w); }
__device__ __forceinline__ void conv2rows(const u32x4 (&pre)[5], const float (&cw)[4][8], float (&out)[2][8]) {
    float pf[5][8];
#pragma unroll
    for (int i = 0; i < 5; ++i) unpack8(pre[i], pf[i]);
#pragma unroll
    for (int rr = 0; rr < 2; ++rr)
#pragma unroll
        for (int e = 0; e < 8; ++e) { float a = 0.f;
#pragma unroll
            for (int j = 0; j < 4; ++j) a += pf[rr + j][e] * cw[j][e];
            out[rr][e] = a * fast_sigmoid(a); }
}
__device__ __forceinline__ void load_pre5(const bf16_t* __restrict__ P, int tok0, int c, int l0, int col, u32x4 (&pre)[5]) {
#pragma unroll
    for (int i = 0; i < 5; ++i) { const int l = l0 - 3 + i; pre[i] = (c * 64 + l >= 0) ? *(const u32x4*)(P + (size_t)(tok0 + l) * NP + col) : (u32x4){0u, 0u, 0u, 0u}; }
}
__device__ __forceinline__ void load_cw(const float* __restrict__ conv_w, int ch, float (&cw)[4][8]) {
#pragma unroll
    for (int j = 0; j < 4; ++j) { const f32x4 a = *(const f32x4*)(conv_w + j * 1024 + ch), b = *(const f32x4*)(conv_w + j * 1024 + ch + 4);
        cw[j][0] = a.x; cw[j][1] = a.y; cw[j][2] = a.z; cw[j][3] = a.w; cw[j][4] = b.x; cw[j][5] = b.y; cw[j][6] = b.z; cw[j][7] = b.w; }
}
constexpr float KSCALE = 0.08838834764831845f;

__device__ __forceinline__ void phase2_group(Frame& F) {
    const bf16_t* P = (const bf16_t*)(F.ws + WS_P); const float* gates = (const float*)(F.ws + WS_GATES); const float* conv_w = F.in[I_CONVW];
    u32x4* Cloc = (u32x4*)(F.ws + WS_CST); u32x4* Ctot = (u32x4*)(F.ws + WS_CIN); float* nst = (float*)(F.ws + WS_NST); float* mloc = (float*)(F.ws + WS_MLOC); float* btot = (float*)(F.ws + WS_BTOT);
    float* ntot = (float*)(F.ws + WS_NIN); float* mgrp = (float*)(F.ws + WS_MIN);
    LAS unsigned char* IMG_WK = F.lds; LAS unsigned char* IMG_V = F.lds + 16384; LAS float* s_w = (LAS float*)(F.lds + 32768);
    const int lane = flane(), wave = F.wave, tid = wave * 64 + lane, d8 = tid & 15, lq = tid >> 4, l0 = 2 * lq;
    u32x4 pre[5], vv[2]; float g_i = 0.f, g_f = 0.f;
#define P2_LOAD(uu) do { const int c_ = (uu) & 63, h_ = ((uu) >> 6) & 3, b_ = (uu) >> 8, tok0_ = b_ * SEQ + c_ * 64; \
        load_pre5(P, tok0_, c_, l0, 512 + h_ * 128 + 8 * d8, pre); \
        _Pragma("unroll") for (int rr = 0; rr < 2; ++rr) vv[rr] = *(const u32x4*)(P + (size_t)(tok0_ + l0 + rr) * NP + PC_V + h_ * 128 + 8 * d8); \
        if (wave == 0) { const float* pr_ = gates + (size_t)(tok0_ + lane) * 8; g_i = pr_[h_]; g_f = pr_[4 + h_]; } } while (0)
    for (int up = blockIdx.x; up < 256; up += F.G) {
        const int u0 = (up >> 4) * 64 + 4 * (up & 15), h = (up >> 4) & 3;
        P2_LOAD(u0);
        float cw[4][8]; load_cw(conv_w, 512 + h * 128 + 8 * d8, cw);
        const int a = wave >> 1, b0 = 2 * (wave & 1), r = lane & 31, hh = lane >> 5;
        f32x16 ct0, ct1, cn;
#pragma unroll
        for (int i = 0; i < 16; ++i) { ct0[i] = 0.f; ct1[i] = 0.f; cn[i] = 0.f; }
        float mg = -1e30f, Bg = 0.f;
#pragma unroll 1
        for (int cc = 0; cc < 4; ++cc) {
            const int u = u0 + cc;
            LAS float* sw = s_w + 128 * (cc & 1);
            if (wave == 0) { const float ig = g_i + F.in[I_IGB][h]; const float lf = logsigmoidf_(g_f + F.in[I_FGB][h]);
                const float bb = wave_scan_add(lf, lane); const float bt = lane_bcast(bb, 63); const float g = bt - bb + ig; const float m = wave_max(g);
                sw[lane] = expf(g - m); if (lane == 0) { mloc[u] = m; btot[u] = bt; sw[64] = m; sw[65] = bt; } }
            __syncthreads();
            const float ml = sw[64], bt = sw[65];
            { float kc[2][8]; conv2rows(pre, cw, kc);
#pragma unroll
              for (int rr = 0; rr < 2; ++rr) { const float w = sw[l0 + rr] * KSCALE;
                  *(LAS bf16x8*)(IMG_WK + img_off(l0 + rr, d8)) = pack8(kc[rr][0] * w, kc[rr][1] * w, kc[rr][2] * w, kc[rr][3] * w, kc[rr][4] * w, kc[rr][5] * w, kc[rr][6] * w, kc[rr][7] * w);
                  *(LAS u32x4*)(IMG_V + img_off(l0 + rr, d8)) = vv[rr]; } }
            __syncthreads();
            if (cc < 3) P2_LOAD(u + 1);
            f32x16 acc0, acc1, accn;
#pragma unroll
            for (int i = 0; i < 16; ++i) { acc0[i] = 0.f; acc1[i] = 0.f; accn[i] = 0.f; }
            const bf16x8 ones = {(short)0x3F80, (short)0x3F80, (short)0x3F80, (short)0x3F80, (short)0x3F80, (short)0x3F80, (short)0x3F80, (short)0x3F80};
#pragma unroll
            for (int ks = 0; ks < 4; ++ks) { const bf16x8 A = img_trn(IMG_WK, 16 * ks, lane, a);
                acc0 = MFMA32(A, img_trn(IMG_V, 16 * ks, lane, b0), acc0); acc1 = MFMA32(A, img_trn(IMG_V, 16 * ks, lane, b0 + 1), acc1);
                if (b0 == 0) accn = MFMA32(A, ones, accn); }
            if (b0 == 0 && r == 0) {
#pragma unroll
                for (int i = 0; i < 16; ++i) nst[(size_t)u * 128 + 32 * a + (i & 3) + 8 * (i >> 2) + 4 * hh] = accn[i]; }
            { u32x4* dst = Cloc + ((size_t)u * 8 + wave) * 256 + lane;
#pragma unroll
              for (int q = 0; q < 2; ++q) {
                  dst[q * 64] = (u32x4){pack2(acc0[8 * q], acc0[8 * q + 1]), pack2(acc0[8 * q + 2], acc0[8 * q + 3]), pack2(acc0[8 * q + 4], acc0[8 * q + 5]), pack2(acc0[8 * q + 6], acc0[8 * q + 7])};
                  dst[(2 + q) * 64] = (u32x4){pack2(acc1[8 * q], acc1[8 * q + 1]), pack2(acc1[8 * q + 2], acc1[8 * q + 3]), pack2(acc1[8 * q + 4], acc1[8 * q + 5]), pack2(acc1[8 * q + 6], acc1[8 * q + 7])}; } }
            { const float mn = fmaxf(bt + mg, ml), so = __expf(bt + mg - mn), sl = __expf(ml - mn);
#pragma unroll
              for (int i = 0; i < 16; ++i) { ct0[i] = so * ct0[i] + sl * acc0[i]; ct1[i] = so * ct1[i] + sl * acc1[i]; cn[i] = so * cn[i] + sl * accn[i]; }
              mg = mn; Bg += bt; }
        }
        { u32x4* dst = Ctot + ((size_t)up * 8 + wave) * 256 + lane;
#pragma unroll
          for (int q = 0; q < 2; ++q) {
              dst[q * 64] = (u32x4){pack2(ct0[8 * q], ct0[8 * q + 1]), pack2(ct0[8 * q + 2], ct0[8 * q + 3]), pack2(ct0[8 * q + 4], ct0[8 * q + 5]), pack2(ct0[8 * q + 6], ct0[8 * q + 7])};
              dst[(2 + q) * 64] = (u32x4){pack2(ct1[8 * q], ct1[8 * q + 1]), pack2(ct1[8 * q + 2], ct1[8 * q + 3]), pack2(ct1[8 * q + 4], ct1[8 * q + 5]), pack2(ct1[8 * q + 6], ct1[8 * q + 7])}; } }
        if (b0 == 0 && r == 0) {
#pragma unroll
            for (int i = 0; i < 16; ++i) ntot[(size_t)up * 128 + 32 * a + (i & 3) + 8 * (i >> 2) + 4 * hh] = cn[i]; }
        if (tid == 0) { mgrp[up] = mg; mgrp[256 + up] = Bg; }
        __syncthreads();
    }
#undef P2_LOAD
}
__device__ __forceinline__ void phase2_pool(Frame& F) {
    const bf16_t* P = (const bf16_t*)(F.ws + WS_P); bf16_t* ycat = (bf16_t*)(F.ws + WS_YCAT); const bf16_t* pwt = (const bf16_t*)(F.ws + WS_POOLWT); const float* pool_scale = F.in[I_POOLS];
    LAS unsigned char* IMG_PL = F.lds; LAS unsigned char* IMG_PW = F.lds + 16384; LAS unsigned char* STG = F.lds + 49152;
    const int lane = flane(), wave = F.wave, tid = wave * 64 + lane, d8 = tid & 15, lq = tid >> 4, l0 = 2 * lq;
    for (int u = blockIdx.x; u < 1024; u += F.G) {
        const int tok0 = (u >> 2) * 64, gi = u & 3, w = 2 << gi;
#pragma unroll
        for (int i = 0; i < 4; ++i) { const int idx = tid + i * NTHR, d = idx >> 4, j = idx & 15;
            *(LAS u32x4*)(IMG_PW + img_off(d, j)) = *(const u32x4*)(pwt + ((size_t)gi * 128 + d) * 128 + j * 8); }
        {
            const int s1 = ((tok0 + l0 + 1) & (SEQ - 1));
            const bf16_t* base = P + (size_t)(tok0 + l0 + 1) * NP + PC_U + gi * 128 + 8 * d8;
            u32x4 rw[17];
#pragma unroll
            for (int j = 0; j < 17; ++j) { int jj = j < w ? j : w; jj = jj < s1 ? jj : s1; rw[j] = *(const u32x4*)(base - (size_t)jj * NP); }
            float sum[8], cur0[8], cur1[8], old[8], f[8];
#pragma unroll
            for (int e = 0; e < 8; ++e) sum[e] = 0.f;
#pragma unroll
            for (int j = 2; j < 16; ++j) { const bool on = (j < w) && (s1 - j >= 0); unpack8(rw[j], f);
#pragma unroll
                for (int e = 0; e < 8; ++e) sum[e] += on ? f[e] : 0.f; }
            unpack8(rw[1], cur0); unpack8(rw[0], cur1);
            { const u32x4 ro = (w == 2) ? rw[2] : ((w == 4) ? rw[4] : ((w == 8) ? rw[8] : rw[16])); unpack8(ro, old); const bool on = (s1 - w >= 0);
#pragma unroll
              for (int e = 0; e < 8; ++e) old[e] = on ? old[e] : 0.f; }
            const int s0 = s1 - 1; const float ic0 = 1.f / (float)((s0 + 1 < w) ? s0 + 1 : w), ic1 = 1.f / (float)((s1 + 1 < w) ? s1 + 1 : w);
            float p0[8], p1[8];
#pragma unroll
            for (int e = 0; e < 8; ++e) { const float mid = sum[e] + cur0[e];
                p0[e] = (mid + old[e]) * ic0 - cur0[e]; p1[e] = (mid + cur1[e]) * ic1 - cur1[e]; }
            *(LAS bf16x8*)(IMG_PL + img_off(l0, d8)) = pack8(p0[0], p0[1], p0[2], p0[3], p0[4], p0[5], p0[6], p0[7]);
            *(LAS bf16x8*)(IMG_PL + img_off(l0 + 1, d8)) = pack8(p1[0], p1[1], p1[2], p1[3], p1[4], p1[5], p1[6], p1[7]);
        }
        __syncthreads();
        { const int wi = wave >> 2, wj = wave & 3, r = lane & 31, hh = lane >> 5;
          f32x16 acc;
#pragma unroll
          for (int i = 0; i < 16; ++i) acc[i] = 0.f;
#pragma unroll
          for (int sx = 0; sx < 8; ++sx) acc = MFMA32(img_rr(IMG_PL, 32 * wi, lane, sx), img_rr(IMG_PW, 32 * wj, lane, sx), acc);
          const int d = 32 * wj + r; const float sc = pool_scale[gi * 128 + d];
#pragma unroll
          for (int i = 0; i < 16; ++i) { const int l = 32 * wi + (i & 3) + 8 * (i >> 2) + 4 * hh;
              *(LAS unsigned short*)(STG + l * 256 + 2 * (d ^ ((l & 15) << 3))) = (unsigned short)(pack2(acc[i] * sc, 0.f) & 0xffffu); } }
        __syncthreads();
#pragma unroll
        for (int i = 0; i < 2; ++i) { const int idx = tid + i * NTHR, l = idx >> 4, j = idx & 15;
            *(u32x4*)(ycat + (size_t)(tok0 + l) * D + 512 + gi * 128 + j * 8) = *(const LAS u32x4*)(STG + l * 256 + ((j ^ (l & 15)) << 4)); }
        __syncthreads();
    }
}
__device__ __forceinline__ void state_axpy(f32x16& C0, f32x16& C1, const float so, const float sl, const u32x4 (&t)[4]) {
#pragma unroll
    for (int q = 0; q < 2; ++q) { float f[8]; unpack8(t[q], f);
#pragma unroll
        for (int e = 0; e < 8; ++e) C0[8 * q + e] = so * C0[8 * q + e] + sl * f[e];
        unpack8(t[2 + q], f);
#pragma unroll
        for (int e = 0; e < 8; ++e) C1[8 * q + e] = so * C1[8 * q + e] + sl * f[e]; }
}
__device__ __forceinline__ void phase4_group(Frame& F) {
    const bf16_t* P = (const bf16_t*)(F.ws + WS_P); const float* gates = (const float*)(F.ws + WS_GATES); const float* conv_w = F.in[I_CONVW]; const float* head_norm_g = F.in[I_HNG];
    const u32x4* Cloc = (const u32x4*)(F.ws + WS_CST); const u32x4* Ctot = (const u32x4*)(F.ws + WS_CIN); const float* nst = (const float*)(F.ws + WS_NST);
    const float* mloc = (const float*)(F.ws + WS_MLOC); const float* btot = (const float*)(F.ws + WS_BTOT); const float* ntot = (const float*)(F.ws + WS_NIN); const float* mgrp = (const float*)(F.ws + WS_MIN);
    bf16_t* ycat = (bf16_t*)(F.ws + WS_YCAT);
    LAS unsigned char* IMG_Q = F.lds; LAS unsigned char* IMG_K = F.lds + 16384; LAS unsigned char* IMG_V = F.lds + 32768; LAS unsigned char* IMG_C = F.lds + 49152;
    LAS float* HB = (LAS float*)(F.lds + 81920);
    LAS unsigned char* RAWQ = F.lds + 115712; LAS unsigned char* RAWK = RAWQ + 17408;
    LAS float* s_c = (LAS float*)(F.lds + 150528); LAS float* s_M = s_c + 64; LAS float* s_int = s_M + 64; LAS float* s_edn = s_int + 64; LAS float* s_qn = s_edn + 64; LAS float* s_rd = s_qn + 64;
    LAS float* s_n = s_rd + 256;
    const int lane = flane(), wave = F.wave, tid = wave * 64 + lane, d8 = tid & 15, lq = tid >> 4, l0 = 2 * lq;
#define P4_DMA_RAW(uu) do { const int c_ = (uu) & 63, h_ = ((uu) >> 6) & 3, b_ = (uu) >> 8, tok0_ = b_ * SEQ + c_ * 64; \
        _Pragma("unroll") for (int i = 0; i < 3; ++i) { const int pc = 8 * i + wave; if (pc < 17) { const int rr_ = pc * 4 + (lane >> 4); int tk = tok0_ - 3 + rr_; tk = tk < 0 ? 0 : (tk > T - 1 ? T - 1 : tk); \
            const char* src_ = (const char*)(P + (size_t)tk * NP + h_ * 128) + (lane & 15) * 16; \
            __builtin_amdgcn_global_load_lds((const unsigned*)src_, (LAS unsigned*)(RAWQ + pc * 1024), 16, 0, 0); \
            __builtin_amdgcn_global_load_lds((const unsigned*)(src_ + 1024), (LAS unsigned*)(RAWK + pc * 1024), 16, 0, 0); } } } while (0)
#define P4_DMA_V(uu) do { const int c_ = (uu) & 63, h_ = ((uu) >> 6) & 3, b_ = (uu) >> 8, tok0_ = b_ * SEQ + c_ * 64; const unsigned ol_ = (unsigned)olane(); \
        _Pragma("unroll") for (int i = 0; i < 2; ++i) { const unsigned d = (unsigned)((8 * i + wave) * 64) + ol_, row = d >> 4, sl = d & 15u, j = sl ^ (((row & 3u) << 2) | ((row >> 2) & 3u)); \
            __builtin_amdgcn_global_load_lds((const unsigned*)((const char*)(P + (size_t)(tok0_ + row) * NP + PC_V + h_ * 128) + j * 16), (LAS unsigned*)(IMG_V + (8 * i + wave) * 1024), 16, 0, 0); } } while (0)
    float g_i = 0.f, g_f = 0.f;
#define P4_GATES(uu) do { if (wave == 0) { const int c_ = (uu) & 63, h_ = ((uu) >> 6) & 3, b_ = (uu) >> 8; const float* pr_ = gates + (size_t)(b_ * SEQ + c_ * 64 + lane) * 8; g_i = pr_[h_]; g_f = pr_[4 + h_]; } } while (0)
    const int ca = wave >> 1, cb0 = 2 * (wave & 1), cr = lane & 31, chh = lane >> 5;
    {
        const int up = blockIdx.x; const int bh = up >> 4, g = up & 15, h = bh & 3, b = bh >> 2, u0 = bh * 64 + 4 * g;
        P4_DMA_RAW(u0); P4_DMA_V(u0); P4_GATES(u0);
        f32x16 C0, C1;
#pragma unroll
        for (int i = 0; i < 16; ++i) { C0[i] = 0.f; C1[i] = 0.f; }
        float m = 0.f, nv = 0.f;
        float mgv = -1e30f, Bgv = 0.f;
        if (lane < g) { mgv = mgrp[bh * 16 + lane]; Bgv = mgrp[256 + bh * 16 + lane]; }
#pragma unroll 1
        for (int j0 = 0; j0 < g; j0 += 8) {
            u32x4 t[8][4]; float nt[8];
#pragma unroll
            for (int jj = 0; jj < 8; ++jj) { const int j = (j0 + jj < g) ? j0 + jj : g - 1; const u32x4* src = Ctot + ((size_t)(bh * 16 + j) * 8 + wave) * 256 + lane;
#pragma unroll
                for (int q = 0; q < 4; ++q) t[jj][q] = src[q * 64];
                nt[jj] = (tid < 128) ? ntot[(size_t)(bh * 16 + j) * 128 + tid] : 0.f; }
#pragma unroll
            for (int jj = 0; jj < 8; ++jj) { const float mgj = lane_bcast(mgv, j0 + jj), Bgj = lane_bcast(Bgv, j0 + jj);
                const float mn = fmaxf(Bgj + m, mgj), so = __expf(Bgj + m - mn), sl = __expf(mgj - mn);
                state_axpy(C0, C1, so, sl, t[jj]); nv = so * nv + sl * nt[jj]; m = mn; }
        }
#pragma unroll
        for (int bb = 0; bb < 2; ++bb) { const unsigned dv = 32 * (cb0 + bb) + cr;
#pragma unroll
            for (int gq = 0; gq < 4; ++gq) { u32x2 w;
                if (bb == 0) { w.x = pack2(C0[4 * gq], C0[4 * gq + 1]); w.y = pack2(C0[4 * gq + 2], C0[4 * gq + 3]); } else { w.x = pack2(C1[4 * gq], C1[4 * gq + 1]); w.y = pack2(C1[4 * gq + 2], C1[4 * gq + 3]); }
                *(LAS u32x2*)(IMG_C + img_off(dv, 4 * ca + gq) + 8 * chh) = w; } }
#pragma unroll 1
        for (int cc = 0; cc < 4; ++cc) {
            const int u = u0 + cc, c = 4 * g + cc, tok0 = b * SEQ + c * 64;
            if (tid < 128) s_n[tid] = nv;
            float cwq[4][8], cwk[4][8]; load_cw(conv_w, h * 128 + 8 * d8, cwq); load_cw(conv_w, 512 + h * 128 + 8 * d8, cwk);
            asm volatile("s_waitcnt vmcnt(0)" ::: "memory");
            __syncthreads();
            if (wave == 0) { const float ig = g_i + F.in[I_IGB][h]; const float lf = logsigmoidf_(g_f + F.in[I_FGB][h]);
                const float bb = wave_scan_add(lf, lane); const float cc_ = ig - bb; const float M = fmaxf(m, wave_scan_max(cc_, lane));
                s_c[lane] = cc_; s_M[lane] = M; s_int[lane] = expf(m - M); s_edn[lane] = expf(-bb - M); }
            { u32x4 preq[5], prek[5];
              const f32x4 n0 = *(const LAS f32x4*)(s_n + 8 * d8), n1 = *(const LAS f32x4*)(s_n + 8 * d8 + 4);
#pragma unroll
              for (int i = 0; i < 5; ++i) { const bool ok = (c * 64 + l0 - 3 + i) >= 0; const u32x4 zq = *(const LAS u32x4*)(RAWQ + (l0 + i) * 256 + d8 * 16), zk = *(const LAS u32x4*)(RAWK + (l0 + i) * 256 + d8 * 16);
                  preq[i] = ok ? zq : (u32x4){0u, 0u, 0u, 0u}; prek[i] = ok ? zk : (u32x4){0u, 0u, 0u, 0u}; }
              float qc[2][8], kc[2][8]; conv2rows(preq, cwq, qc); conv2rows(prek, cwk, kc);
#pragma unroll
              for (int rr = 0; rr < 2; ++rr) {
                  *(LAS bf16x8*)(IMG_Q + img_off(l0 + rr, d8)) = pack8(qc[rr][0], qc[rr][1], qc[rr][2], qc[rr][3], qc[rr][4], qc[rr][5], qc[rr][6], qc[rr][7]);
                  *(LAS bf16x8*)(IMG_K + img_off(l0 + rr, d8)) = pack8(kc[rr][0] * KSCALE, kc[rr][1] * KSCALE, kc[rr][2] * KSCALE, kc[rr][3] * KSCALE, kc[rr][4] * KSCALE, kc[rr][5] * KSCALE, kc[rr][6] * KSCALE, kc[rr][7] * KSCALE);
                  float qn = (qc[rr][0] * n0.x + qc[rr][1] * n0.y) + (qc[rr][2] * n0.z + qc[rr][3] * n0.w) + (qc[rr][4] * n1.x + qc[rr][5] * n1.y) + (qc[rr][6] * n1.z + qc[rr][7] * n1.w);
                  qn = row16_sum(qn);
                  if (d8 == 0) s_qn[l0 + rr] = qn; } }
            __syncthreads();
            const bool more = (cc < 3);
            if (more) { P4_DMA_RAW(u + 1); P4_GATES(u + 1); }
            {
                const int wi = wave >> 2, wj = wave & 3, r = lane & 31, hh = lane >> 5, lcol = 32 * wi + r;
                const float Ml = s_M[lcol];
                bf16x8 pa[2][2]; float dsum = 0.f;
                bf16x8 qf[8];
#pragma unroll
                for (int sx = 0; sx < 8; ++sx) qf[sx] = img_rr(IMG_Q, 32 * wi, lane, sx);
#pragma unroll
                for (int rb = 0; rb < 2; ++rb) {
                    if (rb <= wi) {
                        f32x16 sa;
#pragma unroll
                        for (int i = 0; i < 16; ++i) sa[i] = 0.f;
                        { bf16x8 kf[8];
#pragma unroll
                          for (int sx = 0; sx < 8; ++sx) kf[sx] = img_rr(IMG_K, 32 * rb, lane, sx);
#pragma unroll
                          for (int sx = 0; sx < 8; ++sx) sa = MFMA32(kf[sx], qf[sx], sa); }
                        float pv[16];
#pragma unroll
                        for (int gq = 0; gq < 4; ++gq) { const f32x4 c4 = *(const LAS f32x4*)(s_c + 32 * rb + 8 * gq + 4 * hh);
#pragma unroll
                            for (int j = 0; j < 4; ++j) { const int rrow = 32 * rb + 8 * gq + 4 * hh + j; const float e = __expf(c4[j] - Ml);
                                const float v = (rrow <= lcol) ? sa[4 * gq + j] * e : 0.f; pv[4 * gq + j] = v; dsum += v; } }
                        pa[rb][0] = pack8(pv[0], pv[1], pv[2], pv[3], pv[4], pv[5], pv[6], pv[7]);
                        pa[rb][1] = pack8(pv[8], pv[9], pv[10], pv[11], pv[12], pv[13], pv[14], pv[15]);
                    }
                }
                dsum += __shfl_xor(dsum, 32);
                { const float den = dsum + s_int[lcol] * s_qn[lcol]; const float rd = 1.0f / fmaxf(fabsf(den), s_edn[lcol]); if (hh == 0) s_rd[wave * 32 + r] = rd; }
                f32x16 z, z2;
#pragma unroll
                for (int i = 0; i < 16; ++i) { z[i] = 0.f; z2[i] = 0.f; }
#pragma unroll
                for (int rb = 0; rb < 2; ++rb) if (rb <= wi) {
#pragma unroll
                    for (int sx = 0; sx < 2; ++sx) z = MFMA32(pa[rb][sx], img_trp(IMG_V, 32 * rb + 16 * sx, lane, wj), z); }
                { bf16x8 cf[8];
#pragma unroll
                  for (int sx = 0; sx < 8; ++sx) cf[sx] = img_rr(IMG_C, 32 * wj, lane, sx);
#pragma unroll
                  for (int sx = 0; sx < 8; ++sx) z2 = MFMA32(qf[sx], cf[sx], z2); }
#pragma unroll
                for (int gq = 0; gq < 4; ++gq) { const f32x4 rd4 = *(const LAS f32x4*)(s_rd + wave * 32 + 8 * gq + 4 * hh), in4 = *(const LAS f32x4*)(s_int + 32 * wi + 8 * gq + 4 * hh);
#pragma unroll
                    for (int j = 0; j < 4; ++j) HB[(32 * wi + 8 * gq + 4 * hh + j) * 132 + 32 * wj + r] = (z[4 * gq + j] + in4[j] * z2[4 * gq + j]) * rd4[j]; }
            }
            unsigned owc[8];
#pragma unroll
            for (int i = 0; i < 8; ++i) owc[i] = *(const unsigned*)(P + (size_t)(tok0 + wave * 8 + i) * NP + PC_O + h * 128 + 2 * lane);
            __syncthreads();
            u32x4 cl[4] = {{0u, 0u, 0u, 0u}, {0u, 0u, 0u, 0u}, {0u, 0u, 0u, 0u}, {0u, 0u, 0u, 0u}}; float nl = 0.f, ml = 0.f, bt = 0.f;
            if (more) { P4_DMA_V(u + 1);
                const u32x4* src = Cloc + ((size_t)u * 8 + wave) * 256 + olane();
#pragma unroll
                for (int q = 0; q < 4; ++q) cl[q] = src[q * 64];
                if (tid < 128) nl = nst[(size_t)u * 128 + tid];
                ml = mloc[u]; bt = btot[u]; }
            const f32x2 gg = *(const f32x2*)(head_norm_g + h * 128 + 2 * lane);
#pragma unroll
            for (int i = 0; i < 8; ++i) { const int l = wave * 8 + i; const f32x2 hv = *(const LAS f32x2*)(HB + l * 132 + 2 * lane);
                const float mu = wave_sum(hv.x + hv.y) * (1.f / 128.f); const float e0 = hv.x - mu, e1 = hv.y - mu;
                const float var = wave_sum(e0 * e0 + e1 * e1) * (1.f / 128.f); const float rstd = rsqrtf(var + EPS);
                *(unsigned*)(ycat + (size_t)(tok0 + l) * D + h * 128 + 2 * lane) = pack2(fast_sigmoid(bflo(owc[i])) * e0 * rstd * gg.x, fast_sigmoid(bfhi(owc[i])) * e1 * rstd * gg.y); }
            if (more) { const float mn = fmaxf(bt + m, ml), so = __expf(bt + m - mn), sl = __expf(ml - mn);
                const int ol = olane(), ocr = ol & 31, ochh = ol >> 5;
#pragma unroll
                for (int bb = 0; bb < 2; ++bb) { const unsigned dv = 32 * (cb0 + bb) + ocr;
#pragma unroll
                    for (int gq = 0; gq < 4; ++gq) { LAS u32x2* pp = (LAS u32x2*)(IMG_C + img_off(dv, 4 * ca + gq) + 8 * ochh); const u32x2 w = *pp;
                        const u32x4 cw4 = cl[2 * bb + (gq >> 1)]; const unsigned c0 = (gq & 1) ? cw4.z : cw4.x, c1 = (gq & 1) ? cw4.w : cw4.y;
                        u32x2 o; o.x = pack2(so * bflo(w.x) + sl * bflo(c0), so * bfhi(w.x) + sl * bfhi(c0)); o.y = pack2(so * bflo(w.y) + sl * bflo(c1), so * bfhi(w.y) + sl * bfhi(c1));
                        *pp = o; } }
                nv = so * nv + sl * nl; m = mn; }
        }
        asm volatile("s_waitcnt vmcnt(0)" ::: "memory");
        __syncthreads();
    }
#undef P4_DMA_RAW
#undef P4_DMA_V
#undef P4_GATES
}

__device__ __forceinline__ void phase6_route(Frame& F, const int probe_rep) {
    const int lane = flane(), wave = F.wave, tid = wave * 64 + lane;
    const bf16_t* x1 = (const bf16_t*)(F.ws + WS_X1); const float* g2 = F.in[I_N2G]; const float* w_router = F.in[I_WR]; const float* b_router = F.in[I_BR];
    signed char* h2 = (signed char*)(F.ws + WS_H2); float* shv = (float*)(F.ws + WS_SH); int* cnt0 = (int*)(F.ws + WS_CTL) + CW_CNT; int* list0 = (int*)(F.ws + WS_LIST); float* gate_of = (float*)(F.ws + WS_GATEOF);
    LAS unsigned char* WH = F.lds; LAS unsigned char* WL = F.lds + 65536;
    LAS float* LG = (LAS float*)(F.lds + LDS_TOK);
    LAS float* RST = LG + 64 * 33;
    LAS float* s_rs = RST + 256;
    LAS int* hist = (LAS int*)(F.lds + LDS_P6); LAS int* base = hist + 64; LAS int* s_e = base + 64; LAS int* s_t = s_e + 1024; LAS float* s_g = (LAS float*)(s_t + 256); LAS float* s_sh = s_g + 256;
    float* lsc = (float*)(F.ws + WS_LSC); float* lgw = (float*)(F.ws + WS_LGW);
    { const int e = tid & 31, kg = tid >> 5;
#pragma unroll 2
      for (int i = 0; i < 8; ++i) { const int c = kg + 16 * i; float w[8], wl[8];
#pragma unroll
          for (int j = 0; j < 8; ++j) { const int k = 8 * c + j; w[j] = w_router[(size_t)k * NE + e] * g2[k]; }
          const bf16x8 hi = pack8(w[0], w[1], w[2], w[3], w[4], w[5], w[6], w[7]);
#pragma unroll
          for (int j = 0; j < 8; ++j) wl[j] = w[j] - bf2f((unsigned short)hi[j]);
          const unsigned off = (unsigned)e * 2048u + 16u * (unsigned)(c ^ (e & 15));
          *(LAS bf16x8*)(WH + off) = hi; *(LAS bf16x8*)(WL + off) = pack8(wl[0], wl[1], wl[2], wl[3], wl[4], wl[5], wl[6], wl[7]); } }
    if (tid < 64) hist[tid] = 0;
    __syncthreads();
    const int t0 = 64 * F.vcu;
    const __amdgpu_buffer_rsrc_t x1rsrc = __builtin_amdgcn_make_buffer_rsrc((void*)x1, 0, T * D * 2, 0x00020000);
#pragma unroll 1
    for (int rep = 0; rep < probe_rep; ++rep) {
        {
            const int tb = wave >> 2, kq = wave & 3, r = lane & 31, h = lane >> 5;
            const int voff = (r * 1024 + 8 * h) * 2, sbase = ((t0 + 32 * tb) * 1024 + 256 * kq) * 2;
            f32x16 acc;
#pragma unroll
            for (int i = 0; i < 16; ++i) acc[i] = 0.f;
            float ss = 0.f;
#pragma unroll
            for (int sb = 0; sb < 16; sb += 8) {
                u32x4 xa[8];
#pragma unroll
                for (int sx = 0; sx < 8; ++sx) xa[sx] = __builtin_amdgcn_raw_buffer_load_b128(x1rsrc, voff, sbase + (sb + sx) * 32, 0);
#pragma unroll
                for (int sx = 0; sx < 8; ++sx) { float f[8]; unpack8(xa[sx], f);
                    ss += ((f[0] * f[0] + f[1] * f[1]) + (f[2] * f[2] + f[3] * f[3])) + ((f[4] * f[4] + f[5] * f[5]) + (f[6] * f[6] + f[7] * f[7]));
                    const bf16x8 ah = __builtin_bit_cast(bf16x8, xa[sx]);
                    const unsigned boff = (unsigned)r * 2048u + 16u * (unsigned)((32 * kq + 2 * (sb + sx) + h) ^ (r & 15));
                    const bf16x8 bh = *(const LAS bf16x8*)(WH + boff), bl = *(const LAS bf16x8*)(WL + boff);
                    acc = MFMA32(ah, bh, acc); acc = MFMA32(ah, bl, acc); }
            }
            ss += __shfl_xor(ss, 32);
            if (h == 0) RST[(32 * tb + r) * 4 + kq] = ss;
#pragma unroll 1
            for (int q = 0; q < 4; ++q) {
                if (kq == q) {
#pragma unroll
                    for (int i = 0; i < 16; ++i) { LAS float* pp = LG + (32 * tb + (i & 3) + 8 * (i >> 2) + 4 * h) * 33 + r; *pp = (q == 0 ? 0.f : *pp) + acc[i]; } }
                __syncthreads();
            }
        }
        LAS int* hist_ = hist + 32 * rep;
        if (wave == 0) {
            const int t = t0 + lane;
            const float rs = rsqrtf(((RST[lane * 4] + RST[lane * 4 + 1]) + (RST[lane * 4 + 2] + RST[lane * 4 + 3])) * (1.f / D) + EPS);
            s_rs[lane] = rs;
            float lg[32];
#pragma unroll
            for (int e = 0; e < 32; ++e) lg[e] = LG[lane * 33 + e] * rs + b_router[e];
            int bi[4]; float bv[4];
#pragma unroll
            for (int k = 0; k < 4; ++k) { float best = -INFINITY; int bb = 0;
#pragma unroll
                for (int e = 0; e < 32; ++e) if (lg[e] > best) { best = lg[e]; bb = e; }
#pragma unroll
                for (int e = 0; e < 32; ++e) if (e == bb) lg[e] = -INFINITY;
                bi[k] = bb; bv[k] = best; }
            float ex[4], se = 0.f;
#pragma unroll
            for (int k = 0; k < 4; ++k) { ex[k] = expf(bv[k] - bv[0]); se += ex[k]; }
#pragma unroll
            for (int k = 0; k < 4; ++k) { const int lr = __hip_atomic_fetch_add(hist_ + bi[k], 1, __ATOMIC_RELAXED, __HIP_MEMORY_SCOPE_WORKGROUP);
                s_e[lane * 4 + k] = bi[k] | (lr << 8); s_g[lane * 4 + k] = ex[k] / se; }
            s_t[lane] = t;
        }
        __syncthreads();
        int nbase = 0;
        if (tid < 32) { const int n = hist_[tid]; nbase = n ? atomicAdd(cnt0 + (rep ? 8128 : 0) + tid * 64, n) : 0; }
        if (rep == 0) {
            f32x4 gg[4]; u32x2 nx[4];
#pragma unroll
            for (int j = 0; j < 4; ++j) { gg[j] = *(const f32x4*)(g2 + 256 * j + 4 * lane); nx[j] = ((const u32x2*)(x1 + (size_t)(t0 + wave * 8) * D) + lane)[64 * j]; }
#pragma unroll 1
            for (int i = 0; i < 8; ++i) {
                const int li = wave * 8 + i, t = t0 + li; const float rs = s_rs[li];
                f32x4 hv[4]; float hmax = 0.f;
#pragma unroll
                for (int j = 0; j < 4; ++j) { hv[j] = (f32x4){bflo(nx[j].x), bfhi(nx[j].x), bflo(nx[j].y), bfhi(nx[j].y)} * gg[j];
                    hmax = fmaxf(fmaxf(hmax, fmaxf(fabsf(hv[j].x), fabsf(hv[j].y))), fmaxf(fabsf(hv[j].z), fabsf(hv[j].w))); }
                if (i < 7) { const u32x2* xr = (const u32x2*)(x1 + (size_t)(t + 1) * D) + lane;
#pragma unroll
                    for (int j = 0; j < 4; ++j) nx[j] = xr[64 * j]; }
                hmax = wave_max(hmax);
                const float qi = hmax > 0.f ? 127.0f / hmax : 0.f; unsigned* o4 = (unsigned*)(h2 + (size_t)t * D) + lane;
#pragma unroll
                for (int j = 0; j < 4; ++j) { const f32x4 hq = hv[j] * qi; o4[64 * j] = pg8::q4(hq.x, hq.y, hq.z, hq.w); }
                if (lane == 0) { const float shval = hmax > 0.f ? hmax * rs * (1.0f / 127.0f) : 1.0f; shv[t] = shval; s_sh[li] = shval; }
            }
        }
        if (tid < 32) base[tid] = nbase;
        __syncthreads();
        if (tid < 256) { const int li = tid >> 2, k = tid & 3, t = s_t[li]; const int ew = s_e[tid], e = ew & 255, lr = ew >> 8; int* list = rep ? (int*)(F.ws + WS_ACT) : list0;
            list[e * T + base[e] + lr] = t * 4 + k;
            if (!rep) { gate_of[t * 4 + k] = s_g[tid]; lsc[e * T + base[e] + lr] = s_sh[li]; lgw[e * T + base[e] + lr] = s_g[tid]; } }
        __syncthreads();
    }
}

__device__ __forceinline__ int moe_tables(Frame& F) {
    LAS int* lcnt = (LAS int*)(F.lds + LDS_CNT); LAS int* ltp = (LAS int*)(F.lds + LDS_TP); LAS int* lte = (LAS int*)(F.lds + LDS_TE);
    const int* cnt = (const int*)(F.ws + WS_CTL) + CW_CNT;
    const int lane = flane();
    if (F.wave == 0) {
        const int c = lane < NE ? cnt[lane * 64] : 0, nt = (c + 255) >> 8;
        const int incl = (int)wave_scan_add((float)nt, lane);
        const int excl = incl - nt;
        if (lane < NE) { lcnt[lane] = c; ltp[lane] = excl; for (int j = 0; j < nt; ++j) lte[excl + j] = lane; }
        if (lane == NE - 1) ltp[NE] = incl;
    }
    __syncthreads();
    return ltp[NE];
}
template <int MODE, class Sched>
__device__ __forceinline__ void build_row_tables(Frame& F, const Sched& S) {
    const int* list = (const int*)(F.ws + WS_LIST); const float* vals = (const float*)(F.ws + (MODE == 0 ? WS_LSC : WS_LGW));
    LAS int* tok = (LAS int*)(F.lds + LDS_TOK); LAS float* tsc = (LAS float*)(F.lds + LDS_TSC);
    const int tid = F.wave * 64 + flane(); const int nent = (S.nmine < 10 ? S.nmine : 10) * 256;
    int a[5]; float v[5];
#pragma unroll
    for (int k = 0; k < 5; ++k) { const int idx = tid + k * NTHR; a[k] = -1; v[k] = 0.f;
        if (idx < nent) { pg8::Unit u; S.next(idx >> 8, u); const int r = idx & 255; if (r < u.nv) { a[k] = list[u.lbase + r]; v[k] = vals[u.lbase + r]; } } }
#pragma unroll
    for (int k = 0; k < 5; ++k) { const int idx = tid + k * NTHR; if (idx < nent) { tok[idx] = a[k] < 0 ? 0 : (MODE == 0 ? (a[k] >> 2) * D : a[k]); tsc[idx] = v[k]; } }
    __syncthreads();
}

__device__ __forceinline__ void phase9_final(Frame& F) {
    const bf16_t* x1 = (const bf16_t*)(F.ws + WS_X1); const unsigned char* ybuf = (const unsigned char*)(F.ws + WS_YBUF); const float* gf = F.in[I_NFG]; float* out = F.out;
    const int gw = F.vcu * NWAVES + F.wave, NGW = F.G * NWAVES, lane = flane();
    f32x4 gg[4];
#pragma unroll
    for (int j = 0; j < 4; ++j) gg[j] = *(const f32x4*)(gf + 256 * j + 4 * lane);
    for (int t = gw; t < T; t += 2 * NGW) {
        f32x4 v[2][4]; unsigned y[2][4][4];
#pragma unroll
        for (int q = 0; q < 2; ++q) { const int tq = (t + q * NGW < T) ? t + q * NGW : t; const u32x2* xr = (const u32x2*)(x1 + (size_t)tq * D) + lane;
#pragma unroll
            for (int j = 0; j < 4; ++j) { const u32x2 xw = xr[64 * j]; v[q][j] = (f32x4){bflo(xw.x), bfhi(xw.x), bflo(xw.y), bfhi(xw.y)}; }
#pragma unroll
            for (int k = 0; k < 4; ++k) { const unsigned* yr = (const unsigned*)(ybuf + (size_t)(tq * 4 + k) * D) + lane;
#pragma unroll
                for (int j = 0; j < 4; ++j) y[q][k][j] = yr[64 * j]; } }
#pragma unroll
        for (int q = 0; q < 2; ++q) { if (t + q * NGW < T) {
#pragma unroll
            for (int j = 0; j < 4; ++j) { f32x4 sb = {0.f, 0.f, 0.f, 0.f};
#pragma unroll
                for (int k = 0; k < 4; ++k) { const unsigned yy = y[q][k][j]; sb.x += (float)(yy & 255u); sb.y += (float)((yy >> 8) & 255u); sb.z += (float)((yy >> 16) & 255u); sb.w += (float)(yy >> 24); }
                v[q][j] = v[q][j] + (sb - 512.0f) * Y_SCALE; }
            float ss = 0.f;
#pragma unroll
            for (int j = 0; j < 4; ++j) ss += (v[q][j].x * v[q][j].x + v[q][j].y * v[q][j].y) + (v[q][j].z * v[q][j].z + v[q][j].w * v[q][j].w);
            const float rs = rsqrtf(wave_sum(ss) * (1.f / D) + EPS);
            f32x4* orow = (f32x4*)(out + (size_t)(t + q * NGW) * D) + lane;
#pragma unroll
            for (int j = 0; j < 4; ++j) orow[64 * j] = v[q][j] * rs * gg[j]; } }
    }
}

__global__ void __launch_bounds__(NTHR, 2) mega(Args args) {
    extern __shared__ __attribute__((aligned(16))) unsigned char lds_raw[];
    Frame F;
    F.lds = (LAS unsigned char*)lds_raw;
    F.wave = __builtin_amdgcn_readfirstlane((int)threadIdx.x >> 6);
    F.G = gridDim.x; { const int bx = blockIdx.x; F.vcu = (F.G % 8 == 0) ? (bx % 8) * (F.G / 8) + bx / 8 : bx; }
#pragma unroll
    for (int i = 0; i < 20; ++i) F.in[i] = args.in[i];
    F.out = args.out; F.ws = args.ws;
    if (threadIdx.x < 16) ((LAS unsigned*)(F.lds + LDS_BARW))[threadIdx.x] = 0u;
    __syncthreads();
    unsigned* ctl = (unsigned*)(F.ws + WS_CTL);
    XcdBarrier bar; bar.bar = ctl + CW_BAR; bar.x = 0; bar.st = nullptr;
    if (MK_N_LAUNCHES == 1) bar = xcd_barrier_post(ctl + CW_BAR, (volatile LAS unsigned*)(F.lds + LDS_BARW));
    const int lo = args.ph_lo, hi = args.ph_hi;
#define IN(k) (lo <= (k) && (k) < hi)
#define SEAM(k) do { if (IN(k) && IN((k) + 1)) { if ((k) <= 6) xcd_barrier_fill(bar, F); else xcd_barrier(bar, F.wave); if ((DUP_MASK >> 10) & 1) xcd_barrier(bar, F.wave); } } while (0)

    if (IN(0)) { REP(0) phase0(F); SEAM(0); }
    if (IN(1)) { {
        pg8::DenseSched S; S.init((const bf16_t*)(F.ws + WS_XB), (const bf16_t*)(F.ws + WS_WIN), T, NP, D, F.G, (int)blockIdx.x, 1 + ((DUP_MASK >> 1) & 1));
        pg8::EpRowScaleBf16 E{(bf16_t*)(F.ws + WS_P), NP, (const float*)(F.ws + WS_RS1), F.lds + LDS_EPI};
        pg8::gemm_phase(F.lds, S, E, F.wave); }
        SEAM(1);
    }
    if (IN(2)) { REP(2) { phase2_group(F); phase2_pool(F); } SEAM(2); }
    if (IN(4)) { REP(4) phase4_group(F); SEAM(4); }
    if (IN(5)) { {
        pg8::DenseSched S; S.init((const bf16_t*)(F.ws + WS_YCAT), (const bf16_t*)(F.ws + WS_WOUT), T, D, D, F.G, (int)blockIdx.x, 1 + ((DUP_MASK >> 5) & 1));
        pg8::EpResidBf16 E{F.in[I_X], (bf16_t*)(F.ws + WS_X1), D};
        pg8::gemm_phase(F.lds, S, E, F.wave); }
        SEAM(5);
    }
    if (IN(6)) { phase6_route(F, 1 + ((DUP_MASK >> 6) & 1)); __syncthreads(); { int par = 0; while (quant_pull(F, par, 1)) par ^= 1; } SEAM(6); }
    if (IN(7)) {
        const int ntiles = moe_tables(F);
        pg8::MoeSched<true, 8, 1> S; S.A = (const void*)(F.ws + WS_H2); S.Bt = (const void*)(F.ws + WS_WGU); S.K = D; S.setup(ntiles * 8, F.G, (int)blockIdx.x, 1 + ((DUP_MASK >> 7) & 1), false);
        S.cnt = (const LAS int*)(F.lds + LDS_CNT); S.tp = (const LAS int*)(F.lds + LDS_TP); S.te = (const LAS int*)(F.lds + LDS_TE); S.tok = (const LAS int*)(F.lds + LDS_TOK);
        build_row_tables<0>(F, S);
        pg8::EpGlu8 E{(signed char*)(F.ws + WS_ACT), F.in[I_BG], F.in[I_BU], (const float*)(F.ws + WS_SGU), (const LAS float*)(F.lds + LDS_TSC), S.nmine > 0 ? S.nmine : 1, 0, F.lds + LDS_EPI};
        pg8::gemm_phase<pg8::EpGlu8, pg8::MoeSched<true, 8, 1>, true, MOE_ALIGN>(F.lds, S, E, F.wave);
        { int par = 0; while (quant_pull(F, par, 2)) par ^= 1; }
        SEAM(7);
    }
    if (IN(8)) {
        const int ntiles = IN(7) ? ((const LAS int*)(F.lds + LDS_TP))[NE] : moe_tables(F);
        pg8::MoeSched<false, 4, 1> S; S.A = (const void*)(F.ws + WS_ACT); S.Bt = (const void*)(F.ws + WS_WD); S.K = FF; S.setup(ntiles * 4, F.G, (int)blockIdx.x, 1 + ((DUP_MASK >> 8) & 1), true);
        S.cnt = (const LAS int*)(F.lds + LDS_CNT); S.tp = (const LAS int*)(F.lds + LDS_TP); S.te = (const LAS int*)(F.lds + LDS_TE); S.tok = (const LAS int*)(F.lds + LDS_TOK);
        build_row_tables<1>(F, S);
        pg8::EpDown8 E{(unsigned char*)(F.ws + WS_YBUF), F.in[I_BD], (const float*)(F.ws + WS_SD), (const LAS int*)(F.lds + LDS_TOK), (const LAS float*)(F.lds + LDS_TSC), S.nmine > 0 ? S.nmine : 1, 0, F.lds + LDS_EPI};
        pg8::gemm_phase<pg8::EpDown8, pg8::MoeSched<false, 4, 1>, true, MOE_ALIGN>(F.lds, S, E, F.wave);
        SEAM(8);
    }
    if (IN(9)) { REP(9) phase9_final(F); }
#undef IN
#undef SEAM
}

extern "C" void kernel_launch(void* const* d_in, const int* in_sizes, int n_in, void* d_out, int out_size, void* d_ws, size_t ws_size, hipStream_t stream) {
    static int grid = 0;
    if (grid == 0) {
        if (n_in != 20 || in_sizes[0] != T * D || out_size != T * D || ws_size < WS_END) { fprintf(stderr, "kernel_launch: unexpected problem (n_in %d, ws %zu)\n", n_in, ws_size); grid = -1; return; }
        int dev = 0, cus = 0, per_cu = 0;
        if (hipGetDevice(&dev) != hipSuccess || hipDeviceGetAttribute(&cus, hipDeviceAttributeMultiprocessorCount, dev) != hipSuccess) { grid = -1; return; }
        if (hipFuncSetAttribute((const void*)mega, hipFuncAttributeMaxDynamicSharedMemorySize, LDS_BYTES) != hipSuccess) { fprintf(stderr, "kernel_launch: hipFuncSetAttribute failed\n"); grid = -1; return; }
        if (hipOccupancyMaxActiveBlocksPerMultiprocessor(&per_cu, (const void*)mega, NTHR, LDS_BYTES) != hipSuccess || per_cu < 1) fprintf(stderr, "kernel_launch: occupancy query reports %d\n", per_cu);
        (void)hipGetLastError();
        if (cus != 256) { fprintf(stderr, "kernel_launch: built for a 256-CU device (one 64-token routing block and one workgroup per CU); found %d CUs, nothing launched\n", cus); grid = -1; return; }
        grid = cus;
    }
    if (grid < 0) return;
    (void)hipMemsetAsync((char*)d_ws + WS_CTL, 0, CTL_ZERO_BYTES, stream);
    Args a{};
    for (int i = 0; i < 20; ++i) a.in[i] = (const float*)d_in[i];
    a.out = (float*)d_out; a.ws = (unsigned char*)d_ws;
    if (MK_N_LAUNCHES == 1) { a.ph_lo = 0; a.ph_hi = N_PHASES; hipLaunchKernelGGL(mega, dim3(grid), dim3(NTHR), LDS_BYTES, stream, a); }
    else for (int p = 0; p < N_PHASES; ++p) { a.ph_lo = p; a.ph_hi = p + 1; hipLaunchKernelGGL(mega, dim3(grid), dim3(NTHR), LDS_BYTES, stream, a); }
}
```

```cpp
#include <hip/hip_runtime.h>
#include <cstdio>
#include <cstdint>

#ifndef MK_N_LAUNCHES
#define MK_N_LAUNCHES 1
#endif
constexpr int N_PHASES = 10;
constexpr bool MOE_ALIGN = true;
#ifndef DUP_MASK
#define DUP_MASK 0
#endif
#define REP(k) for (int rep_ = 0; rep_ < 1 + ((DUP_MASK >> (k)) & 1); ++rep_)

constexpr int T = 16384, D = 1024, SEQ = 4096;
constexpr int NIN = 2568;
constexpr int NP = 2560;
constexpr int NE = 32, FF = 1024;
constexpr float EPS = 1e-5f;
constexpr int PC_V = 1024, PC_O = 1536, PC_U = 2048;

#define GAS __attribute__((address_space(1)))
#define LAS __attribute__((address_space(3)))
typedef unsigned short bf16_t;
typedef short bf16x8 __attribute__((ext_vector_type(8)));
typedef float f32x4 __attribute__((ext_vector_type(4)));
typedef unsigned u32x4 __attribute__((ext_vector_type(4)));
typedef unsigned u32x2 __attribute__((ext_vector_type(2)));

__device__ __forceinline__ unsigned cvt_pk_bf16(float lo, float hi) { unsigned r; asm volatile("v_cvt_pk_bf16_f32 %0, %1, %2" : "=v"(r) : "v"(lo), "v"(hi)); return r; }
__device__ __forceinline__ float bf2f(unsigned short b) { return __uint_as_float(((unsigned)b) << 16); }
__device__ __forceinline__ float bflo(unsigned w) { return __uint_as_float(w << 16); }
__device__ __forceinline__ float bfhi(unsigned w) { return __uint_as_float(w & 0xffff0000u); }
template <int CTRL> __device__ __forceinline__ float dpp_mov(float v) { return __builtin_bit_cast(float, __builtin_amdgcn_update_dpp(0, __builtin_bit_cast(int, v), CTRL, 0xF, 0xF, true)); }
__device__ __forceinline__ float wave_sum(float v) {
    v += dpp_mov<0xB1>(v);
    v += dpp_mov<0x4E>(v);
    v += dpp_mov<0x141>(v);
    v += dpp_mov<0x140>(v);
    const int vi = __builtin_bit_cast(int, v);
    return (__builtin_bit_cast(float, __builtin_amdgcn_readlane(vi, 0)) + __builtin_bit_cast(float, __builtin_amdgcn_readlane(vi, 16)))
         + (__builtin_bit_cast(float, __builtin_amdgcn_readlane(vi, 32)) + __builtin_bit_cast(float, __builtin_amdgcn_readlane(vi, 48)));
}
template <int CTRL, int ROWMASK> __device__ __forceinline__ float dpp_old(float old, float v) { return __builtin_bit_cast(float, __builtin_amdgcn_update_dpp(__builtin_bit_cast(int, old), __builtin_bit_cast(int, v), CTRL, ROWMASK, 0xF, false)); }
__device__ __forceinline__ float lane_bcast(float v, int l) { return __builtin_bit_cast(float, __builtin_amdgcn_readlane(__builtin_bit_cast(int, v), l)); }
__device__ __forceinline__ float row16_sum(float v) { v += dpp_mov<0xB1>(v); v += dpp_mov<0x4E>(v); v += dpp_mov<0x141>(v); v += dpp_mov<0x140>(v); return v; }
__device__ __forceinline__ float logsigmoidf_(float x) { return fminf(x, 0.f) - log1pf(expf(-fabsf(x))); }
__device__ __forceinline__ float sigmoidf_(float x) { return 1.f / (1.f + expf(-x)); }
__device__ __forceinline__ float fast_sigmoid(float x) { return __builtin_amdgcn_rcpf(1.0f + __builtin_amdgcn_exp2f(-1.44269504f * x)); }

__device__ __forceinline__ int flane() { return (int)__builtin_amdgcn_mbcnt_hi(~0u, __builtin_amdgcn_mbcnt_lo(~0u, 0u)); }
__device__ __forceinline__ int olane() { int v; asm volatile("v_mbcnt_lo_u32_b32 %0, -1, 0\n\tv_mbcnt_hi_u32_b32 %0, -1, %0" : "=v"(v)); return v; }

constexpr size_t MiB = 1u << 20;
constexpr size_t WS_CTL = 0, CTL_ZERO_BYTES = 1 * MiB;
constexpr size_t WS_WIN = 1 * MiB;
constexpr size_t WS_WOUT = 6 * MiB;
constexpr size_t WS_WGU = 8 * MiB;
constexpr size_t WS_WD = 72 * MiB;
constexpr size_t WS_SGU = 104 * MiB;
constexpr size_t WS_SD = WS_SGU + 512 * 1024;
constexpr size_t WS_X1 = 105 * MiB;
constexpr size_t WS_CST = 105 * MiB;
constexpr size_t WS_CIN = 137 * MiB;
constexpr size_t WS_ACT = 169 * MiB;
constexpr size_t WS_YBUF = 241 * MiB;
constexpr size_t WS_P = 169 * MiB;
constexpr size_t WS_XB = 249 * MiB;
constexpr size_t WS_YCAT = 281 * MiB;
constexpr size_t WS_H2 = 369 * MiB;
constexpr size_t WS_SM = 385 * MiB;
constexpr size_t WS_RS1 = WS_SM, WS_GATES = WS_SM + 64 * 1024, WS_NST = WS_GATES + 512 * 1024, WS_MLOC = WS_NST + 512 * 1024, WS_BTOT = WS_MLOC + 4096, WS_MIN = WS_BTOT + 4096, WS_SH = WS_SM + 1280 * 1024, WS_NIN = WS_SM + 2560 * 1024,
                 WS_POOLWT = WS_SM + 1536 * 1024, WS_GATEOF = WS_SM + 2 * MiB, WS_LIST = WS_SM + 3 * MiB, WS_LSC = WS_LIST + (size_t)NE * T * 4, WS_LGW = WS_LSC + (size_t)NE * T * 4, WS_END = WS_LGW + (size_t)NE * T * 4;
static_assert(WS_END <= 396 * MiB, "ws map");
constexpr float ACT_CLIP = 16.0f, ACT_Q = 127.0f / ACT_CLIP, ACT_SCALE = ACT_CLIP / 127.0f;
constexpr float Y_CLIP = 3.0f, Y_Q = 127.0f / Y_CLIP, Y_SCALE = Y_CLIP / 127.0f;
constexpr int CW_CNT = 64;
constexpr int CW_BAR = 4096;
constexpr int CW_QHEAD = 24;

constexpr int RING_BYTES = 131072;
constexpr int LDS_TOK = RING_BYTES;
constexpr int LDS_TSC = LDS_TOK + 10 * 1024;
constexpr int LDS_CNT = LDS_TSC + 10 * 1024;
constexpr int LDS_TP = LDS_CNT + 128;
constexpr int LDS_TE = LDS_TP + 192;
constexpr int LDS_P6 = 153600;
constexpr int LDS_EPI = 153600;
constexpr int LDS_BARW = 163776;
constexpr int LDS_BYTES = 163840;
static_assert(LDS_TE + 1280 <= LDS_P6 && LDS_P6 + 9728 <= LDS_BARW, "LDS map");
constexpr int WR_LANE_STRIDE = 2064;

#define XB_TMO      128
#define XB_XCNT(j)  (256  + 64 * (j))
#define XB_XSUB(j)  (1280 + 64 * (j))
#define XB_XGEN(j)  (2304 + 64 * (j))
#define XB_TOP      3328
#define XB_TOPGEN   3392
#define XCD_BAR_WORDS 3456
#define XB_SPIN_CAP (1u << 18)
__device__ __forceinline__ unsigned xb_ld(unsigned* p)              { return __hip_atomic_load(p, __ATOMIC_RELAXED, __HIP_MEMORY_SCOPE_AGENT); }
__device__ __forceinline__ unsigned xb_add(unsigned* p, unsigned v) { return __hip_atomic_fetch_add(p, v, __ATOMIC_RELAXED, __HIP_MEMORY_SCOPE_AGENT); }
__device__ __forceinline__ unsigned xb_xcc_id() { return (unsigned)__builtin_amdgcn_s_getreg((3 << 11) | 20) & 0xFu; }
#define XB_SPIN(cond, bar) do { unsigned _sp = 0; while (cond) { __builtin_amdgcn_s_sleep(1); \
    if ((++_sp & 255u) == 0u) { if (xb_ld(&(bar)[XB_TMO])) break; if (_sp > XB_SPIN_CAP) { atomicAdd(&(bar)[XB_TMO], 1u); break; } } } } while (0)
struct XcdBarrier { unsigned* bar; unsigned x; volatile LAS unsigned* st; };
__device__ __forceinline__ XcdBarrier xcd_barrier_post(unsigned* bar, volatile LAS unsigned* st) {
    XcdBarrier b; b.bar = bar; b.x = xb_xcc_id(); b.st = st;
    if (threadIdx.x == 0) (void)xb_add(&bar[XB_XCNT(b.x)], 1u);
    return b;
}
__device__ __forceinline__ void xcd_barrier_complete(unsigned* bar, unsigned x, unsigned& nloc, unsigned& nx) {
    const unsigned G = gridDim.x * gridDim.y * gridDim.z;
    unsigned sum, cnt, mine, sp = 0u;
    for (;;) {
        sum = 0u; cnt = 0u; mine = 0u;
#pragma unroll
        for (unsigned j = 0; j < 16; ++j) { const unsigned c = xb_ld(&bar[XB_XCNT(j)]); sum += c; cnt += (c > 0u) ? 1u : 0u; mine = (j == x) ? c : mine; }
        if (sum == G) break;
        __builtin_amdgcn_s_sleep(1);
        if ((++sp & 255u) == 0u) { if (xb_ld(&bar[XB_TMO])) break; if (sp > XB_SPIN_CAP) { atomicAdd(&bar[XB_TMO], 1u); break; } }
    }
    nloc = mine > 0u ? mine : 1u; nx = cnt > 0u ? cnt : 1u;
}
__device__ __forceinline__ void xcd_barrier(const XcdBarrier& b, const int wave) {
    asm volatile("s_waitcnt vmcnt(0)" ::: "memory");
    __syncthreads();
    if (wave == 0 && flane() == 0) {
        unsigned* bar = b.bar;
        __builtin_amdgcn_s_waitcnt(0);
        unsigned nloc = b.st[0], nx = b.st[1];
        if (nloc == 0u) { xcd_barrier_complete(bar, b.x, nloc, nx); b.st[0] = nloc; b.st[1] = nx; }
        const unsigned old = xb_add(&bar[XB_XSUB(b.x)], 1u);
        const unsigned gen = old / nloc;
        if (old + 1u == (gen + 1u) * nloc) {
            __builtin_amdgcn_fence(__ATOMIC_RELEASE, "agent");
            asm volatile("s_waitcnt vmcnt(0)" ::: "memory");
            const unsigned og = xb_add(&bar[XB_TOP], 1u);
            const unsigned tg = og / nx;
            if (og + 1u == (tg + 1u) * nx) xb_add(&bar[XB_TOPGEN], 1u);
            else XB_SPIN(xb_ld(&bar[XB_TOPGEN]) == tg, bar);
            __builtin_amdgcn_fence(__ATOMIC_ACQUIRE, "agent");
            xb_add(&bar[XB_XGEN(b.x)], 1u);
            asm volatile("s_waitcnt vmcnt(0)" ::: "memory");
        } else {
            XB_SPIN(xb_ld(&bar[XB_XGEN(b.x)]) == gen, bar);
            __builtin_amdgcn_fence(__ATOMIC_ACQUIRE, "agent");
            asm volatile("s_waitcnt vmcnt(0)" ::: "memory");
        }
    }
    __syncthreads();
}

namespace pg8 {
typedef int i32x4 __attribute__((ext_vector_type(4)));
constexpr int BM = 256, BK = 64, HALF = 128, HTB = HALF * BK * 2, STAGE_BYTES = 8 * HTB, NXCD = 8, WGM = 8;
__host__ __device__ __forceinline__ int lds_byte(int r, int c) { const int st = (r >> 4) * 2 + (c >> 5), rr = r & 15, cc = c & 31, ob = rr * 64 + cc * 2; return st * 1024 + (ob ^ (((ob >> 9) & 1) << 5)); }
__host__ __device__ __forceinline__ void stage_rc(int b, int& R, int& C) { const int st = b / 1024, sb = b % 1024, swz = sb ^ (((sb >> 9) & 1) << 5); R = (st >> 1) * 16 + swz / 64; C = (st & 1) * 32 + (swz % 64) / 2; }
__host__ __device__ __forceinline__ int perm32(int rho) { const int n = rho >> 4, i = rho & 15; return 8 * (i >> 2) + 4 * n + (i & 3); }

struct Unit { int pm, pn, e, nv, lbase, half; };

struct DenseSched {
    static constexpr bool GATHER = false; static constexpr int ESZ_ = 2;
    const bf16_t* A; const bf16_t* Bt; int K; int nM, nN, nwg, G, c, nmine, nrep, nfull, split;
    __device__ __forceinline__ void init(const bf16_t* A_, const bf16_t* Bt_, int M, int N, int K_, int G_, int c_, int nrep_) { A = A_; Bt = Bt_; K = K_; nM = M / BM; nN = N / BM; nwg = nM * nN; G = G_; c = c_; nrep = nrep_;
        nfull = (nwg / G) * G; const int rest = nwg - nfull; split = (rest > 0 && 2 * rest <= G) ? 1 : 0;
        const int ntot = split ? nfull + 2 * rest : nwg; nmine = ntot > c ? (ntot - c + G - 1) / G : 0; }
    __device__ __forceinline__ bool next(int i, Unit& u) const {
        if (i >= nmine * nrep) return false; const int L = (i % nmine) * G + c;
        int wgid = L, half = 0;
        if (split && L >= nfull) { wgid = nfull + ((L - nfull) >> 1); half = 1 + ((L - nfull) & 1); }
        { const int q = nwg / NXCD, r = nwg % NXCD, xcd = wgid % NXCD, off = wgid / NXCD; wgid = (xcd < r ? xcd * (q + 1) : r * (q + 1) + (xcd - r) * q) + off; }
        const int nig = WGM * nN, gid = wgid / nig, fm = gid * WGM, gsz = (nM - fm) < WGM ? (nM - fm) : WGM;
        u.pm = fm + ((wgid % nig) % gsz); u.pn = (wgid % nig) / gsz; u.e = 0; u.nv = 256; u.lbase = 0; u.half = half; return true;
    }
    __device__ __forceinline__ const char* a_ptr(const Unit& u) const { return (const char*)A + ((size_t)u.pm * BM + (u.half == 2 ? HALF : 0)) * (size_t)2 * K; }
    __device__ __forceinline__ const char* b_ptr(const Unit& u) const { return (const char*)Bt + (size_t)u.pn * (size_t)(BM * 2) * K; }
    __device__ __forceinline__ void a_voff(int, const int (&R)[2], const int (&C)[2], unsigned (&vA)[2][2]) const {
#pragma unroll
        for (int h = 0; h < 2; ++h)
#pragma unroll
            for (int i = 0; i < 2; ++i) vA[h][i] = (unsigned)((h * HALF + R[i]) * K + C[i]) * 2u;
    }
};
template <bool GATHER_, int NT  , int ESZ  >
struct MoeSched {
    static constexpr bool GATHER = GATHER_;
    static constexpr int ESZ_ = ESZ;
    const void* A; const void* Bt; int K; int G, c, nunits, nmine, nrep, nfull, split;
    const LAS int* cnt; const LAS int* tp; const LAS int* te; const LAS int* tok;
    __device__ __forceinline__ bool next(int i, Unit& u) const {
        if (i >= nmine * nrep) return false; const int L = (i % nmine) * G + c;
        int wg = L, half = 0;
        if (split && L >= nfull) { wg = nfull + ((L - nfull) >> 1); half = 1 + ((L - nfull) & 1); }
        const int q = nunits / NXCD, r = nunits % NXCD, xcd = wg % NXCD, off = wg / NXCD;
        const int w = (xcd < r ? xcd * (q + 1) : r * (q + 1) + (xcd - r) * q) + off;
        const int tt = w / NT; u.pm = tt; u.pn = w % NT; u.half = half;
        const int e = __builtin_amdgcn_readfirstlane(te[tt]); u.e = e; const int j = tt - __builtin_amdgcn_readfirstlane(tp[e]); const int left = __builtin_amdgcn_readfirstlane(cnt[e]) - j * 256; u.nv = left < 256 ? left : 256; u.lbase = e * T + j * 256; return true;
    }
    __device__ __forceinline__ void setup(int nunits_, int G_, int c_, int nrep_, bool allow_split) { nunits = nunits_; G = G_; c = c_; nrep = nrep_;
        nfull = (nunits / G) * G; const int rest = nunits - nfull; split = (allow_split && rest > 0 && 2 * rest <= G) ? 1 : 0;
        const int ntot = split ? nfull + 2 * rest : nunits; nmine = ntot > c ? (ntot - c + G - 1) / G : 0; }
    __device__ __forceinline__ const char* a_ptr(const Unit& u) const { return GATHER ? (const char*)A : (const char*)A + ((size_t)u.pm * BM + (u.half == 2 ? HALF : 0)) * (size_t)ESZ * K; }
    __device__ __forceinline__ const char* b_ptr(const Unit& u) const { return (const char*)Bt + ((size_t)u.e * NT + u.pn) * (size_t)(BM * ESZ) * K; }
    __device__ __forceinline__ void a_voff(int ui, const int (&R)[2], const int (&C)[2], unsigned (&vA)[2][2]) const {
#pragma unroll
        for (int h = 0; h < 2; ++h)
#pragma unroll
            for (int i = 0; i < 2; ++i) vA[h][i] = GATHER ? (unsigned)tok[(ui % nmine) * 256 + h * HALF + R[i]] + (unsigned)C[i] * 2u : (unsigned)((h * HALF + R[i]) * K * ESZ + C[i] * 2);
    }
};

struct EpRowScaleBf16 {
    static constexpr bool PERM = true; typedef f32x4 acc_t;
    bf16_t* O; int ldc; const float* rs; LAS unsigned char* epi;
    __device__ __forceinline__ void prefetch(const Unit& u, int slot, int wid) const {
        if (wid < 4) __builtin_amdgcn_global_load_lds((const unsigned*)(rs + u.pm * BM + (u.half == 2 ? HALF : 0) + ((wid * 64 + flane()) & (u.half ? 127 : 255))), (LAS unsigned*)(epi + slot * 2048 + wid * 256), 4, 0, 0); }
    __device__ __forceinline__ void operator()(const f32x4 (&acc)[2][2][4][2], const Unit& u, int wr, int wc, int fr, int fq, int slot) const {
        const int row0 = u.pm * BM + (u.half == 2 ? HALF : 0) + wr * 64 + fr, col0 = u.pn * BM + wc * 32 + 8 * fq;
        const __amdgpu_buffer_rsrc_t orsrc = __builtin_amdgcn_make_buffer_rsrc((void*)O, 0, T * NP * 2, 0x00020000);
        const LAS float* rsl = (const LAS float*)(epi + slot * 2048) + wr * 64 + fr;
#pragma unroll
        for (int ai = 0; ai < 2; ++ai) if (ai == 0 || u.half == 0)
#pragma unroll
            for (int m = 0; m < 4; ++m) { const int row = row0 + ai * HALF + m * 16; const float s = rsl[ai * HALF + m * 16]; const int boff = (row * ldc + col0) * 2;
#pragma unroll
                for (int bj = 0; bj < 2; ++bj) { const f32x4 v0 = acc[ai][bj][m][0] * s, v1 = acc[ai][bj][m][1] * s;
                    u32x4 w; w.x = cvt_pk_bf16(v0[0], v0[1]); w.y = cvt_pk_bf16(v0[2], v0[3]); w.z = cvt_pk_bf16(v1[0], v1[1]); w.w = cvt_pk_bf16(v1[2], v1[3]);
                    __builtin_amdgcn_raw_buffer_store_b128(w, orsrc, boff + bj * HALF * 2, 0, 16); } }
    }
};
struct EpResidF32 {
    static constexpr bool PERM = false; typedef f32x4 acc_t;
    const float* base; float* C; int ldc;
    __device__ __forceinline__ void prefetch(const Unit&, int, int) const {}
    __device__ __forceinline__ void operator()(const f32x4 (&acc)[2][2][4][2], const Unit& u, int wr, int wc, int fr, int fq, int) const {
        const int row0 = u.pm * BM + (u.half == 2 ? HALF : 0) + wr * 64 + fr, col0 = u.pn * BM + wc * 32 + 4 * fq;
#pragma unroll
        for (int ai = 0; ai < 2; ++ai) if (ai == 0 || u.half == 0)
#pragma unroll
            for (int m = 0; m < 4; ++m) { const size_t off = (size_t)(row0 + ai * HALF + m * 16) * ldc + col0;
#pragma unroll
                for (int bj = 0; bj < 2; ++bj)
#pragma unroll
                    for (int n = 0; n < 2; ++n) { const f32x4 bs = *(const f32x4*)(base + off + bj * HALF + n * 16); *(f32x4*)(C + off + bj * HALF + n * 16) = bs + acc[ai][bj][m][n]; } }
    }
};
struct EpResidBf16 {
    static constexpr bool PERM = true; typedef f32x4 acc_t;
    const bf16_t* base; bf16_t* C; int ldc;
    __device__ __forceinline__ void prefetch(const Unit&, int, int) const {}
    __device__ __forceinline__ void operator()(const f32x4 (&acc)[2][2][4][2], const Unit& u, int wr, int wc, int fr, int fq, int) const {
        const int row0 = u.pm * BM + (u.half == 2 ? HALF : 0) + wr * 64 + fr, col0 = u.pn * BM + wc * 32 + 8 * fq;
#pragma unroll
        for (int ai = 0; ai < 2; ++ai) if (ai == 0 || u.half == 0)
#pragma unroll
            for (int m = 0; m < 4; ++m) { const size_t off = (size_t)(row0 + ai * HALF + m * 16) * ldc + col0;
#pragma unroll
                for (int bj = 0; bj < 2; ++bj) { const u32x4 bw = *(const u32x4*)(base + off + bj * HALF);
                    const f32x4 b0 = {__uint_as_float(bw.x << 16), __uint_as_float(bw.x & 0xffff0000u), __uint_as_float(bw.y << 16), __uint_as_float(bw.y & 0xffff0000u)};
                    const f32x4 b1 = {__uint_as_float(bw.z << 16), __uint_as_float(bw.z & 0xffff0000u), __uint_as_float(bw.w << 16), __uint_as_float(bw.w & 0xffff0000u)};
                    const f32x4 v0 = b0 + acc[ai][bj][m][0], v1 = b1 + acc[ai][bj][m][1];
                    u32x4 w; w.x = cvt_pk_bf16(v0[0], v0[1]); w.y = cvt_pk_bf16(v0[2], v0[3]); w.z = cvt_pk_bf16(v1[0], v1[1]); w.w = cvt_pk_bf16(v1[2], v1[3]);
                    *(u32x4*)(C + off + bj * HALF) = w; } }
    }
};
__device__ __forceinline__ f32x4 i2f(const i32x4 v) { return (f32x4){(float)v.x, (float)v.y, (float)v.z, (float)v.w}; }
__device__ __forceinline__ unsigned q4(const float a, const float b, const float c, const float d) {
    unsigned w = __builtin_amdgcn_cvt_pk_u8_f32(a + 128.0f, 0, 0u); w = __builtin_amdgcn_cvt_pk_u8_f32(b + 128.0f, 1, w); w = __builtin_amdgcn_cvt_pk_u8_f32(c + 128.0f, 2, w); w = __builtin_amdgcn_cvt_pk_u8_f32(d + 128.0f, 3, w);
    return w ^ 0x80808080u; }
typedef float f32x2p __attribute__((ext_vector_type(2)));
__device__ __forceinline__ f32x2p swiglu_q2(f32x2p gate, f32x2p up) {
    f32x2p g, uu; g.x = fminf(gate.x, 7.0f); g.y = fminf(gate.y, 7.0f); uu.x = __builtin_amdgcn_fmed3f(up.x, -7.0f, 7.0f); uu.y = __builtin_amdgcn_fmed3f(up.y, -7.0f, 7.0f);
    const f32x2p a = g * (-1.702f * 1.44269504f); f32x2p e; e.x = __builtin_amdgcn_exp2f(a.x); e.y = __builtin_amdgcn_exp2f(a.y);
    const f32x2p d = e + 1.0f; f32x2p r; r.x = __builtin_amdgcn_rcpf(d.x); r.y = __builtin_amdgcn_rcpf(d.y);
    const f32x2p t = g * r, uq = uu * ACT_Q + ACT_Q;
    return t * uq + 128.0f;
}
__device__ __forceinline__ unsigned pk_u8x4(f32x2p a, f32x2p b) {
    unsigned w = __builtin_amdgcn_cvt_pk_u8_f32(a.x, 0, 0u); w = __builtin_amdgcn_cvt_pk_u8_f32(a.y, 1, w); w = __builtin_amdgcn_cvt_pk_u8_f32(b.x, 2, w); w = __builtin_amdgcn_cvt_pk_u8_f32(b.y, 3, w); return w ^ 0x80808080u; }
struct EpGlu8 {
    static constexpr bool PERM = true; typedef i32x4 acc_t;
    signed char* act; const float* bg; const float* bu; const float* sgu; const LAS float* tsc; int nmine; mutable int ui; LAS unsigned char* epi;
    __device__ __forceinline__ void prefetch(const Unit& u, int slot, int wid) const {
        const int arr = wid >> 1, j = ((wid & 1) << 6) + flane();
        const float* pb = (arr == 0 ? bg : bu) + u.e * FF + u.pn * HALF + j; const float* ps = sgu + (size_t)u.e * 2048 + u.pn * BM + (arr == 3 ? HALF : 0) + j;
        __builtin_amdgcn_global_load_lds((const unsigned*)(arr < 2 ? pb : ps), (LAS unsigned*)(epi + slot * 2048 + wid * 256), 4, 0, 0); }
    __device__ __forceinline__ void operator()(const i32x4 (&acc)[2][2][4][2], const Unit& u, int wr, int wc, int fr, int fq, int slot) const {
        const int c0 = u.pn * HALF + wc * 32 + 8 * fq;
        const LAS f32x4* ev = (const LAS f32x4*)(epi + slot * 2048 + (wc * 32 + 8 * fq) * 4);
        f32x2p bgv[4], buv[4], sgv[4], suv[4];
#pragma unroll
        for (int hq = 0; hq < 2; ++hq) { const f32x4 b = ev[hq], bu4 = ev[32 + hq], sg4 = ev[64 + hq], su4 = ev[96 + hq];
            bgv[2 * hq] = (f32x2p){b.x, b.y}; bgv[2 * hq + 1] = (f32x2p){b.z, b.w}; buv[2 * hq] = (f32x2p){bu4.x, bu4.y}; buv[2 * hq + 1] = (f32x2p){bu4.z, bu4.w};
            sgv[2 * hq] = (f32x2p){sg4.x, sg4.y}; sgv[2 * hq + 1] = (f32x2p){sg4.z, sg4.w}; suv[2 * hq] = (f32x2p){su4.x, su4.y}; suv[2 * hq + 1] = (f32x2p){su4.z, su4.w}; }
        const LAS float* ts = tsc + (ui % nmine) * 256;
        float sav[2][4];
#pragma unroll
        for (int ai = 0; ai < 2; ++ai)
#pragma unroll
            for (int m = 0; m < 4; ++m) sav[ai][m] = ts[ai * HALF + wr * 64 + m * 16 + fr];
        asm volatile("s_waitcnt lgkmcnt(0)" ::: "memory");
#pragma unroll 1
        for (int rep_ = 0; rep_ < 1 + ((DUP_MASK >> 11) & 1); ++rep_)
#pragma unroll
        for (int ai = 0; ai < 2; ++ai)
#pragma unroll
            for (int m = 0; m < 4; ++m) { const int r = ai * HALF + wr * 64 + m * 16 + fr; const float sa = sav[ai][m];
                f32x2p o[4];
#pragma unroll
                for (int q = 0; q < 4; ++q) { const i32x4 ga = acc[ai][0][m][q >> 1], ua = acc[ai][1][m][q >> 1];
                    f32x2p gf, uf; if (q & 1) { gf.x = (float)ga.z; gf.y = (float)ga.w; uf.x = (float)ua.z; uf.y = (float)ua.w; } else { gf.x = (float)ga.x; gf.y = (float)ga.y; uf.x = (float)ua.x; uf.y = (float)ua.y; }
                    o[q] = swiglu_q2(gf * (sgv[q] * sa) + bgv[q], uf * (suv[q] * sa) + buv[q]); }
                const unsigned w0 = pk_u8x4(o[0], o[1]), w1 = pk_u8x4(o[2], o[3]);
                *(u32x2*)(act + (size_t)(u.pm * BM + r) * FF + c0) = (u32x2){w0, w1}; }
        ++ui;
    }
};
struct EpDown8 {
    static constexpr bool PERM = true; typedef i32x4 acc_t;
    unsigned char* ybuf; const float* bd; const float* sd; const LAS int* tok; const LAS float* tsc; int nmine; mutable int ui; LAS unsigned char* epi;
    __device__ __forceinline__ void prefetch(const Unit& u, int slot, int wid) const {
        const int j = ((wid & 3) << 6) + flane();
        __builtin_amdgcn_global_load_lds((const unsigned*)((wid < 4 ? bd : sd) + u.e * D + u.pn * BM + j), (LAS unsigned*)(epi + slot * 2048 + wid * 256), 4, 0, 0); }
    __device__ __forceinline__ void operator()(const i32x4 (&acc)[2][2][4][2], const Unit& u, int wr, int wc, int fr, int fq, int slot) const {
        const int c0 = u.pn * BM + wc * 32 + 8 * fq;
        const LAS f32x4* ev = (const LAS f32x4*)(epi + slot * 2048 + (wc * 32 + 8 * fq) * 4);
        f32x4 bv[2][2], sv[2][2];
#pragma unroll
        for (int bj = 0; bj < 2; ++bj)
#pragma unroll
            for (int n = 0; n < 2; ++n) { bv[bj][n] = ev[bj * 32 + n]; sv[bj][n] = ev[64 + bj * 32 + n] * ACT_SCALE; }
        int av[2][4]; float gwv[2][4];
#pragma unroll
        for (int ai = 0; ai < 2; ++ai)
#pragma unroll
            for (int m = 0; m < 4; ++m) { const int r = (u.half == 2 ? HALF : 0) + ai * HALF + wr * 64 + m * 16 + fr; const int rc = r < 256 ? r : 255;
                av[ai][m] = tok[(ui % nmine) * 256 + rc]; gwv[ai][m] = tsc[(ui % nmine) * 256 + rc] * Y_Q; }
        asm volatile("s_waitcnt lgkmcnt(0)" ::: "memory");
#pragma unroll
        for (int ai = 0; ai < 2; ++ai) if (ai == 0 || u.half == 0)
#pragma unroll
            for (int m = 0; m < 4; ++m) { const int r = (u.half == 2 ? HALF : 0) + ai * HALF + wr * 64 + m * 16 + fr;
                if (r < u.nv) { const int a = av[ai][m]; const float gw = gwv[ai][m]; unsigned char* rowp = ybuf + (size_t)a * D + c0;
#pragma unroll
                    for (int bj = 0; bj < 2; ++bj) { const f32x4 v0 = (i2f(acc[ai][bj][m][0]) * sv[bj][0] + bv[bj][0]) * gw + 128.0f, v1 = (i2f(acc[ai][bj][m][1]) * sv[bj][1] + bv[bj][1]) * gw + 128.0f;
                        u32x2 w; w.x = pk_u8x4((f32x2p){v0[0], v0[1]}, (f32x2p){v0[2], v0[3]}) ^ 0x80808080u; w.y = pk_u8x4((f32x2p){v1[0], v1[1]}, (f32x2p){v1[2], v1[3]}) ^ 0x80808080u;
                        *(u32x2*)(rowp + bj * HALF) = w; } } }
        ++ui;
    }
};

template <class Epi, class Sched, bool I8 = false, bool ALIGN_EPI = true>
__device__ __forceinline__ void gemm_phase(LAS unsigned char* lds, const Sched& S, const Epi& E, const int wid  ) {
    static_assert(Sched::ESZ_ == (I8 ? 1 : 2), "element size");
    typedef typename Epi::acc_t acc_t;
    const int lane = flane(), tid = wid * 64 + lane, wr = wid >> 2, wc = wid & 3, fr = lane & 15, fq = lane >> 4;
    const int K = S.K, PITCH = K * (I8 ? 1 : 2), nt = PITCH / (BK * 2);
    unsigned voffB[2], vA[2][2]; int Rr[2], Cc[2];
#pragma unroll
    for (int i = 0; i < 2; ++i) { int R, C; stage_rc(tid * 16 + i * 8192, R, C); const int Rb = Epi::PERM ? ((R & ~31) + perm32(R & 31)) : R;
        voffB[i] = (unsigned)(Rb * PITCH + C * 2); Rr[i] = R; Cc[i] = C; }
    const size_t kstep = (size_t)(BK * 2);
    const size_t hstep = (size_t)HALF * PITCH;
    const unsigned ldsw = (unsigned)wid * 1024u;
    const int aoff = lds_byte(wr * 64 + fr, fq * 8), boff = lds_byte(wc * 32 + fr, fq * 8);
#define PG8_SA(b, h) (((b) * 2 + (h)) * HTB)
#define PG8_SB(b, h) ((4 + (b) * 2 + (h)) * HTB)
#define PG8_STAGE(bufoff, gbase, voff) do { _Pragma("unroll") for (int _i = 0; _i < 2; ++_i) \
        __builtin_amdgcn_global_load_lds((const unsigned*)((const char*)(gbase) + (voff)[_i]), (LAS unsigned*)(lds + (bufoff) + ldsw + _i * 8192), 16, 0, 0); } while (0)
#define PG8_LDA(dst, b, h) do { _Pragma("unroll") for (int m = 0; m < 4; ++m) _Pragma("unroll") for (int k = 0; k < 2; ++k) dst[m][k] = *(const LAS bf16x8*)(lds + PG8_SA(b, h) + aoff + m * 2048 + k * 1024); } while (0)
#define PG8_LDB(dst, b, h) do { _Pragma("unroll") for (int n = 0; n < 2; ++n) _Pragma("unroll") for (int k = 0; k < 2; ++k) dst[n][k] = *(const LAS bf16x8*)(lds + PG8_SB(b, h) + boff + n * 2048 + k * 1024); } while (0)
#define PG8_MMA(ai, bj, At, Bt) do { __builtin_amdgcn_s_setprio(1); _Pragma("unroll") for (int m = 0; m < 4; ++m) _Pragma("unroll") for (int n = 0; n < 2; ++n) _Pragma("unroll") for (int k = 0; k < 2; ++k) \
        { if constexpr (I8) acc[ai][bj][m][n] = __builtin_amdgcn_mfma_i32_16x16x64_i8(__builtin_bit_cast(i32x4, Bt[n][k]), __builtin_bit_cast(i32x4, At[m][k]), acc[ai][bj][m][n], 0, 0, 0); \
          else acc[ai][bj][m][n] = __builtin_amdgcn_mfma_f32_16x16x32_bf16(Bt[n][k], At[m][k], acc[ai][bj][m][n], 0, 0, 0); } __builtin_amdgcn_s_setprio(0); } while (0)
#define PG8_WAIT_V(n) asm volatile("s_waitcnt vmcnt(" #n ")" ::: "memory")
#define PG8_WAIT_L(n) asm volatile("s_waitcnt lgkmcnt(" #n ")" ::: "memory")
#define PG8_BAR __builtin_amdgcn_s_barrier()
#define PG8_SCHED __builtin_amdgcn_sched_barrier(0)
    Unit cur, nxt; int ui = 0;
    if (!S.next(0, cur)) return;
    S.a_voff(0, Rr, Cc, vA);
    acc_t acc[2][2][4][2];
#pragma unroll
    for (int a = 0; a < 2; ++a)
#pragma unroll
        for (int b = 0; b < 2; ++b)
#pragma unroll
            for (int m = 0; m < 4; ++m)
#pragma unroll
                for (int n = 0; n < 2; ++n) acc[a][b][m][n] = (acc_t){0, 0, 0, 0};
    bf16x8 At[4][2], B0[2][2], B1[2][2];
    const char* cA = S.a_ptr(cur); const char* cB = S.b_ptr(cur);
    PG8_STAGE(PG8_SB(0, 0), cB, voffB); PG8_STAGE(PG8_SB(0, 1), cB + hstep, voffB); PG8_STAGE(PG8_SA(0, 0), cA, vA[0]); PG8_STAGE(PG8_SA(0, 1), cA, vA[1]);
    if (wr == 1) PG8_BAR;
    PG8_WAIT_V(2); PG8_BAR;
    PG8_STAGE(PG8_SB(1, 0), cB + kstep, voffB); PG8_STAGE(PG8_SA(1, 0), cA + kstep, vA[0]); PG8_STAGE(PG8_SB(1, 1), cB + hstep + kstep, voffB);
    PG8_WAIT_V(6); PG8_BAR;
    for (;;) {
        const bool has_next = S.next(ui + 1, nxt);
        E.prefetch(cur, ui & 1, wid);
        const bool hu = __builtin_amdgcn_readfirstlane(cur.half) != 0;
        const char* nA = has_next ? S.a_ptr(nxt) : cA; const char* nB = has_next ? S.b_ptr(nxt) : cB;
        constexpr int KP = (I8 && ((DUP_MASK >> 22) & 1)) ? 2 : 1;
#pragma unroll 1
        for (int kp = 0; kp < KP; ++kp)
#pragma unroll 1
        for (int t = 0; t < nt; t += 2) {
            const bool lastk = (t == nt - 2), last = lastk && (kp == KP - 1);
            const char* a1 = cA + (size_t)(t + 1) * kstep;
            const char* a2 = lastk ? (last ? nA : cA) : cA + (size_t)(t + 2) * kstep; const char* b2 = lastk ? (last ? nB : cB) : cB + (size_t)(t + 2) * kstep;
#define PG8_ZB() do { if (KP == 2 && kp == 0) { _Pragma("unroll") for (int n = 0; n < 2; ++n) _Pragma("unroll") for (int k = 0; k < 2; ++k) { B0[n][k] = (bf16x8){0,0,0,0,0,0,0,0}; B1[n][k] = (bf16x8){0,0,0,0,0,0,0,0}; } } } while (0)
            const char* a3 = a2 + kstep; const char* b3 = b2 + kstep;
            PG8_LDB(B0, 0, 0); PG8_LDB(B1, 0, 1); PG8_SCHED; PG8_LDA(At, 0, 0); PG8_STAGE(PG8_SA(1, 1), a1, vA[1]);
            if (Sched::GATHER) { if (last && has_next) S.a_voff(ui + 1, Rr, Cc, vA); }
            PG8_WAIT_V(8); PG8_WAIT_L(0); PG8_ZB(); PG8_BAR; PG8_MMA(0, 0, At, B0); PG8_MMA(0, 1, At, B1); PG8_BAR; PG8_SCHED;
            if (!hu) PG8_LDA(At, 0, 1); PG8_STAGE(PG8_SB(0, 0), b2, voffB); PG8_STAGE(PG8_SB(0, 1), b2 + hstep, voffB); PG8_STAGE(PG8_SA(0, 0), a2, vA[0]);
            PG8_WAIT_V(8); PG8_WAIT_L(0); PG8_BAR; if (!hu) { PG8_MMA(1, 0, At, B0); PG8_MMA(1, 1, At, B1); } PG8_BAR; PG8_SCHED;
            PG8_LDB(B0, 1, 0); PG8_LDB(B1, 1, 1); PG8_SCHED; PG8_LDA(At, 1, 0); PG8_STAGE(PG8_SA(0, 1), a2, vA[1]);
            PG8_WAIT_V(8); PG8_WAIT_L(0); PG8_ZB(); PG8_BAR; PG8_MMA(0, 0, At, B0); PG8_MMA(0, 1, At, B1); PG8_BAR; PG8_SCHED;
            if (!hu) PG8_LDA(At, 1, 1); PG8_STAGE(PG8_SB(1, 0), b3, voffB); PG8_STAGE(PG8_SB(1, 1), b3 + hstep, voffB); PG8_STAGE(PG8_SA(1, 0), a3, vA[0]);
            PG8_WAIT_V(8); PG8_WAIT_L(0); PG8_BAR; if (!hu) { PG8_MMA(1, 0, At, B0); PG8_MMA(1, 1, At, B1); } PG8_BAR; PG8_SCHED;
        }
        if constexpr (ALIGN_EPI) { if (wr == 0) PG8_BAR; }
        E(acc, cur, wr, wc, fr, fq, ui & 1);
        if (!has_next) break;
#pragma unroll
        for (int a = 0; a < 2; ++a)
#pragma unroll
            for (int b = 0; b < 2; ++b)
#pragma unroll
                for (int m = 0; m < 4; ++m)
#pragma unroll
                    for (int n = 0; n < 2; ++n) acc[a][b][m][n] = (acc_t){0, 0, 0, 0};
        cur = nxt; cA = nA; cB = nB; ++ui;
        if constexpr (ALIGN_EPI) { if (wr == 1) PG8_BAR; }
    }
    PG8_WAIT_V(0);
    if constexpr (!ALIGN_EPI) { if (wr == 0) PG8_BAR; }
    PG8_BAR;
#undef PG8_SA
#undef PG8_ZB
#undef PG8_SB
#undef PG8_STAGE
#undef PG8_LDA
#undef PG8_LDB
#undef PG8_MMA
#undef PG8_WAIT_V
#undef PG8_WAIT_L
#undef PG8_BAR
#undef PG8_SCHED
}
}

constexpr int NWAVES = 8, NTHR = 512;
struct Frame {
    LAS unsigned char* lds;
    int wave, vcu, G;
    const float* in[20]; float* out; unsigned char* ws;
};
struct Args { const float* in[20]; float* out; unsigned char* ws; int ph_lo, ph_hi; };
enum { I_X = 0, I_N1G, I_WIN, I_IGB, I_FGB, I_CONVW, I_HNG, I_POOLW, I_POOLS, I_WOUT, I_N2G, I_WR, I_BR, I_WG, I_BG, I_WU, I_BU, I_WD, I_BD, I_NFG };

#define LDS_WAIT() asm volatile("s_waitcnt lgkmcnt(0)" ::: "memory")

constexpr int QITEMS = NE * 3 * 32;
constexpr int QEXTRA = ((DUP_MASK >> 13) & 1) * 1024;
constexpr int QSTATIC = 0; static_assert(QSTATIC == 0, "the two-queue pull assumes no static share");
__device__ __forceinline__ void quant_item(const Frame& F, const int it, const int par) {
    const int lane = flane();
    signed char* wgu_q = (signed char*)(F.ws + WS_WGU); signed char* wd_q = (signed char*)(F.ws + WS_WD); float* sgu = (float*)(F.ws + WS_SGU); float* sd = (float*)(F.ws + WS_SD);
    LAS float* scr = (LAS float*)(F.lds + F.wave * 12800);
    LAS unsigned* tile = (LAS unsigned*)(F.lds + F.wave * 12800 + 8704);
    LAS float* cmax = (LAS float*)(F.lds + 8 * 12800);
    const int rsub = lane >> 3, cg = lane & 7, nn = lane & 31, kh = lane >> 5, k0 = 128 * F.wave;
    const float* const p_wg = F.in[I_WG]; const float* const p_wu = F.in[I_WU]; const float* const p_wd = F.in[I_WD];
    const int e = it / 96, r2 = it % 96, which = r2 >> 5, nb = r2 & 31;
    const float* mat = (which == 0 ? p_wg : (which == 1 ? p_wu : p_wd)) + (size_t)e * D * FF;
    const __amdgpu_buffer_rsrc_t rsrc = __builtin_amdgcn_make_buffer_rsrc((void*)mat, 0, D * FF * 4, 0x00020000);
    const int voff = ((k0 + rsub) * 1024 + 32 * nb + 4 * cg) * 4;
    f32x4 v[16];
#pragma unroll
    for (int i = 0; i < 16; ++i) v[i] = __builtin_bit_cast(f32x4, __builtin_amdgcn_raw_buffer_load_b128(rsrc, voff, i * 32768, 2  ));
    f32x4 m4 = {0.f, 0.f, 0.f, 0.f};
#pragma unroll
    for (int i = 0; i < 16; ++i) { m4.x = fmaxf(m4.x, fabsf(v[i].x)); m4.y = fmaxf(m4.y, fabsf(v[i].y)); m4.z = fmaxf(m4.z, fabsf(v[i].z)); m4.w = fmaxf(m4.w, fabsf(v[i].w)); }
#pragma unroll
    for (int o = 8; o < 64; o <<= 1) { m4.x = fmaxf(m4.x, __shfl_xor(m4.x, o)); m4.y = fmaxf(m4.y, __shfl_xor(m4.y, o)); m4.z = fmaxf(m4.z, __shfl_xor(m4.z, o)); m4.w = fmaxf(m4.w, __shfl_xor(m4.w, o)); }
    if (rsub == 0) *(LAS f32x4*)(cmax + (par * 8 + F.wave) * 32 + 4 * cg) = m4;
    __syncthreads();
    float M = 0.f;
#pragma unroll
    for (int w = 0; w < 8; ++w) M = fmaxf(M, cmax[(par * 8 + w) * 32 + nn]);
    const float inv = M > 0.f ? 127.0f / M : 0.f;
    { const int col = 32 * nb + nn, rowi = (which == 2) ? col : 256 * (col >> 7) + 128 * which + (col & 127);
      if (F.wave == 0 && kh == 0) { if (which == 2) sd[e * D + rowi] = M > 0.f ? M * (1.0f / 127.0f) : 1.0f; else sgu[e * 2048 + rowi] = M > 0.f ? M * (1.0f / 127.0f) : 1.0f; } }
#pragma unroll
    for (int half = 0; half < 2; ++half) {
#pragma unroll
        for (int i = 0; i < 8; ++i) { LAS float* d = scr + (8 * i + rsub) * 33 + 4 * cg; const f32x4 x = v[8 * half + i]; d[0] = x.x; d[1] = x.y; d[2] = x.z; d[3] = x.w; }
        LDS_WAIT(); asm volatile("" ::: "memory");
#pragma unroll
        for (int j = 0; j < 8; ++j) { const LAS float* sp = scr + (32 * kh + 4 * j) * 33 + nn;
            const unsigned w = pg8::q4(sp[0] * inv, sp[33] * inv, sp[66] * inv, sp[99] * inv);
            const int word = 16 * half + 8 * kh + j; tile[nn * 32 + (word ^ nn)] = w; }
        LDS_WAIT(); asm volatile("" ::: "memory");
    }
    signed char* dst = (which == 2) ? wd_q + (size_t)e * D * 1024 : wgu_q + (size_t)e * 2048 * 1024;
#pragma unroll
    for (int pss = 0; pss < 4; ++pss) { const int n = pss * 8 + (lane >> 3), j4 = lane & 7; u32x4 w;
        w.x = tile[n * 32 + ((4 * j4 + 0) ^ n)]; w.y = tile[n * 32 + ((4 * j4 + 1) ^ n)]; w.z = tile[n * 32 + ((4 * j4 + 2) ^ n)]; w.w = tile[n * 32 + ((4 * j4 + 3) ^ n)];
        const int coln = 32 * nb + n, rown = (which == 2) ? coln : 256 * (coln >> 7) + 128 * which + (coln & 127);
        *(u32x4*)(dst + (size_t)rown * 1024 + k0 + 16 * j4) = w; }
    LDS_WAIT(); asm volatile("" ::: "memory");
}
__device__ __forceinline__ bool quant_pull(const Frame& F, const int par, const int nq) {
    LAS unsigned* qw = (LAS unsigned*)(F.lds + LDS_BARW) + 2;
    if (F.wave == 0 && flane() == 0) { unsigned* qh = (unsigned*)(F.ws + WS_CTL) + CW_QHEAD;
        unsigned q = (unsigned)atomicAdd(qh, 1u), it = 0xffffffffu;
        if (q < (unsigned)(NE * 64 + QEXTRA)) { q %= (unsigned)(NE * 64); it = (q >> 6) * 96u + (q & 63u); }
        else if (nq > 1) { q = (unsigned)atomicAdd(qh + 64, 1u); if (q < (unsigned)(NE * 32)) it = (q >> 5) * 96u + 64u + (q & 31u); }
        qw[par] = it; }
    __syncthreads();
    const unsigned it = qw[par];
    if (it == 0xffffffffu) return false;
    quant_item(F, (int)it, par);
    return true;
}
__device__ __forceinline__ void xcd_barrier_fill(const XcdBarrier& b, const Frame& F) {
    asm volatile("s_waitcnt vmcnt(0)" ::: "memory");
    __syncthreads();
    LAS unsigned* st = (LAS unsigned*)(F.lds + LDS_BARW);
    const bool t0 = (F.wave == 0 && flane() == 0);
    if (t0) {
        unsigned* bar = b.bar;
        __builtin_amdgcn_s_waitcnt(0);
        unsigned nloc = b.st[0], nx = b.st[1];
        if (nloc == 0u) { xcd_barrier_complete(bar, b.x, nloc, nx); b.st[0] = nloc; b.st[1] = nx; }
        const unsigned old = xb_add(&bar[XB_XSUB(b.x)], 1u);
        const unsigned gen = old / nloc;
        if (old + 1u == (gen + 1u) * nloc) {
            __builtin_amdgcn_fence(__ATOMIC_RELEASE, "agent");
            asm volatile("s_waitcnt vmcnt(0)" ::: "memory");
            const unsigned og = xb_add(&bar[XB_TOP], 1u);
            const unsigned tg = og / nx;
            if (og + 1u == (tg + 1u) * nx) xb_add(&bar[XB_TOPGEN], 1u);
            else XB_SPIN(xb_ld(&bar[XB_TOPGEN]) == tg, bar);
            __builtin_amdgcn_fence(__ATOMIC_ACQUIRE, "agent");
            xb_add(&bar[XB_XGEN(b.x)], 1u);
            asm volatile("s_waitcnt vmcnt(0)" ::: "memory");
            st[2] = 0xffffffffu;
        } else { st[2] = 0u; st[3] = gen; }
    }
    __syncthreads();
    if (st[2] != 0xffffffffu) {
        const unsigned gen = st[3];
        LAS unsigned* rw = (LAS unsigned*)(F.lds + LDS_BARW + 32);
        __syncthreads();
        int par = 0;
        for (;;) {
            if (t0) rw[par] = (xb_ld(&b.bar[XB_XGEN(b.x)]) != gen) ? 1u : 0u;
            __syncthreads();
            if (rw[par]) break;
            if (!quant_pull(F, par, 2)) { if (t0) XB_SPIN(xb_ld(&b.bar[XB_XGEN(b.x)]) == gen, b.bar); break; }
            par ^= 1;
        }
        if (t0) { __builtin_amdgcn_fence(__ATOMIC_ACQUIRE, "agent"); asm volatile("s_waitcnt vmcnt(0)" ::: "memory"); }
    }
    __syncthreads();
}

__device__ __forceinline__ void p0_item_load(const float* __restrict__ W, int ldw, int col0, int k0, int lane, float (&wv)[32]) {
#pragma unroll
    for (int i = 0; i < 32; ++i) wv[i] = W[(size_t)(k0 + 2 * i + (lane >> 5)) * ldw + col0 + (lane & 31)];
}
__device__ __forceinline__ void p0_item_finish(const float (&wv)[32], const float* __restrict__ gk, bf16_t* wt, int k0, LAS float* scr, int lane) {
    const int c = lane & 7;
    f32x4 g0 = {1.f, 1.f, 1.f, 1.f}, g1 = {1.f, 1.f, 1.f, 1.f};
    if (gk) { g0 = *(const f32x4*)(gk + k0 + 8 * c); g1 = *(const f32x4*)(gk + k0 + 8 * c + 4); }
#pragma unroll
    for (int i = 0; i < 32; ++i) scr[(2 * i + (lane >> 5)) * 33 + (lane & 31)] = wv[i];
    LDS_WAIT(); asm volatile("" ::: "memory");
#pragma unroll
    for (int j = 0; j < 4; ++j) { const int n = (lane >> 3) + 8 * j; const LAS float* sp = scr + (8 * c) * 33 + n;
        u32x4 o; o.x = cvt_pk_bf16(sp[0 * 33] * g0.x, sp[1 * 33] * g0.y); o.y = cvt_pk_bf16(sp[2 * 33] * g0.z, sp[3 * 33] * g0.w); o.z = cvt_pk_bf16(sp[4 * 33] * g1.x, sp[5 * 33] * g1.y); o.w = cvt_pk_bf16(sp[6 * 33] * g1.z, sp[7 * 33] * g1.w);
        *(u32x4*)(wt + (size_t)n * 1024 + k0 + 8 * c) = o; }
    LDS_WAIT(); asm volatile("" ::: "memory");
}
#define P0_ITEM_OF(it_, W_, gk_, wt_, ldw_, col0_, k0_) \
    const bool in_ = (it_) < 16 * (NP / 32); const int q_ = in_ ? (it_) : (it_) - 16 * (NP / 32), nbk_ = in_ ? (NP / 32) : 32, kb_ = q_ / nbk_, nb_ = q_ % nbk_, n0_ = 32 * nb_; \
    const float* W_ = in_ ? p_win : p_wout; const float* gk_ = in_ ? p_g : nullptr; bf16_t* wt_ = (in_ ? win_t : wout_t) + (size_t)n0_ * 1024; \
    const int ldw_ = in_ ? NIN : D, col0_ = (in_ && n0_ >= 2048) ? n0_ + 8 : n0_, k0_ = 64 * kb_
__device__ __forceinline__ void phase0(Frame& F) {
    const int lane = flane(), tid = F.wave * 64 + lane;
    const int gw = F.vcu * NWAVES + F.wave, NGW = F.G * NWAVES;
    constexpr int NITEMS = 16 * (NP / 32) + 16 * 32;
    const int pi = blockIdx.x * NTHR + tid; float pwv = 0.f; const float* pw = F.in[I_POOLW];
    if (pi < 4 * 128 * 128) { const int g = pi >> 14, d = (pi >> 7) & 127, cc = pi & 127; pwv = pw[(g * 128 + cc) * 128 + d]; }
    const float* const p_win = F.in[I_WIN]; const float* const p_wout = F.in[I_WOUT]; const float* const p_g = F.in[I_N1G];
    bf16_t* const win_t = (bf16_t*)(F.ws + WS_WIN); bf16_t* const wout_t = (bf16_t*)(F.ws + WS_WOUT);
    float wv[32]; const bool have_item = gw < NITEMS; const int it_first = have_item ? gw : 0;
    P0_ITEM_OF(it_first, iW, igk, iwt, ildw, icol0, ik0);
    if (have_item) p0_item_load(iW, ildw, icol0, ik0, lane, wv);
    {
        LAS float* wgl = (LAS float*)(F.lds + 98304);
        const float* w_in = F.in[I_WIN]; const float* g1 = F.in[I_N1G];
        { float gwv[2][8], gg[2];
#pragma unroll
          for (int t = 0; t < 2; ++t) { const int sidx = tid + t * NTHR, j = sidx >> 8, q = (sidx >> 6) & 3, l = sidx & 63, k = 256 * j + 4 * l + q; gg[t] = g1[k];
#pragma unroll
              for (int i = 0; i < 8; ++i) gwv[t][i] = w_in[(size_t)k * NIN + 2048 + i]; }
#pragma unroll
          for (int t = 0; t < 2; ++t)
#pragma unroll
              for (int i = 0; i < 8; ++i) wgl[(tid + t * NTHR) * 8 + i] = gwv[t][i] * gg[t]; }
        __syncthreads();
        bf16_t* xb = (bf16_t*)(F.ws + WS_XB); float* rs1 = (float*)(F.ws + WS_RS1); float* gates = (float*)(F.ws + WS_GATES);
        const float* x = F.in[I_X];
        f32x4 nx[4];
        if (gw < T) { const f32x4* xr = (const f32x4*)(x + (size_t)gw * D) + lane;
#pragma unroll
            for (int j = 0; j < 4; ++j) nx[j] = xr[64 * j]; }
        for (int row = gw; row < T; row += NGW) {
            f32x4 v[4]; float ss = 0.f; float ga[8];
#pragma unroll
            for (int j = 0; j < 4; ++j) v[j] = nx[j];
            if (row + NGW < T) { const f32x4* xr = (const f32x4*)(x + (size_t)(row + NGW) * D) + lane;
#pragma unroll
                for (int j = 0; j < 4; ++j) nx[j] = xr[64 * j]; }
#pragma unroll
            for (int i = 0; i < 8; ++i) ga[i] = 0.f;
#pragma unroll
            for (int j = 0; j < 4; ++j) ss += (v[j].x * v[j].x + v[j].y * v[j].y) + (v[j].z * v[j].z + v[j].w * v[j].w);
#pragma unroll
            for (int j = 0; j < 4; ++j)
#pragma unroll
                for (int q = 0; q < 4; ++q) { const LAS f32x4* wp = (const LAS f32x4*)(wgl + (256 * j + 64 * q + lane) * 8); const f32x4 w0 = wp[0], w1 = wp[1]; const float xv = v[j][q];
                    ga[0] += xv * w0.x; ga[1] += xv * w0.y; ga[2] += xv * w0.z; ga[3] += xv * w0.w; ga[4] += xv * w1.x; ga[5] += xv * w1.y; ga[6] += xv * w1.z; ga[7] += xv * w1.w; }
            const float rs = rsqrtf(wave_sum(ss) * (1.f / D) + EPS);
            float mine = 0.f;
#pragma unroll
            for (int i = 0; i < 8; ++i) { const float sm = wave_sum(ga[i]); mine = (lane == i) ? sm : mine; }
            if (lane < 8) gates[(size_t)row * 8 + lane] = mine * rs;
            if (lane == 0) rs1[row] = rs;
            u32x2* o8 = (u32x2*)(xb + (size_t)row * D) + lane;
#pragma unroll
            for (int j = 0; j < 4; ++j) { u32x2 o; o.x = cvt_pk_bf16(v[j].x, v[j].y); o.y = cvt_pk_bf16(v[j].z, v[j].w); o8[64 * j] = o; }
        }
    }
    {
        LAS float* scr = (LAS float*)(F.lds + F.wave * 8704);
        if (have_item) p0_item_finish(wv, igk, iwt, ik0, scr, lane);
        for (int it = gw + NGW; it < NITEMS; it += NGW) { P0_ITEM_OF(it, tW, tgk, twt, tldw, tcol0, tk0); p0_item_load(tW, tldw, tcol0, tk0, lane, wv); p0_item_finish(wv, tgk, twt, tk0, scr, lane); }
    }
    if (pi < 4 * 128 * 128) { bf16_t* pwt = (bf16_t*)(F.ws + WS_POOLWT); pwt[pi] = (bf16_t)(cvt_pk_bf16(pwv, 0.f) & 0xffffu); }
    for (int i = pi + F.G * NTHR; i < 4 * 128 * 128; i += F.G * NTHR) { const int g = i >> 14, d = (i >> 7) & 127, cc = i & 127; ((bf16_t*)(F.ws + WS_POOLWT))[i] = (bf16_t)(cvt_pk_bf16(pw[(g * 128 + cc) * 128 + d], 0.f) & 0xffffu); }
    __syncthreads();
#pragma unroll 1
    for (int j = 0; j < QSTATIC * (1 + (DUP_MASK & 1)); ++j) quant_item(F, F.vcu + (j % (QSTATIC > 0 ? QSTATIC : 1)) * F.G, j & 1);
}

typedef short s16x4 __attribute__((ext_vector_type(4)));
typedef float f32x16 __attribute__((ext_vector_type(16)));
typedef float f32x8 __attribute__((ext_vector_type(8)));
typedef float f32x2 __attribute__((ext_vector_type(2)));
typedef __bf16 bfv8 __attribute__((ext_vector_type(8)));
typedef __bf16 bfv2 __attribute__((ext_vector_type(2)));
#define MFMA32(a, b, c) __builtin_amdgcn_mfma_f32_32x32x16_bf16((a), (b), (c), 0, 0, 0)
__device__ __forceinline__ bf16x8 pack8(float a0, float a1, float a2, float a3, float a4, float a5, float a6, float a7) {
    const f32x8 f = {a0, a1, a2, a3, a4, a5, a6, a7}; return __builtin_bit_cast(bf16x8, __builtin_convertvector(f, bfv8)); }
__device__ __forceinline__ unsigned pack2(float a, float b) { const f32x2 f = {a, b}; return __builtin_bit_cast(unsigned, __builtin_convertvector(f, bfv2)); }
__device__ __forceinline__ unsigned img_off(unsigned row, unsigned ch) { return 256u * row + 16u * (ch ^ (((row & 3u) << 2) | ((row >> 2) & 3u))); }
__device__ __forceinline__ bf16x8 img_rr(const LAS unsigned char* img, unsigned row0, unsigned lane, unsigned s) { return *(const LAS bf16x8*)(img + img_off(row0 + (lane & 31u), 2u * s + (lane >> 5))); }
__device__ __forceinline__ bf16x8 img_trn(const LAS unsigned char* img, unsigned k0, unsigned lane, unsigned c) {
    const unsigned h = lane >> 5, blk = (lane >> 4) & 1u, q = (lane & 15u) >> 2, p = lane & 3u, ch = 4u * c + 2u * blk + (p >> 1), sub = 8u * (p & 1u);
    const s16x4 lo = __builtin_amdgcn_ds_read_tr16_b64_v4i16((LAS s16x4*)(img + img_off(k0 + 8u * h + q, ch) + sub));
    const s16x4 hi = __builtin_amdgcn_ds_read_tr16_b64_v4i16((LAS s16x4*)(img + img_off(k0 + 8u * h + 4u + q, ch) + sub));
    return __builtin_shufflevector(lo, hi, 0, 1, 2, 3, 4, 5, 6, 7); }
__device__ __forceinline__ bf16x8 img_trp(const LAS unsigned char* img, unsigned k0, unsigned lane, unsigned c) {
    const unsigned h = lane >> 5, blk = (lane >> 4) & 1u, q = (lane & 15u) >> 2, p = lane & 3u, ch = 4u * c + 2u * blk + (p >> 1), sub = 8u * (p & 1u);
    const s16x4 lo = __builtin_amdgcn_ds_read_tr16_b64_v4i16((LAS s16x4*)(img + img_off(k0 + 4u * h + q, ch) + sub));
    const s16x4 hi = __builtin_amdgcn_ds_read_tr16_b64_v4i16((LAS s16x4*)(img + img_off(k0 + 8u + 4u * h + q, ch) + sub));
    return __builtin_shufflevector(lo, hi, 0, 1, 2, 3, 4, 5, 6, 7); }
__device__ __forceinline__ float wave_scan_add(float v, int) {
    v += dpp_old<0x111, 0xF>(0.f, v); v += dpp_old<0x112, 0xF>(0.f, v); v += dpp_old<0x114, 0xF>(0.f, v); v += dpp_old<0x118, 0xF>(0.f, v);
    v += dpp_old<0x142, 0xA>(0.f, v); v += dpp_old<0x143, 0xC>(0.f, v);
    return v; }
__device__ __forceinline__ float wave_scan_max(float v, int) {
    constexpr float NI = -3.0e38f;
    v = fmaxf(v, dpp_old<0x111, 0xF>(NI, v)); v = fmaxf(v, dpp_old<0x112, 0xF>(NI, v)); v = fmaxf(v, dpp_old<0x114, 0xF>(NI, v)); v = fmaxf(v, dpp_old<0x118, 0xF>(NI, v));
    v = fmaxf(v, dpp_old<0x142, 0xA>(NI, v)); v = fmaxf(v, dpp_old<0x143, 0xC>(NI, v));
    return v; }
__device__ __forceinline__ float wave_max(float v) {
    v = fmaxf(v, dpp_mov<0xB1>(v)); v = fmaxf(v, dpp_mov<0x4E>(v)); v = fmaxf(v, dpp_mov<0x141>(v)); v = fmaxf(v, dpp_mov<0x140>(v));
    return fmaxf(fmaxf(lane_bcast(v, 0), lane_bcast(v, 16)), fmaxf(lane_bcast(v, 32), lane_bcast(v, 48))); }
__device__ __forceinline__ void unpack8(const u32x4 w, float (&f)[8]) { f[0] = bflo(w.x); f[1] = bfhi(w.x); f[2] = bflo(w.y); f[3] = bfhi(w.y); f[4] = bflo(w.z); f[5] = bfhi(w.z); f[6] = bflo(w.w); f[7] = bfhi(w.w); }
__device__ __forceinline__ void conv2rows(const u32x4 (&pre)[5], const float (&cw)[4][8], float (&out)[2][8]) {
    float pf[5][8];
#pragma unroll
    for (int i = 0; i < 5; ++i) unpack8(pre[i], pf[i]);
#pragma unroll
    for (int rr = 0; rr < 2; ++rr)
#pragma unroll
        for (int e = 0; e < 8; ++e) { float a = 0.f;
#pragma unroll
            for (int j = 0; j < 4; ++j) a += pf[rr + j][e] * cw[j][e];
            out[rr][e] = a * fast_sigmoid(a); }
}
__device__ __forceinline__ void load_pre5(const bf16_t* __restrict__ P, int tok0, int c, int l0, int col, u32x4 (&pre)[5]) {
#pragma unroll
    for (int i = 0; i < 5; ++i) { const int l = l0 - 3 + i; pre[i] = (c * 64 + l >= 0) ? *(const u32x4*)(P + (size_t)(tok0 + l) * NP + col) : (u32x4){0u, 0u, 0u, 0u}; }
}
__device__ __forceinline__ void load_cw(const float* __restrict__ conv_w, int ch, float (&cw)[4][8]) {
#pragma unroll
    for (int j = 0; j < 4; ++j) { const f32x4 a = *(const f32x4*)(conv_w + j * 1024 + ch), b = *(const f32x4*)(conv_w + j * 1024 + ch + 4);
        cw[j][0] = a.x; cw[j][1] = a.y; cw[j][2] = a.z; cw[j][3] = a.w; cw[j][4] = b.x; cw[j][5] = b.y; cw[j][6] = b.z; cw[j][7] = b.w; }
}
constexpr float KSCALE = 0.08838834764831845f;

__device__ __forceinline__ void phase2_group(Frame& F) {
    const bf16_t* P = (const bf16_t*)(F.ws + WS_P); const float* gates = (const float*)(F.ws + WS_GATES); const float* conv_w = F.in[I_CONVW];
    u32x4* Cloc = (u32x4*)(F.ws + WS_CST); u32x4* Ctot = (u32x4*)(F.ws + WS_CIN); float* nst = (float*)(F.ws + WS_NST); float* mloc = (float*)(F.ws + WS_MLOC); float* btot = (float*)(F.ws + WS_BTOT);
    float* ntot = (float*)(F.ws + WS_NIN); float* mgrp = (float*)(F.ws + WS_MIN);
    LAS unsigned char* IMG_WK = F.lds; LAS unsigned char* IMG_V = F.lds + 16384; LAS float* s_w = (LAS float*)(F.lds + 32768);
    const int lane = flane(), wave = F.wave, tid = wave * 64 + lane, d8 = tid & 15, lq = tid >> 4, l0 = 2 * lq;
    u32x4 pre[5], vv[2]; float g_i = 0.f, g_f = 0.f;
#define P2_LOAD(uu) do { const int c_ = (uu) & 63, h_ = ((uu) >> 6) & 3, b_ = (uu) >> 8, tok0_ = b_ * SEQ + c_ * 64; \
        load_pre5(P, tok0_, c_, l0, 512 + h_ * 128 + 8 * d8, pre); \
        _Pragma("unroll") for (int rr = 0; rr < 2; ++rr) vv[rr] = *(const u32x4*)(P + (size_t)(tok0_ + l0 + rr) * NP + PC_V + h_ * 128 + 8 * d8); \
        if (wave == 0) { const float* pr_ = gates + (size_t)(tok0_ + lane) * 8; g_i = pr_[h_]; g_f = pr_[4 + h_]; } } while (0)
    for (int up = blockIdx.x; up < 256; up += F.G) {
        const int u0 = (up >> 4) * 64 + 4 * (up & 15), h = (up >> 4) & 3;
        P2_LOAD(u0);
        float cw[4][8]; load_cw(conv_w, 512 + h * 128 + 8 * d8, cw);
        const int a = wave >> 1, b0 = 2 * (wave & 1), r = lane & 31, hh = lane >> 5;
        f32x16 ct0, ct1, cn;
#pragma unroll
        for (int i = 0; i < 16; ++i) { ct0[i] = 0.f; ct1[i] = 0.f; cn[i] = 0.f; }
        float mg = -1e30f, Bg = 0.f;
#pragma unroll 1
        for (int cc = 0; cc < 4; ++cc) {
            const int u = u0 + cc;
            LAS float* sw = s_w + 128 * (cc & 1);
            if (wave == 0) { const float ig = g_i + F.in[I_IGB][h]; const float lf = logsigmoidf_(g_f + F.in[I_FGB][h]);
                const float bb = wave_scan_add(lf, lane); const float bt = lane_bcast(bb, 63); const float g = bt - bb + ig; const float m = wave_max(g);
                sw[lane] = expf(g - m); if (lane == 0) { mloc[u] = m; btot[u] = bt; sw[64] = m; sw[65] = bt; } }
            __syncthreads();
            const float ml = sw[64], bt = sw[65];
            { float kc[2][8]; conv2rows(pre, cw, kc);
#pragma unroll
              for (int rr = 0; rr < 2; ++rr) { const float w = sw[l0 + rr] * KSCALE;
                  *(LAS bf16x8*)(IMG_WK + img_off(l0 + rr, d8)) = pack8(kc[rr][0] * w, kc[rr][1] * w, kc[rr][2] * w, kc[rr][3] * w, kc[rr][4] * w, kc[rr][5] * w, kc[rr][6] * w, kc[rr][7] * w);
                  *(LAS u32x4*)(IMG_V + img_off(l0 + rr, d8)) = vv[rr]; } }
            __syncthreads();
            if (cc < 3) P2_LOAD(u + 1);
            f32x16 acc0, acc1, accn;
#pragma unroll
            for (int i = 0; i < 16; ++i) { acc0[i] = 0.f; acc1[i] = 0.f; accn[i] = 0.f; }
            const bf16x8 ones = {(short)0x3F80, (short)0x3F80, (short)0x3F80, (short)0x3F80, (short)0x3F80, (short)0x3F80, (short)0x3F80, (short)0x3F80};
#pragma unroll
            for (int ks = 0; ks < 4; ++ks) { const bf16x8 A = img_trn(IMG_WK, 16 * ks, lane, a);
                acc0 = MFMA32(A, img_trn(IMG_V, 16 * ks, lane, b0), acc0); acc1 = MFMA32(A, img_trn(IMG_V, 16 * ks, lane, b0 + 1), acc1);
                if (b0 == 0) accn = MFMA32(A, ones, accn); }
            if (b0 == 0 && r == 0) {
#pragma unroll
                for (int i = 0; i < 16; ++i) nst[(size_t)u * 128 + 32 * a + (i & 3) + 8 * (i >> 2) + 4 * hh] = accn[i]; }
            { u32x4* dst = Cloc + ((size_t)u * 8 + wave) * 256 + lane;
#pragma unroll
              for (int q = 0; q < 2; ++q) {
                  dst[q * 64] = (u32x4){pack2(acc0[8 * q], acc0[8 * q + 1]), pack2(acc0[8 * q + 2], acc0[8 * q + 3]), pack2(acc0[8 * q + 4], acc0[8 * q + 5]), pack2(acc0[8 * q + 6], acc0[8 * q + 7])};
                  dst[(2 + q) * 64] = (u32x4){pack2(acc1[8 * q], acc1[8 * q + 1]), pack2(acc1[8 * q + 2], acc1[8 * q + 3]), pack2(acc1[8 * q + 4], acc1[8 * q + 5]), pack2(acc1[8 * q + 6], acc1[8 * q + 7])}; } }
            { const float mn = fmaxf(bt + mg, ml), so = __expf(bt + mg - mn), sl = __expf(ml - mn);
#pragma unroll
              for (int i = 0; i < 16; ++i) { ct0[i] = so * ct0[i] + sl * acc0[i]; ct1[i] = so * ct1[i] + sl * acc1[i]; cn[i] = so * cn[i] + sl * accn[i]; }
              mg = mn; Bg += bt; }
        }
        { u32x4* dst = Ctot + ((size_t)up * 8 + wave) * 256 + lane;
#pragma unroll
          for (int q = 0; q < 2; ++q) {
              dst[q * 64] = (u32x4){pack2(ct0[8 * q], ct0[8 * q + 1]), pack2(ct0[8 * q + 2], ct0[8 * q + 3]), pack2(ct0[8 * q + 4], ct0[8 * q + 5]), pack2(ct0[8 * q + 6], ct0[8 * q + 7])};
              dst[(2 + q) * 64] = (u32x4){pack2(ct1[8 * q], ct1[8 * q + 1]), pack2(ct1[8 * q + 2], ct1[8 * q + 3]), pack2(ct1[8 * q + 4], ct1[8 * q + 5]), pack2(ct1[8 * q + 6], ct1[8 * q + 7])}; } }
        if (b0 == 0 && r == 0) {
#pragma unroll
            for (int i = 0; i < 16; ++i) ntot[(size_t)up * 128 + 32 * a + (i & 3) + 8 * (i >> 2) + 4 * hh] = cn[i]; }
        if (tid == 0) { mgrp[up] = mg; mgrp[256 + up] = Bg; }
        __syncthreads();
    }
#undef P2_LOAD
}
__device__ __forceinline__ void phase2_pool(Frame& F) {
    const bf16_t* P = (const bf16_t*)(F.ws + WS_P); bf16_t* ycat = (bf16_t*)(F.ws + WS_YCAT); const bf16_t* pwt = (const bf16_t*)(F.ws + WS_POOLWT); const float* pool_scale = F.in[I_POOLS];
    LAS unsigned char* IMG_PL = F.lds; LAS unsigned char* IMG_PW = F.lds + 16384; LAS unsigned char* STG = F.lds + 49152;
    const int lane = flane(), wave = F.wave, tid = wave * 64 + lane, d8 = tid & 15, lq = tid >> 4, l0 = 2 * lq;
    for (int u = blockIdx.x; u < 1024; u += F.G) {
        const int tok0 = (u >> 2) * 64, gi = u & 3, w = 2 << gi;
#pragma unroll
        for (int i = 0; i < 4; ++i) { const int idx = tid + i * NTHR, d = idx >> 4, j = idx & 15;
            *(LAS u32x4*)(IMG_PW + img_off(d, j)) = *(const u32x4*)(pwt + ((size_t)gi * 128 + d) * 128 + j * 8); }
        {
            const int s1 = ((tok0 + l0 + 1) & (SEQ - 1));
            const bf16_t* base = P + (size_t)(tok0 + l0 + 1) * NP + PC_U + gi * 128 + 8 * d8;
            u32x4 rw[17];
#pragma unroll
            for (int j = 0; j < 17; ++j) { int jj = j < w ? j : w; jj = jj < s1 ? jj : s1; rw[j] = *(const u32x4*)(base - (size_t)jj * NP); }
            float sum[8], cur0[8], cur1[8], old[8], f[8];
#pragma unroll
            for (int e = 0; e < 8; ++e) sum[e] = 0.f;
#pragma unroll
            for (int j = 2; j < 16; ++j) { const bool on = (j < w) && (s1 - j >= 0); unpack8(rw[j], f);
#pragma unroll
                for (int e = 0; e < 8; ++e) sum[e] += on ? f[e] : 0.f; }
            unpack8(rw[1], cur0); unpack8(rw[0], cur1);
            { const u32x4 ro = (w == 2) ? rw[2] : ((w == 4) ? rw[4] : ((w == 8) ? rw[8] : rw[16])); unpack8(ro, old); const bool on = (s1 - w >= 0);
#pragma unroll
              for (int e = 0; e < 8; ++e) old[e] = on ? old[e] : 0.f; }
            const int s0 = s1 - 1; const float ic0 = 1.f / (float)((s0 + 1 < w) ? s0 + 1 : w), ic1 = 1.f / (float)((s1 + 1 < w) ? s1 + 1 : w);
            float p0[8], p1[8];
#pragma unroll
            for (int e = 0; e < 8; ++e) { const float mid = sum[e] + cur0[e];
                p0[e] = (mid + old[e]) * ic0 - cur0[e]; p1[e] = (mid + cur1[e]) * ic1 - cur1[e]; }
            *(LAS bf16x8*)(IMG_PL + img_off(l0, d8)) = pack8(p0[0], p0[1], p0[2], p0[3], p0[4], p0[5], p0[6], p0[7]);
            *(LAS bf16x8*)(IMG_PL + img_off(l0 + 1, d8)) = pack8(p1[0], p1[1], p1[2], p1[3], p1[4], p1[5], p1[6], p1[7]);
        }
        __syncthreads();
        { const int wi = wave >> 2, wj = wave & 3, r = lane & 31, hh = lane >> 5;
          f32x16 acc;
#pragma unroll
          for (int i = 0; i < 16; ++i) acc[i] = 0.f;
#pragma unroll
          for (int sx = 0; sx < 8; ++sx) acc = MFMA32(img_rr(IMG_PL, 32 * wi, lane, sx), img_rr(IMG_PW, 32 * wj, lane, sx), acc);
          const int d = 32 * wj + r; const float sc = pool_scale[gi * 128 + d];
#pragma unroll
          for (int i = 0; i < 16; ++i) { const int l = 32 * wi + (i & 3) + 8 * (i >> 2) + 4 * hh;
              *(LAS unsigned short*)(STG + l * 256 + 2 * (d ^ ((l & 15) << 3))) = (unsigned short)(pack2(acc[i] * sc, 0.f) & 0xffffu); } }
        __syncthreads();
#pragma unroll
        for (int i = 0; i < 2; ++i) { const int idx = tid + i * NTHR, l = idx >> 4, j = idx & 15;
            *(u32x4*)(ycat + (size_t)(tok0 + l) * D + 512 + gi * 128 + j * 8) = *(const LAS u32x4*)(STG + l * 256 + ((j ^ (l & 15)) << 4)); }
        __syncthreads();
    }
}
__device__ __forceinline__ void state_axpy(f32x16& C0, f32x16& C1, const float so, const float sl, const u32x4 (&t)[4]) {
#pragma unroll
    for (int q = 0; q < 2; ++q) { float f[8]; unpack8(t[q], f);
#pragma unroll
        for (int e = 0; e < 8; ++e) C0[8 * q + e] = so * C0[8 * q + e] + sl * f[e];
        unpack8(t[2 + q], f);
#pragma unroll
        for (int e = 0; e < 8; ++e) C1[8 * q + e] = so * C1[8 * q + e] + sl * f[e]; }
}
__device__ __forceinline__ void phase4_group(Frame& F) {
    const bf16_t* P = (const bf16_t*)(F.ws + WS_P); const float* gates = (const float*)(F.ws + WS_GATES); const float* conv_w = F.in[I_CONVW]; const float* head_norm_g = F.in[I_HNG];
    const u32x4* Cloc = (const u32x4*)(F.ws + WS_CST); const u32x4* Ctot = (const u32x4*)(F.ws + WS_CIN); const float* nst = (const float*)(F.ws + WS_NST);
    const float* mloc = (const float*)(F.ws + WS_MLOC); const float* btot = (const float*)(F.ws + WS_BTOT); const float* ntot = (const float*)(F.ws + WS_NIN); const float* mgrp = (const float*)(F.ws + WS_MIN);
    bf16_t* ycat = (bf16_t*)(F.ws + WS_YCAT);
    LAS unsigned char* IMG_Q = F.lds; LAS unsigned char* IMG_K = F.lds + 16384; LAS unsigned char* IMG_V = F.lds + 32768; LAS unsigned char* IMG_C = F.lds + 49152;
    LAS float* HB = (LAS float*)(F.lds + 81920);
    LAS unsigned char* RAWQ = F.lds + 115712; LAS unsigned char* RAWK = RAWQ + 17408;
    LAS float* s_c = (LAS float*)(F.lds + 150528); LAS float* s_M = s_c + 64; LAS float* s_int = s_M + 64; LAS float* s_edn = s_int + 64; LAS float* s_qn = s_edn + 64; LAS float* s_rd = s_qn + 64;
    LAS float* s_n = s_rd + 256;
    const int lane = flane(), wave = F.wave, tid = wave * 64 + lane, d8 = tid & 15, lq = tid >> 4, l0 = 2 * lq;
#define P4_DMA_RAW(uu) do { const int c_ = (uu) & 63, h_ = ((uu) >> 6) & 3, b_ = (uu) >> 8, tok0_ = b_ * SEQ + c_ * 64; \
        _Pragma("unroll") for (int i = 0; i < 3; ++i) { const int pc = 8 * i + wave; if (pc < 17) { const int rr_ = pc * 4 + (lane >> 4); int tk = tok0_ - 3 + rr_; tk = tk < 0 ? 0 : (tk > T - 1 ? T - 1 : tk); \
            const char* src_ = (const char*)(P + (size_t)tk * NP + h_ * 128) + (lane & 15) * 16; \
            __builtin_amdgcn_global_load_lds((const unsigned*)src_, (LAS unsigned*)(RAWQ + pc * 1024), 16, 0, 0); \
            __builtin_amdgcn_global_load_lds((const unsigned*)(src_ + 1024), (LAS unsigned*)(RAWK + pc * 1024), 16, 0, 0); } } } while (0)
#define P4_DMA_V(uu) do { const int c_ = (uu) & 63, h_ = ((uu) >> 6) & 3, b_ = (uu) >> 8, tok0_ = b_ * SEQ + c_ * 64; const unsigned ol_ = (unsigned)olane(); \
        _Pragma("unroll") for (int i = 0; i < 2; ++i) { const unsigned d = (unsigned)((8 * i + wave) * 64) + ol_, row = d >> 4, sl = d & 15u, j = sl ^ (((row & 3u) << 2) | ((row >> 2) & 3u)); \
            __builtin_amdgcn_global_load_lds((const unsigned*)((const char*)(P + (size_t)(tok0_ + row) * NP + PC_V + h_ * 128) + j * 16), (LAS unsigned*)(IMG_V + (8 * i + wave) * 1024), 16, 0, 0); } } while (0)
    float g_i = 0.f, g_f = 0.f;
#define P4_GATES(uu) do { if (wave == 0) { const int c_ = (uu) & 63, h_ = ((uu) >> 6) & 3, b_ = (uu) >> 8; const float* pr_ = gates + (size_t)(b_ * SEQ + c_ * 64 + lane) * 8; g_i = pr_[h_]; g_f = pr_[4 + h_]; } } while (0)
    const int ca = wave >> 1, cb0 = 2 * (wave & 1), cr = lane & 31, chh = lane >> 5;
    {
        const int up = blockIdx.x; const int bh = up >> 4, g = up & 15, h = bh & 3, b = bh >> 2, u0 = bh * 64 + 4 * g;
        P4_DMA_RAW(u0); P4_DMA_V(u0); P4_GATES(u0);
        f32x16 C0, C1;
#pragma unroll
        for (int i = 0; i < 16; ++i) { C0[i] = 0.f; C1[i] = 0.f; }
        float m = 0.f, nv = 0.f;
        float mgv = -1e30f, Bgv = 0.f;
        if (lane < g) { mgv = mgrp[bh * 16 + lane]; Bgv = mgrp[256 + bh * 16 + lane]; }
#pragma unroll 1
        for (int j0 = 0; j0 < g; j0 += 8) {
            u32x4 t[8][4]; float nt[8];
#pragma unroll
            for (int jj = 0; jj < 8; ++jj) { const int j = (j0 + jj < g) ? j0 + jj : g - 1; const u32x4* src = Ctot + ((size_t)(bh * 16 + j) * 8 + wave) * 256 + lane;
#pragma unroll
                for (int q = 0; q < 4; ++q) t[jj][q] = src[q * 64];
                nt[jj] = (tid < 128) ? ntot[(size_t)(bh * 16 + j) * 128 + tid] : 0.f; }
#pragma unroll
            for (int jj = 0; jj < 8; ++jj) { const float mgj = lane_bcast(mgv, j0 + jj), Bgj = lane_bcast(Bgv, j0 + jj);
                const float mn = fmaxf(Bgj + m, mgj), so = __expf(Bgj + m - mn), sl = __expf(mgj - mn);
                state_axpy(C0, C1, so, sl, t[jj]); nv = so * nv + sl * nt[jj]; m = mn; }
        }
#pragma unroll
        for (int bb = 0; bb < 2; ++bb) { const unsigned dv = 32 * (cb0 + bb) + cr;
#pragma unroll
            for (int gq = 0; gq < 4; ++gq) { u32x2 w;
                if (bb == 0) { w.x = pack2(C0[4 * gq], C0[4 * gq + 1]); w.y = pack2(C0[4 * gq + 2], C0[4 * gq + 3]); } else { w.x = pack2(C1[4 * gq], C1[4 * gq + 1]); w.y = pack2(C1[4 * gq + 2], C1[4 * gq + 3]); }
                *(LAS u32x2*)(IMG_C + img_off(dv, 4 * ca + gq) + 8 * chh) = w; } }
#pragma unroll 1
        for (int cc = 0; cc < 4; ++cc) {
            const int u = u0 + cc, c = 4 * g + cc, tok0 = b * SEQ + c * 64;
            if (tid < 128) s_n[tid] = nv;
            float cwq[4][8], cwk[4][8]; load_cw(conv_w, h * 128 + 8 * d8, cwq); load_cw(conv_w, 512 + h * 128 + 8 * d8, cwk);
            asm volatile("s_waitcnt vmcnt(0)" ::: "memory");
            __syncthreads();
            if (wave == 0) { const float ig = g_i + F.in[I_IGB][h]; const float lf = logsigmoidf_(g_f + F.in[I_FGB][h]);
                const float bb = wave_scan_add(lf, lane); const float cc_ = ig - bb; const float M = fmaxf(m, wave_scan_max(cc_, lane));
                s_c[lane] = cc_; s_M[lane] = M; s_int[lane] = expf(m - M); s_edn[lane] = expf(-bb - M); }
            { u32x4 preq[5], prek[5];
              const f32x4 n0 = *(const LAS f32x4*)(s_n + 8 * d8), n1 = *(const LAS f32x4*)(s_n + 8 * d8 + 4);
#pragma unroll
              for (int i = 0; i < 5; ++i) { const bool ok = (c * 64 + l0 - 3 + i) >= 0; const u32x4 zq = *(const LAS u32x4*)(RAWQ + (l0 + i) * 256 + d8 * 16), zk = *(const LAS u32x4*)(RAWK + (l0 + i) * 256 + d8 * 16);
                  preq[i] = ok ? zq : (u32x4){0u, 0u, 0u, 0u}; prek[i] = ok ? zk : (u32x4){0u, 0u, 0u, 0u}; }
              float qc[2][8], kc[2][8]; conv2rows(preq, cwq, qc); conv2rows(prek, cwk, kc);
#pragma unroll
              for (int rr = 0; rr < 2; ++rr) {
                  *(LAS bf16x8*)(IMG_Q + img_off(l0 + rr, d8)) = pack8(qc[rr][0], qc[rr][1], qc[rr][2], qc[rr][3], qc[rr][4], qc[rr][5], qc[rr][6], qc[rr][7]);
                  *(LAS bf16x8*)(IMG_K + img_off(l0 + rr, d8)) = pack8(kc[rr][0] * KSCALE, kc[rr][1] * KSCALE, kc[rr][2] * KSCALE, kc[rr][3] * KSCALE, kc[rr][4] * KSCALE, kc[rr][5] * KSCALE, kc[rr][6] * KSCALE, kc[rr][7] * KSCALE);
                  float qn = (qc[rr][0] * n0.x + qc[rr][1] * n0.y) + (qc[rr][2] * n0.z + qc[rr][3] * n0.w) + (qc[rr][4] * n1.x + qc[rr][5] * n1.y) + (qc[rr][6] * n1.z + qc[rr][7] * n1.w);
                  qn = row16_sum(qn);
                  if (d8 == 0) s_qn[l0 + rr] = qn; } }
            __syncthreads();
            const bool more = (cc < 3);
            if (more) { P4_DMA_RAW(u + 1); P4_GATES(u + 1); }
            {
                const int wi = wave >> 2, wj = wave & 3, r = lane & 31, hh = lane >> 5, lcol = 32 * wi + r;
                const float Ml = s_M[lcol];
                bf16x8 pa[2][2]; float dsum = 0.f;
                bf16x8 qf[8];
#pragma unroll
                for (int sx = 0; sx < 8; ++sx) qf[sx] = img_rr(IMG_Q, 32 * wi, lane, sx);
#pragma unroll
                for (int rb = 0; rb < 2; ++rb) {
                    if (rb <= wi) {
                        f32x16 sa;
#pragma unroll
                        for (int i = 0; i < 16; ++i) sa[i] = 0.f;
                        { bf16x8 kf[8];
#pragma unroll
                          for (int sx = 0; sx < 8; ++sx) kf[sx] = img_rr(IMG_K, 32 * rb, lane, sx);
#pragma unroll
                          for (int sx = 0; sx < 8; ++sx) sa = MFMA32(kf[sx], qf[sx], sa); }
                        float pv[16];
#pragma unroll
                        for (int gq = 0; gq < 4; ++gq) { const f32x4 c4 = *(const LAS f32x4*)(s_c + 32 * rb + 8 * gq + 4 * hh);
#pragma unroll
                            for (int j = 0; j < 4; ++j) { const int rrow = 32 * rb + 8 * gq + 4 * hh + j; const float e = __expf(c4[j] - Ml);
                                const float v = (rrow <= lcol) ? sa[4 * gq + j] * e : 0.f; pv[4 * gq + j] = v; dsum += v; } }
                        pa[rb][0] = pack8(pv[0], pv[1], pv[2], pv[3], pv[4], pv[5], pv[6], pv[7]);
                        pa[rb][1] = pack8(pv[8], pv[9], pv[10], pv[11], pv[12], pv[13], pv[14], pv[15]);
                    }
                }
                dsum += __shfl_xor(dsum, 32);
                { const float den = dsum + s_int[lcol] * s_qn[lcol]; const float rd = 1.0f / fmaxf(fabsf(den), s_edn[lcol]); if (hh == 0) s_rd[wave * 32 + r] = rd; }
                f32x16 z, z2;
#pragma unroll
                for (int i = 0; i < 16; ++i) { z[i] = 0.f; z2[i] = 0.f; }
#pragma unroll
                for (int rb = 0; rb < 2; ++rb) if (rb <= wi) {
#pragma unroll
                    for (int sx = 0; sx < 2; ++sx) z = MFMA32(pa[rb][sx], img_trp(IMG_V, 32 * rb + 16 * sx, lane, wj), z); }
                { bf16x8 cf[8];
#pragma unroll
                  for (int sx = 0; sx < 8; ++sx) cf[sx] = img_rr(IMG_C, 32 * wj, lane, sx);
#pragma unroll
                  for (int sx = 0; sx < 8; ++sx) z2 = MFMA32(qf[sx], cf[sx], z2); }
#pragma unroll
                for (int gq = 0; gq < 4; ++gq) { const f32x4 rd4 = *(const LAS f32x4*)(s_rd + wave * 32 + 8 * gq + 4 * hh), in4 = *(const LAS f32x4*)(s_int + 32 * wi + 8 * gq + 4 * hh);
#pragma unroll
                    for (int j = 0; j < 4; ++j) HB[(32 * wi + 8 * gq + 4 * hh + j) * 132 + 32 * wj + r] = (z[4 * gq + j] + in4[j] * z2[4 * gq + j]) * rd4[j]; }
            }
            unsigned owc[8];
#pragma unroll
            for (int i = 0; i < 8; ++i) owc[i] = *(const unsigned*)(P + (size_t)(tok0 + wave * 8 + i) * NP + PC_O + h * 128 + 2 * lane);
            __syncthreads();
            u32x4 cl[4] = {{0u, 0u, 0u, 0u}, {0u, 0u, 0u, 0u}, {0u, 0u, 0u, 0u}, {0u, 0u, 0u, 0u}}; float nl = 0.f, ml = 0.f, bt = 0.f;
            if (more) { P4_DMA_V(u + 1);
                const u32x4* src = Cloc + ((size_t)u * 8 + wave) * 256 + olane();
#pragma unroll
                for (int q = 0; q < 4; ++q) cl[q] = src[q * 64];
                if (tid < 128) nl = nst[(size_t)u * 128 + tid];
                ml = mloc[u]; bt = btot[u]; }
            const f32x2 gg = *(const f32x2*)(head_norm_g + h * 128 + 2 * lane);
#pragma unroll
            for (int i = 0; i < 8; ++i) { const int l = wave * 8 + i; const f32x2 hv = *(const LAS f32x2*)(HB + l * 132 + 2 * lane);
                const float mu = wave_sum(hv.x + hv.y) * (1.f / 128.f); const float e0 = hv.x - mu, e1 = hv.y - mu;
                const float var = wave_sum(e0 * e0 + e1 * e1) * (1.f / 128.f); const float rstd = rsqrtf(var + EPS);
                *(unsigned*)(ycat + (size_t)(tok0 + l) * D + h * 128 + 2 * lane) = pack2(fast_sigmoid(bflo(owc[i])) * e0 * rstd * gg.x, fast_sigmoid(bfhi(owc[i])) * e1 * rstd * gg.y); }
            if (more) { const float mn = fmaxf(bt + m, ml), so = __expf(bt + m - mn), sl = __expf(ml - mn);
                const int ol = olane(), ocr = ol & 31, ochh = ol >> 5;
#pragma unroll
                for (int bb = 0; bb < 2; ++bb) { const unsigned dv = 32 * (cb0 + bb) + ocr;
#pragma unroll
                    for (int gq = 0; gq < 4; ++gq) { LAS u32x2* pp = (LAS u32x2*)(IMG_C + img_off(dv, 4 * ca + gq) + 8 * ochh); const u32x2 w = *pp;
                        const u32x4 cw4 = cl[2 * bb + (gq >> 1)]; const unsigned c0 = (gq & 1) ? cw4.z : cw4.x, c1 = (gq & 1) ? cw4.w : cw4.y;
                        u32x2 o; o.x = pack2(so * bflo(w.x) + sl * bflo(c0), so * bfhi(w.x) + sl * bfhi(c0)); o.y = pack2(so * bflo(w.y) + sl * bflo(c1), so * bfhi(w.y) + sl * bfhi(c1));
                        *pp = o; } }
                nv = so * nv + sl * nl; m = mn; }
        }
        asm volatile("s_waitcnt vmcnt(0)" ::: "memory");
        __syncthreads();
    }
#undef P4_DMA_RAW
#undef P4_DMA_V
#undef P4_GATES
}

__device__ __forceinline__ void phase6_route(Frame& F, const int probe_rep) {
    const int lane = flane(), wave = F.wave, tid = wave * 64 + lane;
    const bf16_t* x1 = (const bf16_t*)(F.ws + WS_X1); const float* g2 = F.in[I_N2G]; const float* w_router = F.in[I_WR]; const float* b_router = F.in[I_BR];
    signed char* h2 = (signed char*)(F.ws + WS_H2); float* shv = (float*)(F.ws + WS_SH); int* cnt0 = (int*)(F.ws + WS_CTL) + CW_CNT; int* list0 = (int*)(F.ws + WS_LIST); float* gate_of = (float*)(F.ws + WS_GATEOF);
    LAS unsigned char* WH = F.lds; LAS unsigned char* WL = F.lds + 65536;
    LAS float* LG = (LAS float*)(F.lds + LDS_TOK);
    LAS float* RST = LG + 64 * 33;
    LAS float* s_rs = RST + 256;
    LAS int* hist = (LAS int*)(F.lds + LDS_P6); LAS int* base = hist + 64; LAS int* s_e = base + 64; LAS int* s_t = s_e + 1024; LAS float* s_g = (LAS float*)(s_t + 256); LAS float* s_sh = s_g + 256;
    float* lsc = (float*)(F.ws + WS_LSC); float* lgw = (float*)(F.ws + WS_LGW);
    { const int e = tid & 31, kg = tid >> 5;
#pragma unroll 2
      for (int i = 0; i < 8; ++i) { const int c = kg + 16 * i; float w[8], wl[8];
#pragma unroll
          for (int j = 0; j < 8; ++j) { const int k = 8 * c + j; w[j] = w_router[(size_t)k * NE + e] * g2[k]; }
          const bf16x8 hi = pack8(w[0], w[1], w[2], w[3], w[4], w[5], w[6], w[7]);
#pragma unroll
          for (int j = 0; j < 8; ++j) wl[j] = w[j] - bf2f((unsigned short)hi[j]);
          const unsigned off = (unsigned)e * 2048u + 16u * (unsigned)(c ^ (e & 15));
          *(LAS bf16x8*)(WH + off) = hi; *(LAS bf16x8*)(WL + off) = pack8(wl[0], wl[1], wl[2], wl[3], wl[4], wl[5], wl[6], wl[7]); } }
    if (tid < 64) hist[tid] = 0;
    __syncthreads();
    const int t0 = 64 * F.vcu;
    const __amdgpu_buffer_rsrc_t x1rsrc = __builtin_amdgcn_make_buffer_rsrc((void*)x1, 0, T * D * 2, 0x00020000);
#pragma unroll 1
    for (int rep = 0; rep < probe_rep; ++rep) {
        {
            const int tb = wave >> 2, kq = wave & 3, r = lane & 31, h = lane >> 5;
            const int voff = (r * 1024 + 8 * h) * 2, sbase = ((t0 + 32 * tb) * 1024 + 256 * kq) * 2;
            f32x16 acc;
#pragma unroll
            for (int i = 0; i < 16; ++i) acc[i] = 0.f;
            float ss = 0.f;
#pragma unroll
            for (int sb = 0; sb < 16; sb += 8) {
                u32x4 xa[8];
#pragma unroll
                for (int sx = 0; sx < 8; ++sx) xa[sx] = __builtin_amdgcn_raw_buffer_load_b128(x1rsrc, voff, sbase + (sb + sx) * 32, 0);
#pragma unroll
                for (int sx = 0; sx < 8; ++sx) { float f[8]; unpack8(xa[sx], f);
                    ss += ((f[0] * f[0] + f[1] * f[1]) + (f[2] * f[2] + f[3] * f[3])) + ((f[4] * f[4] + f[5] * f[5]) + (f[6] * f[6] + f[7] * f[7]));
                    const bf16x8 ah = __builtin_bit_cast(bf16x8, xa[sx]);
                    const unsigned boff = (unsigned)r * 2048u + 16u * (unsigned)((32 * kq + 2 * (sb + sx) + h) ^ (r & 15));
                    const bf16x8 bh = *(const LAS bf16x8*)(WH + boff), bl = *(const LAS bf16x8*)(WL + boff);
                    acc = MFMA32(ah, bh, acc); acc = MFMA32(ah, bl, acc); }
            }
            ss += __shfl_xor(ss, 32);
            if (h == 0) RST[(32 * tb + r) * 4 + kq] = ss;
#pragma unroll 1
            for (int q = 0; q < 4; ++q) {
                if (kq == q) {
#pragma unroll
                    for (int i = 0; i < 16; ++i) { LAS float* pp = LG + (32 * tb + (i & 3) + 8 * (i >> 2) + 4 * h) * 33 + r; *pp = (q == 0 ? 0.f : *pp) + acc[i]; } }
                __syncthreads();
            }
        }
        LAS int* hist_ = hist + 32 * rep;
        if (wave == 0) {
            const int t = t0 + lane;
            const float rs = rsqrtf(((RST[lane * 4] + RST[lane * 4 + 1]) + (RST[lane * 4 + 2] + RST[lane * 4 + 3])) * (1.f / D) + EPS);
            s_rs[lane] = rs;
            float lg[32];
#pragma unroll
            for (int e = 0; e < 32; ++e) lg[e] = LG[lane * 33 + e] * rs + b_router[e];
            int bi[4]; float bv[4];
#pragma unroll
            for (int k = 0; k < 4; ++k) { float best = -INFINITY; int bb = 0;
#pragma unroll
                for (int e = 0; e < 32; ++e) if (lg[e] > best) { best = lg[e]; bb = e; }
#pragma unroll
                for (int e = 0; e < 32; ++e) if (e == bb) lg[e] = -INFINITY;
                bi[k] = bb; bv[k] = best; }
            float ex[4], se = 0.f;
#pragma unroll
            for (int k = 0; k < 4; ++k) { ex[k] = expf(bv[k] - bv[0]); se += ex[k]; }
#pragma unroll
            for (int k = 0; k < 4; ++k) { const int lr = __hip_atomic_fetch_add(hist_ + bi[k], 1, __ATOMIC_RELAXED, __HIP_MEMORY_SCOPE_WORKGROUP);
                s_e[lane * 4 + k] = bi[k] | (lr << 8); s_g[lane * 4 + k] = ex[k] / se; }
            s_t[lane] = t;
        }
        __syncthreads();
        int nbase = 0;
        if (tid < 32) { const int n = hist_[tid]; nbase = n ? atomicAdd(cnt0 + (rep ? 8128 : 0) + tid * 64, n) : 0; }
        if (rep == 0) {
            f32x4 gg[4]; u32x2 nx[4];
#pragma unroll
            for (int j = 0; j < 4; ++j) { gg[j] = *(const f32x4*)(g2 + 256 * j + 4 * lane); nx[j] = ((const u32x2*)(x1 + (size_t)(t0 + wave * 8) * D) + lane)[64 * j]; }
#pragma unroll 1
            for (int i = 0; i < 8; ++i) {
                const int li = wave * 8 + i, t = t0 + li; const float rs = s_rs[li];
                f32x4 hv[4]; float hmax = 0.f;
#pragma unroll
                for (int j = 0; j < 4; ++j) { hv[j] = (f32x4){bflo(nx[j].x), bfhi(nx[j].x), bflo(nx[j].y), bfhi(nx[j].y)} * gg[j];
                    hmax = fmaxf(fmaxf(hmax, fmaxf(fabsf(hv[j].x), fabsf(hv[j].y))), fmaxf(fabsf(hv[j].z), fabsf(hv[j].w))); }
                if (i < 7) { const u32x2* xr = (const u32x2*)(x1 + (size_t)(t + 1) * D) + lane;
#pragma unroll
                    for (int j = 0; j < 4; ++j) nx[j] = xr[64 * j]; }
                hmax = wave_max(hmax);
                const float qi = hmax > 0.f ? 127.0f / hmax : 0.f; unsigned* o4 = (unsigned*)(h2 + (size_t)t * D) + lane;
#pragma unroll
                for (int j = 0; j < 4; ++j) { const f32x4 hq = hv[j] * qi; o4[64 * j] = pg8::q4(hq.x, hq.y, hq.z, hq.w); }
                if (lane == 0) { const float shval = hmax > 0.f ? hmax * rs * (1.0f / 127.0f) : 1.0f; shv[t] = shval; s_sh[li] = shval; }
            }
        }
        if (tid < 32) base[tid] = nbase;
        __syncthreads();
        if (tid < 256) { const int li = tid >> 2, k = tid & 3, t = s_t[li]; const int ew = s_e[tid], e = ew & 255, lr = ew >> 8; int* list = rep ? (int*)(F.ws + WS_ACT) : list0;
            list[e * T + base[e] + lr] = t * 4 + k;
            if (!rep) { gate_of[t * 4 + k] = s_g[tid]; lsc[e * T + base[e] + lr] = s_sh[li]; lgw[e * T + base[e] + lr] = s_g[tid]; } }
        __syncthreads();
    }
}

__device__ __forceinline__ int moe_tables(Frame& F) {
    LAS int* lcnt = (LAS int*)(F.lds + LDS_CNT); LAS int* ltp = (LAS int*)(F.lds + LDS_TP); LAS int* lte = (LAS int*)(F.lds + LDS_TE);
    const int* cnt = (const int*)(F.ws + WS_CTL) + CW_CNT;
    const int lane = flane();
    if (F.wave == 0) {
        const int c = lane < NE ? cnt[lane * 64] : 0, nt = (c + 255) >> 8;
        const int incl = (int)wave_scan_add((float)nt, lane);
        const int excl = incl - nt;
        if (lane < NE) { lcnt[lane] = c; ltp[lane] = excl; for (int j = 0; j < nt; ++j) lte[excl + j] = lane; }
        if (lane == NE - 1) ltp[NE] = incl;
    }
    __syncthreads();
    return ltp[NE];
}
template <int MODE, class Sched>
__device__ __forceinline__ void build_row_tables(Frame& F, const Sched& S) {
    const int* list = (const int*)(F.ws + WS_LIST); const float* vals = (const float*)(F.ws + (MODE == 0 ? WS_LSC : WS_LGW));
    LAS int* tok = (LAS int*)(F.lds + LDS_TOK); LAS float* tsc = (LAS float*)(F.lds + LDS_TSC);
    const int tid = F.wave * 64 + flane(); const int nent = (S.nmine < 10 ? S.nmine : 10) * 256;
    int a[5]; float v[5];
#pragma unroll
    for (int k = 0; k < 5; ++k) { const int idx = tid + k * NTHR; a[k] = -1; v[k] = 0.f;
        if (idx < nent) { pg8::Unit u; S.next(idx >> 8, u); const int r = idx & 255; if (r < u.nv) { a[k] = list[u.lbase + r]; v[k] = vals[u.lbase + r]; } } }
#pragma unroll
    for (int k = 0; k < 5; ++k) { const int idx = tid + k * NTHR; if (idx < nent) { tok[idx] = a[k] < 0 ? 0 : (MODE == 0 ? (a[k] >> 2) * D : a[k]); tsc[idx] = v[k]; } }
    __syncthreads();
}

__device__ __forceinline__ void phase9_final(Frame& F) {
    const bf16_t* x1 = (const bf16_t*)(F.ws + WS_X1); const unsigned char* ybuf = (const unsigned char*)(F.ws + WS_YBUF); const float* gf = F.in[I_NFG]; float* out = F.out;
    const int gw = F.vcu * NWAVES + F.wave, NGW = F.G * NWAVES, lane = flane();
    f32x4 gg[4];
#pragma unroll
    for (int j = 0; j < 4; ++j) gg[j] = *(const f32x4*)(gf + 256 * j + 4 * lane);
    for (int t = gw; t < T; t += 2 * NGW) {
        f32x4 v[2][4]; unsigned y[2][4][4];
#pragma unroll
        for (int q = 0; q < 2; ++q) { const int tq = (t + q * NGW < T) ? t + q * NGW : t; const u32x2* xr = (const u32x2*)(x1 + (size_t)tq * D) + lane;
#pragma unroll
            for (int j = 0; j < 4; ++j) { const u32x2 xw = xr[64 * j]; v[q][j] = (f32x4){bflo(xw.x), bfhi(xw.x), bflo(xw.y), bfhi(xw.y)}; }
#pragma unroll
            for (int k = 0; k < 4; ++k) { const unsigned* yr = (const unsigned*)(ybuf + (size_t)(tq * 4 + k) * D) + lane;
#pragma unroll
                for (int j = 0; j < 4; ++j) y[q][k][j] = yr[64 * j]; } }
#pragma unroll
        for (int q = 0; q < 2; ++q) { if (t + q * NGW < T) {
#pragma unroll
            for (int j = 0; j < 4; ++j) { f32x4 sb = {0.f, 0.f, 0.f, 0.f};
#pragma unroll
                for (int k = 0; k < 4; ++k) { const unsigned yy = y[q][k][j]; sb.x += (float)(yy & 255u); sb.y += (float)((yy >> 8) & 255u); sb.z += (float)((yy >> 16) & 255u); sb.w += (float)(yy >> 24); }
                v[q][j] = v[q][j] + (sb - 512.0f) * Y_SCALE; }
            float ss = 0.f;
#pragma unroll
            for (int j = 0; j < 4; ++j) ss += (v[q][j].x * v[q][j].x + v[q][j].y * v[q][j].y) + (v[q][j].z * v[q][j].z + v[q][j].w * v[q][j].w);
            const float rs = rsqrtf(wave_sum(ss) * (1.f / D) + EPS);
            f32x4* orow = (f32x4*)(out + (size_t)(t + q * NGW) * D) + lane;
#pragma unroll
            for (int j = 0; j < 4; ++j) orow[64 * j] = v[q][j] * rs * gg[j]; } }
    }
}

__global__ void __launch_bounds__(NTHR, 2) mega(Args args) {
    extern __shared__ __attribute__((aligned(16))) unsigned char lds_raw[];
    Frame F;
    F.lds = (LAS unsigned char*)lds_raw;
    F.wave = __builtin_amdgcn_readfirstlane((int)threadIdx.x >> 6);
    F.G = gridDim.x; { const int bx = blockIdx.x; F.vcu = (F.G % 8 == 0) ? (bx % 8) * (F.G / 8) + bx / 8 : bx; }
#pragma unroll
    for (int i = 0; i < 20; ++i) F.in[i] = args.in[i];
    F.out = args.out; F.ws = args.ws;
    if (threadIdx.x < 16) ((LAS unsigned*)(F.lds + LDS_BARW))[threadIdx.x] = 0u;
    __syncthreads();
    unsigned* ctl = (unsigned*)(F.ws + WS_CTL);
    XcdBarrier bar; bar.bar = ctl + CW_BAR; bar.x = 0; bar.st = nullptr;
    if (MK_N_LAUNCHES == 1) bar = xcd_barrier_post(ctl + CW_BAR, (volatile LAS unsigned*)(F.lds + LDS_BARW));
    const int lo = args.ph_lo, hi = args.ph_hi;
#define IN(k) (lo <= (k) && (k) < hi)
#define SEAM(k) do { if (IN(k) && IN((k) + 1)) { if ((k) <= 6) xcd_barrier_fill(bar, F); else xcd_barrier(bar, F.wave); if ((DUP_MASK >> 10) & 1) xcd_barrier(bar, F.wave); } } while (0)

    if (IN(0)) { REP(0) phase0(F); SEAM(0); }
    if (IN(1)) { {
        pg8::DenseSched S; S.init((const bf16_t*)(F.ws + WS_XB), (const bf16_t*)(F.ws + WS_WIN), T, NP, D, F.G, (int)blockIdx.x, 1 + ((DUP_MASK >> 1) & 1));
        pg8::EpRowScaleBf16 E{(bf16_t*)(F.ws + WS_P), NP, (const float*)(F.ws + WS_RS1), F.lds + LDS_EPI};
        pg8::gemm_phase(F.lds, S, E, F.wave); }
        SEAM(1);
    }
    if (IN(2)) { REP(2) { phase2_group(F); phase2_pool(F); } SEAM(2); }
    if (IN(4)) { REP(4) phase4_group(F); SEAM(4); }
    if (IN(5)) { {
        pg8::DenseSched S; S.init((const bf16_t*)(F.ws + WS_YCAT), (const bf16_t*)(F.ws + WS_WOUT), T, D, D, F.G, (int)blockIdx.x, 1 + ((DUP_MASK >> 5) & 1));
        pg8::EpResidBf16 E{(const bf16_t*)(F.ws + WS_XB), (bf16_t*)(F.ws + WS_X1), D};
        pg8::gemm_phase(F.lds, S, E, F.wave); }
        SEAM(5);
    }
    if (IN(6)) { phase6_route(F, 1 + ((DUP_MASK >> 6) & 1)); __syncthreads(); { int par = 0; while (quant_pull(F, par, 1)) par ^= 1; } SEAM(6); }
    if (IN(7)) {
        const int ntiles = moe_tables(F);
        pg8::MoeSched<true, 8, 1> S; S.A = (const void*)(F.ws + WS_H2); S.Bt = (const void*)(F.ws + WS_WGU); S.K = D; S.setup(ntiles * 8, F.G, (int)blockIdx.x, 1 + ((DUP_MASK >> 7) & 1), false);
        S.cnt = (const LAS int*)(F.lds + LDS_CNT); S.tp = (const LAS int*)(F.lds + LDS_TP); S.te = (const LAS int*)(F.lds + LDS_TE); S.tok = (const LAS int*)(F.lds + LDS_TOK);
        build_row_tables<0>(F, S);
        pg8::EpGlu8 E{(signed char*)(F.ws + WS_ACT), F.in[I_BG], F.in[I_BU], (const float*)(F.ws + WS_SGU), (const LAS float*)(F.lds + LDS_TSC), S.nmine > 0 ? S.nmine : 1, 0, F.lds + LDS_EPI};
        pg8::gemm_phase<pg8::EpGlu8, pg8::MoeSched<true, 8, 1>, true, MOE_ALIGN>(F.lds, S, E, F.wave);
        { int par = 0; while (quant_pull(F, par, 2)) par ^= 1; }
        SEAM(7);
    }
    if (IN(8)) {
        const int ntiles = IN(7) ? ((const LAS int*)(F.lds + LDS_TP))[NE] : moe_tables(F);
        pg8::MoeSched<false, 4, 1> S; S.A = (const void*)(F.ws + WS_ACT); S.Bt = (const void*)(F.ws + WS_WD); S.K = FF; S.setup(ntiles * 4, F.G, (int)blockIdx.x, 1 + ((DUP_MASK >> 8) & 1), true);
        S.cnt = (const LAS int*)(F.lds + LDS_CNT); S.tp = (const LAS int*)(F.lds + LDS_TP); S.te = (const LAS int*)(F.lds + LDS_TE); S.tok = (const LAS int*)(F.lds + LDS_TOK);
        build_row_tables<1>(F, S);
        pg8::EpDown8 E{(unsigned char*)(F.ws + WS_YBUF), F.in[I_BD], (const float*)(F.ws + WS_SD), (const LAS int*)(F.lds + LDS_TOK), (const LAS float*)(F.lds + LDS_TSC), S.nmine > 0 ? S.nmine : 1, 0, F.lds + LDS_EPI};
        pg8::gemm_phase<pg8::EpDown8, pg8::MoeSched<false, 4, 1>, true, MOE_ALIGN>(F.lds, S, E, F.wave);
        SEAM(8);
    }
    if (IN(9)) { REP(9) phase9_final(F); }
#undef IN
#undef SEAM
}

extern "C" void kernel_launch(void* const* d_in, const int* in_sizes, int n_in, void* d_out, int out_size, void* d_ws, size_t ws_size, hipStream_t stream) {
    static int grid = 0;
    if (grid == 0) {
        if (n_in != 20 || in_sizes[0] != T * D || out_size != T * D || ws_size < WS_END) { fprintf(stderr, "kernel_launch: unexpected problem (n_in %d, ws %zu)\n", n_in, ws_size); grid = -1; return; }
        int dev = 0, cus = 0, per_cu = 0;
        if (hipGetDevice(&dev) != hipSuccess || hipDeviceGetAttribute(&cus, hipDeviceAttributeMultiprocessorCount, dev) != hipSuccess) { grid = -1; return; }
        if (hipFuncSetAttribute((const void*)mega, hipFuncAttributeMaxDynamicSharedMemorySize, LDS_BYTES) != hipSuccess) { fprintf(stderr, "kernel_launch: hipFuncSetAttribute failed\n"); grid = -1; return; }
        if (hipOccupancyMaxActiveBlocksPerMultiprocessor(&per_cu, (const void*)mega, NTHR, LDS_BYTES) != hipSuccess || per_cu < 1) fprintf(stderr, "kernel_launch: occupancy query reports %d\n", per_cu);
        (void)hipGetLastError();
        if (cus != 256) { fprintf(stderr, "kernel_launch: built for a 256-CU device (one 64-token routing block and one workgroup per CU); found %d CUs, nothing launched\n", cus); grid = -1; return; }
        grid = cus;
    }
    if (grid < 0) return;
    (void)hipMemsetAsync((char*)d_ws + WS_CTL, 0, CTL_ZERO_BYTES, stream);
    Args a{};
    for (int i = 0; i < 20; ++i) a.in[i] = (const float*)d_in[i];
    a.out = (float*)d_out; a.ws = (unsigned char*)d_ws;
    if (MK_N_LAUNCHES == 1) { a.ph_lo = 0; a.ph_hi = N_PHASES; hipLaunchKernelGGL(mega, dim3(grid), dim3(NTHR), LDS_BYTES, stream, a); }
    else for (int p = 0; p < N_PHASES; ++p) { a.ph_lo = p; a.ph_hi = p + 1; hipLaunchKernelGGL(mega, dim3(grid), dim3(NTHR), LDS_BYTES, stream, a); }
}
```

```cpp
#include <hip/hip_runtime.h>
#include <cstdio>
#include <cstdint>

#ifndef MK_N_LAUNCHES
#define MK_N_LAUNCHES 1
#endif
constexpr int N_PHASES = 10;
constexpr bool MOE_ALIGN = true;
#ifndef DUP_MASK
#define DUP_MASK 0
#endif
#define REP(k) for (int rep_ = 0; rep_ < 1 + ((DUP_MASK >> (k)) & 1); ++rep_)

constexpr int T = 16384, D = 1024, SEQ = 4096;
constexpr int NIN = 2568;
constexpr int NP = 2560;
constexpr int NE = 32, FF = 1024;
constexpr float EPS = 1e-5f;
constexpr int PC_V = 1024, PC_O = 1536, PC_U = 2048;

#define GAS __attribute__((address_space(1)))
#define LAS __attribute__((address_space(3)))
typedef unsigned short bf16_t;
typedef short bf16x8 __attribute__((ext_vector_type(8)));
typedef float f32x4 __attribute__((ext_vector_type(4)));
typedef unsigned u32x4 __attribute__((ext_vector_type(4)));
typedef unsigned u32x2 __attribute__((ext_vector_type(2)));

__device__ __forceinline__ unsigned cvt_pk_bf16(float lo, float hi) { unsigned r; asm volatile("v_cvt_pk_bf16_f32 %0, %1, %2" : "=v"(r) : "v"(lo), "v"(hi)); return r; }
__device__ __forceinline__ float bf2f(unsigned short b) { return __uint_as_float(((unsigned)b) << 16); }
__device__ __forceinline__ float bflo(unsigned w) { return __uint_as_float(w << 16); }
__device__ __forceinline__ float bfhi(unsigned w) { return __uint_as_float(w & 0xffff0000u); }
template <int CTRL> __device__ __forceinline__ float dpp_mov(float v) { return __builtin_bit_cast(float, __builtin_amdgcn_update_dpp(0, __builtin_bit_cast(int, v), CTRL, 0xF, 0xF, true)); }
__device__ __forceinline__ float wave_sum(float v) {
    v += dpp_mov<0xB1>(v);
    v += dpp_mov<0x4E>(v);
    v += dpp_mov<0x141>(v);
    v += dpp_mov<0x140>(v);
    const int vi = __builtin_bit_cast(int, v);
    return (__builtin_bit_cast(float, __builtin_amdgcn_readlane(vi, 0)) + __builtin_bit_cast(float, __builtin_amdgcn_readlane(vi, 16)))
         + (__builtin_bit_cast(float, __builtin_amdgcn_readlane(vi, 32)) + __builtin_bit_cast(float, __builtin_amdgcn_readlane(vi, 48)));
}
template <int CTRL, int ROWMASK> __device__ __forceinline__ float dpp_old(float old, float v) { return __builtin_bit_cast(float, __builtin_amdgcn_update_dpp(__builtin_bit_cast(int, old), __builtin_bit_cast(int, v), CTRL, ROWMASK, 0xF, false)); }
__device__ __forceinline__ float lane_bcast(float v, int l) { return __builtin_bit_cast(float, __builtin_amdgcn_readlane(__builtin_bit_cast(int, v), l)); }
__device__ __forceinline__ float row16_sum(float v) { v += dpp_mov<0xB1>(v); v += dpp_mov<0x4E>(v); v += dpp_mov<0x141>(v); v += dpp_mov<0x140>(v); return v; }
__device__ __forceinline__ float wave_max(float v) {
    v = fmaxf(v, dpp_mov<0xB1>(v)); v = fmaxf(v, dpp_mov<0x4E>(v)); v = fmaxf(v, dpp_mov<0x141>(v)); v = fmaxf(v, dpp_mov<0x140>(v));
    return fmaxf(fmaxf(lane_bcast(v, 0), lane_bcast(v, 16)), fmaxf(lane_bcast(v, 32), lane_bcast(v, 48))); }
__device__ __forceinline__ float logsigmoidf_(float x) { return fminf(x, 0.f) - __logf(1.0f + __expf(-fabsf(x))); }
__device__ __forceinline__ float sigmoidf_(float x) { return 1.f / (1.f + expf(-x)); }
__device__ __forceinline__ float fast_sigmoid(float x) { return __builtin_amdgcn_rcpf(1.0f + __builtin_amdgcn_exp2f(-1.44269504f * x)); }

__device__ __forceinline__ int flane() { return (int)__builtin_amdgcn_mbcnt_hi(~0u, __builtin_amdgcn_mbcnt_lo(~0u, 0u)); }
__device__ __forceinline__ int olane() { int v; asm volatile("v_mbcnt_lo_u32_b32 %0, -1, 0\n\tv_mbcnt_hi_u32_b32 %0, -1, %0" : "=v"(v)); return v; }

constexpr size_t MiB = 1u << 20;
constexpr size_t WS_CTL = 0, CTL_ZERO_BYTES = 1 * MiB;
constexpr size_t WS_WIN = 1 * MiB;
constexpr size_t WS_WOUT = 6 * MiB;
constexpr size_t WS_WGU = 8 * MiB;
constexpr size_t WS_WD = 72 * MiB;
constexpr size_t WS_SGU = 104 * MiB;
constexpr size_t WS_SD = WS_SGU + 512 * 1024;
constexpr size_t WS_X1 = 105 * MiB;
constexpr size_t WS_CST = 105 * MiB;
constexpr size_t WS_CIN = 137 * MiB;
constexpr size_t WS_ACT = 169 * MiB;
constexpr size_t WS_YBUF = 241 * MiB;
constexpr size_t WS_P = 169 * MiB;
constexpr size_t WS_XB = 249 * MiB;
constexpr size_t WS_YCAT = 281 * MiB;
constexpr size_t WS_H2 = 369 * MiB;
constexpr size_t WS_SM = 385 * MiB;
constexpr size_t WS_RS1 = WS_SM, WS_GATES = WS_SM + 64 * 1024, WS_NST = WS_GATES + 512 * 1024, WS_MLOC = WS_NST + 512 * 1024, WS_BTOT = WS_MLOC + 4096, WS_MIN = WS_BTOT + 4096, WS_SH = WS_SM + 1280 * 1024, WS_NIN = WS_SM + 2560 * 1024,
                 WS_POOLWT = WS_SM + 1536 * 1024, WS_GATEOF = WS_SM + 2 * MiB, WS_LIST = WS_SM + 3 * MiB, WS_LSC = WS_LIST + (size_t)NE * T * 4, WS_LGW = WS_LSC + (size_t)NE * T * 4, WS_SWIN = WS_LGW + (size_t)NE * T * 4, WS_SX = WS_SWIN + 16384  , WS_XQ = 396 * MiB, WS_END = WS_XQ + (size_t)T * D;
static_assert(WS_SX + (size_t)T * 4 <= 396 * MiB && WS_END <= 412 * MiB, "ws map");
constexpr float ACT_CLIP = 16.0f, ACT_Q = 127.0f / ACT_CLIP, ACT_SCALE = ACT_CLIP / 127.0f;
constexpr float Y_CLIP = 3.0f, Y_Q = 127.0f / Y_CLIP, Y_SCALE = Y_CLIP / 127.0f;
constexpr int CW_CNT = 64;
constexpr int CW_BAR = 4096;
constexpr int CW_QHEAD = 24;

constexpr int RING_BYTES = 131072;
constexpr int LDS_TOK = RING_BYTES;
constexpr int LDS_TSC = LDS_TOK + 10 * 1024;
constexpr int LDS_CNT = LDS_TSC + 10 * 1024;
constexpr int LDS_TP = LDS_CNT + 128;
constexpr int LDS_TE = LDS_TP + 192;
constexpr int LDS_P6 = 153600;
constexpr int LDS_EPI = 153600;
constexpr int LDS_BARW = 163776;
constexpr int LDS_BYTES = 163840;
static_assert(LDS_TE + 1280 <= LDS_P6 && LDS_P6 + 9728 <= LDS_BARW, "LDS map");
constexpr int WR_LANE_STRIDE = 2064;

#define XB_TMO      128
#define XB_XCNT(j)  (256  + 64 * (j))
#define XB_XSUB(j)  (1280 + 64 * (j))
#define XB_XGEN(j)  (2304 + 64 * (j))
#define XB_TOP      3328
#define XB_TOPGEN   3392
#define XCD_BAR_WORDS 3456
#define XB_SPIN_CAP (1u << 18)
__device__ __forceinline__ unsigned xb_ld(unsigned* p)              { return __hip_atomic_load(p, __ATOMIC_RELAXED, __HIP_MEMORY_SCOPE_AGENT); }
__device__ __forceinline__ unsigned xb_add(unsigned* p, unsigned v) { return __hip_atomic_fetch_add(p, v, __ATOMIC_RELAXED, __HIP_MEMORY_SCOPE_AGENT); }
__device__ __forceinline__ unsigned xb_xcc_id() { return (unsigned)__builtin_amdgcn_s_getreg((3 << 11) | 20) & 0xFu; }
#define XB_SPIN(cond, bar) do { unsigned _sp = 0; while (cond) { __builtin_amdgcn_s_sleep(1); \
    if ((++_sp & 255u) == 0u) { if (xb_ld(&(bar)[XB_TMO])) break; if (_sp > XB_SPIN_CAP) { atomicAdd(&(bar)[XB_TMO], 1u); break; } } } } while (0)
struct XcdBarrier { unsigned* bar; unsigned x; volatile LAS unsigned* st; };
__device__ __forceinline__ XcdBarrier xcd_barrier_post(unsigned* bar, volatile LAS unsigned* st) {
    XcdBarrier b; b.bar = bar; b.x = xb_xcc_id(); b.st = st;
    if (threadIdx.x == 0) (void)xb_add(&bar[XB_XCNT(b.x)], 1u);
    return b;
}
__device__ __forceinline__ void xcd_barrier_complete(unsigned* bar, unsigned x, unsigned& nloc, unsigned& nx) {
    const unsigned G = gridDim.x * gridDim.y * gridDim.z;
    unsigned sum, cnt, mine, sp = 0u;
    for (;;) {
        sum = 0u; cnt = 0u; mine = 0u;
#pragma unroll
        for (unsigned j = 0; j < 16; ++j) { const unsigned c = xb_ld(&bar[XB_XCNT(j)]); sum += c; cnt += (c > 0u) ? 1u : 0u; mine = (j == x) ? c : mine; }
        if (sum == G) break;
        __builtin_amdgcn_s_sleep(1);
        if ((++sp & 255u) == 0u) { if (xb_ld(&bar[XB_TMO])) break; if (sp > XB_SPIN_CAP) { atomicAdd(&bar[XB_TMO], 1u); break; } }
    }
    nloc = mine > 0u ? mine : 1u; nx = cnt > 0u ? cnt : 1u;
}
__device__ __forceinline__ void xcd_barrier_thread0(const XcdBarrier& b) {
    if (flane() == 0) {
        unsigned* bar = b.bar;
        __builtin_amdgcn_s_waitcnt(0);
        unsigned nloc = b.st[0], nx = b.st[1];
        if (nloc == 0u) { xcd_barrier_complete(bar, b.x, nloc, nx); b.st[0] = nloc; b.st[1] = nx; }
        const unsigned old = xb_add(&bar[XB_XSUB(b.x)], 1u);
        const unsigned gen = old / nloc;
        if (old + 1u == (gen + 1u) * nloc) {
            __builtin_amdgcn_fence(__ATOMIC_RELEASE, "agent");
            asm volatile("s_waitcnt vmcnt(0)" ::: "memory");
            const unsigned og = xb_add(&bar[XB_TOP], 1u);
            const unsigned tg = og / nx;
            if (og + 1u == (tg + 1u) * nx) xb_add(&bar[XB_TOPGEN], 1u);
            else XB_SPIN(xb_ld(&bar[XB_TOPGEN]) == tg, bar);
            __builtin_amdgcn_fence(__ATOMIC_ACQUIRE, "agent");
            xb_add(&bar[XB_XGEN(b.x)], 1u);
            asm volatile("s_waitcnt vmcnt(0)" ::: "memory");
        } else {
            XB_SPIN(xb_ld(&bar[XB_XGEN(b.x)]) == gen, bar);
            asm volatile("buffer_inv sc0" ::: "memory");
            asm volatile("s_waitcnt vmcnt(0)" ::: "memory");
        }
    }
}
__device__ __forceinline__ void xcd_barrier(const XcdBarrier& b, const int wave) {
    asm volatile("s_waitcnt vmcnt(0)" ::: "memory");
    __syncthreads();
    if (wave == 0) xcd_barrier_thread0(b);
    __syncthreads();
}

namespace pg8 {
typedef int i32x4 __attribute__((ext_vector_type(4)));
constexpr int BM = 256, BK = 64, HALF = 128, HTB = HALF * BK * 2, STAGE_BYTES = 8 * HTB, NXCD = 8, WGM = 8;
__host__ __device__ __forceinline__ int lds_byte(int r, int c) { const int st = (r >> 4) * 2 + (c >> 5), rr = r & 15, cc = c & 31, ob = rr * 64 + cc * 2; return st * 1024 + (ob ^ (((ob >> 9) & 1) << 5)); }
__host__ __device__ __forceinline__ void stage_rc(int b, int& R, int& C) { const int st = b / 1024, sb = b % 1024, swz = sb ^ (((sb >> 9) & 1) << 5); R = (st >> 1) * 16 + swz / 64; C = (st & 1) * 32 + (swz % 64) / 2; }
__host__ __device__ __forceinline__ int perm32(int rho) { const int n = rho >> 4, i = rho & 15; return 8 * (i >> 2) + 4 * n + (i & 3); }

struct Unit { int pm, pn, e, nv, lbase, half; };

template <int ESZ = 2>
struct DenseSchedT {
    static constexpr bool GATHER = false; static constexpr int ESZ_ = ESZ;
    const bf16_t* A; const bf16_t* Bt; int K; int nM, nN, nwg, G, c, nmine, nrep, nfull, split;
    __device__ __forceinline__ void init(const bf16_t* A_, const bf16_t* Bt_, int M, int N, int K_, int G_, int c_, int nrep_) { A = A_; Bt = Bt_; K = K_; nM = M / BM; nN = N / BM; nwg = nM * nN; G = G_; c = c_; nrep = nrep_;
        nfull = (nwg / G) * G; const int rest = nwg - nfull; split = (rest > 0 && 2 * rest <= G) ? 1 : 0;
        const int ntot = split ? nfull + 2 * rest : nwg; nmine = ntot > c ? (ntot - c + G - 1) / G : 0; }
    __device__ __forceinline__ bool next(int i, Unit& u) const {
        if (i >= nmine * nrep) return false; const int L = (i % nmine) * G + c;
        int wgid = L, half = 0;
        if (split && L >= nfull) { wgid = nfull + ((L - nfull) >> 1); half = 1 + ((L - nfull) & 1); }
        { const int q = nwg / NXCD, r = nwg % NXCD, xcd = wgid % NXCD, off = wgid / NXCD; wgid = (xcd < r ? xcd * (q + 1) : r * (q + 1) + (xcd - r) * q) + off; }
        const int nig = WGM * nN, gid = wgid / nig, fm = gid * WGM, gsz = (nM - fm) < WGM ? (nM - fm) : WGM;
        u.pm = fm + ((wgid % nig) % gsz); u.pn = (wgid % nig) / gsz; u.e = 0; u.nv = 256; u.lbase = 0; u.half = half; return true;
    }
    __device__ __forceinline__ const char* a_ptr(const Unit& u) const { return (const char*)A + ((size_t)u.pm * BM + (u.half == 2 ? HALF : 0)) * (size_t)ESZ * K; }
    __device__ __forceinline__ const char* b_ptr(const Unit& u) const { return (const char*)Bt + (size_t)u.pn * (size_t)(BM * ESZ) * K; }
    __device__ __forceinline__ void a_voff(int, const int (&R)[2], const int (&C)[2], unsigned (&vA)[2][2]) const {
#pragma unroll
        for (int h = 0; h < 2; ++h)
#pragma unroll
            for (int i = 0; i < 2; ++i) vA[h][i] = (unsigned)((h * HALF + R[i]) * K * ESZ + C[i] * 2);
    }
};
typedef DenseSchedT<2> DenseSched;
template <bool GATHER_, int NT  , int ESZ  >
struct MoeSched {
    static constexpr bool GATHER = GATHER_;
    static constexpr int ESZ_ = ESZ;
    const void* A; const void* Bt; int K; int G, c, nunits, nmine, nrep, nfull, split;
    const LAS int* cnt; const LAS int* tp; const LAS int* te; const LAS int* tok;
    __device__ __forceinline__ bool next(int i, Unit& u) const {
        if (i >= nmine * nrep) return false; const int L = (i % nmine) * G + c;
        int wg = L, half = 0;
        if (split && L >= nfull) { wg = nfull + ((L - nfull) >> 1); half = 1 + ((L - nfull) & 1); }
        const int q = nunits / NXCD, r = nunits % NXCD, xcd = wg % NXCD, off = wg / NXCD;
        const int w = (xcd < r ? xcd * (q + 1) : r * (q + 1) + (xcd - r) * q) + off;
        const int tt = w / NT; u.pm = tt; u.pn = w % NT; u.half = half;
        const int e = __builtin_amdgcn_readfirstlane(te[tt]); u.e = e; const int j = tt - __builtin_amdgcn_readfirstlane(tp[e]); const int left = __builtin_amdgcn_readfirstlane(cnt[e]) - j * 256; u.nv = left < 256 ? left : 256; u.lbase = e * T + j * 256; return true;
    }
    __device__ __forceinline__ void setup(int nunits_, int G_, int c_, int nrep_, bool allow_split) { nunits = nunits_; G = G_; c = c_; nrep = nrep_;
        nfull = (nunits / G) * G; const int rest = nunits - nfull; split = (allow_split && rest > 0 && 2 * rest <= G) ? 1 : 0;
        const int ntot = split ? nfull + 2 * rest : nunits; nmine = ntot > c ? (ntot - c + G - 1) / G : 0; }
    __device__ __forceinline__ const char* a_ptr(const Unit& u) const { return GATHER ? (const char*)A : (const char*)A + ((size_t)u.pm * BM + (u.half == 2 ? HALF : 0)) * (size_t)ESZ * K; }
    __device__ __forceinline__ const char* b_ptr(const Unit& u) const { return (const char*)Bt + ((size_t)u.e * NT + u.pn) * (size_t)(BM * ESZ) * K; }
    __device__ __forceinline__ void a_voff(int ui, const int (&R)[2], const int (&C)[2], unsigned (&vA)[2][2]) const {
#pragma unroll
        for (int h = 0; h < 2; ++h)
#pragma unroll
            for (int i = 0; i < 2; ++i) vA[h][i] = GATHER ? (unsigned)tok[(ui % nmine) * 256 + h * HALF + R[i]] + (unsigned)C[i] * 2u : (unsigned)((h * HALF + R[i]) * K * ESZ + C[i] * 2);
    }
};

struct EpRowScaleBf16 {
    static constexpr bool PERM = true; typedef f32x4 acc_t;
    bf16_t* O; int ldc; const float* rs; LAS unsigned char* epi;
    __device__ __forceinline__ void prefetch(const Unit& u, int slot, int wid) const {
        if (wid < 4) __builtin_amdgcn_global_load_lds((const unsigned*)(rs + u.pm * BM + (u.half == 2 ? HALF : 0) + ((wid * 64 + flane()) & (u.half ? 127 : 255))), (LAS unsigned*)(epi + slot * 2048 + wid * 256), 4, 0, 0); }
    __device__ __forceinline__ void operator()(const f32x4 (&acc)[2][2][4][2], const Unit& u, int wr, int wc, int fr, int fq, int slot) const {
        const int row0 = u.pm * BM + (u.half == 2 ? HALF : 0) + wr * 64 + fr, col0 = u.pn * BM + wc * 32 + 8 * fq;
        const __amdgpu_buffer_rsrc_t orsrc = __builtin_amdgcn_make_buffer_rsrc((void*)O, 0, T * NP * 2, 0x00020000);
        const LAS float* rsl = (const LAS float*)(epi + slot * 2048) + wr * 64 + fr;
#pragma unroll
        for (int ai = 0; ai < 2; ++ai) if (ai == 0 || u.half == 0)
#pragma unroll
            for (int m = 0; m < 4; ++m) { const int row = row0 + ai * HALF + m * 16; const float s = rsl[ai * HALF + m * 16]; const int boff = (row * ldc + col0) * 2;
#pragma unroll
                for (int bj = 0; bj < 2; ++bj) { const f32x4 v0 = acc[ai][bj][m][0] * s, v1 = acc[ai][bj][m][1] * s;
                    u32x4 w; w.x = cvt_pk_bf16(v0[0], v0[1]); w.y = cvt_pk_bf16(v0[2], v0[3]); w.z = cvt_pk_bf16(v1[0], v1[1]); w.w = cvt_pk_bf16(v1[2], v1[3]);
                    __builtin_amdgcn_raw_buffer_store_b128(w, orsrc, boff + bj * HALF * 2, 0, 16); } }
    }
};
struct EpRowColScale8 {
    static constexpr bool PERM = true; typedef i32x4 acc_t;
    bf16_t* O; int ldc; const float* rsc; const float* csc; LAS unsigned char* epi;
    __device__ __forceinline__ void prefetch(const Unit& u, int slot, int wid) const {
        const int l = wid * 64 + flane();
        const float* src = wid < 4 ? rsc + u.pm * BM + (u.half == 2 ? HALF : 0) + (l & (u.half ? 127 : 255)) : csc + u.pn * BM + (l - 256);
        __builtin_amdgcn_global_load_lds((const unsigned*)src, (LAS unsigned*)(epi + slot * 2048 + wid * 256), 4, 0, 0); }
    __device__ __forceinline__ void operator()(const i32x4 (&acc)[2][2][4][2], const Unit& u, int wr, int wc, int fr, int fq, int slot) const {
        const int row0 = u.pm * BM + (u.half == 2 ? HALF : 0) + wr * 64 + fr, col0 = u.pn * BM + wc * 32 + 8 * fq;
        const __amdgpu_buffer_rsrc_t orsrc = __builtin_amdgcn_make_buffer_rsrc((void*)O, 0, T * NP * 2, 0x00020000);
        const LAS float* rsl = (const LAS float*)(epi + slot * 2048) + wr * 64 + fr;
        const LAS f32x4* cv = (const LAS f32x4*)(epi + slot * 2048 + 1024 + (wc * 32 + 8 * fq) * 4);
        f32x4 sv[2][2];
#pragma unroll
        for (int bj = 0; bj < 2; ++bj)
#pragma unroll
            for (int n = 0; n < 2; ++n) sv[bj][n] = cv[bj * 32 + n];
        float rs[2][4];
#pragma unroll
        for (int ai = 0; ai < 2; ++ai)
#pragma unroll
            for (int m = 0; m < 4; ++m) rs[ai][m] = rsl[ai * HALF + m * 16];
        asm volatile("s_waitcnt lgkmcnt(0)" ::: "memory");
#pragma unroll
        for (int ai = 0; ai < 2; ++ai) if (ai == 0 || u.half == 0)
#pragma unroll
            for (int m = 0; m < 4; ++m) { const int row = row0 + ai * HALF + m * 16; const float s = rs[ai][m]; const int boff = (row * ldc + col0) * 2;
#pragma unroll
                for (int bj = 0; bj < 2; ++bj) { const i32x4 a0 = acc[ai][bj][m][0], a1 = acc[ai][bj][m][1];
                    const f32x4 v0 = (f32x4){(float)a0.x, (float)a0.y, (float)a0.z, (float)a0.w} * (sv[bj][0] * s), v1 = (f32x4){(float)a1.x, (float)a1.y, (float)a1.z, (float)a1.w} * (sv[bj][1] * s);
                    u32x4 w; w.x = cvt_pk_bf16(v0[0], v0[1]); w.y = cvt_pk_bf16(v0[2], v0[3]); w.z = cvt_pk_bf16(v1[0], v1[1]); w.w = cvt_pk_bf16(v1[2], v1[3]);
                    __builtin_amdgcn_raw_buffer_store_b128(w, orsrc, boff + bj * HALF * 2, 0, 16); } }
    }
};
struct EpResidF32 {
    static constexpr bool PERM = false; typedef f32x4 acc_t;
    const float* base; float* C; int ldc;
    __device__ __forceinline__ void prefetch(const Unit&, int, int) const {}
    __device__ __forceinline__ void operator()(const f32x4 (&acc)[2][2][4][2], const Unit& u, int wr, int wc, int fr, int fq, int) const {
        const int row0 = u.pm * BM + (u.half == 2 ? HALF : 0) + wr * 64 + fr, col0 = u.pn * BM + wc * 32 + 4 * fq;
#pragma unroll
        for (int ai = 0; ai < 2; ++ai) if (ai == 0 || u.half == 0)
#pragma unroll
            for (int m = 0; m < 4; ++m) { const size_t off = (size_t)(row0 + ai * HALF + m * 16) * ldc + col0;
#pragma unroll
                for (int bj = 0; bj < 2; ++bj)
#pragma unroll
                    for (int n = 0; n < 2; ++n) { const f32x4 bs = *(const f32x4*)(base + off + bj * HALF + n * 16); *(f32x4*)(C + off + bj * HALF + n * 16) = bs + acc[ai][bj][m][n]; } }
    }
};
struct EpResidBf16 {
    static constexpr bool PERM = true; typedef f32x4 acc_t;
    const bf16_t* base; bf16_t* C; int ldc;
    __device__ __forceinline__ void prefetch(const Unit&, int, int) const {}
    __device__ __forceinline__ void operator()(const f32x4 (&acc)[2][2][4][2], const Unit& u, int wr, int wc, int fr, int fq, int) const {
        const int row0 = u.pm * BM + (u.half == 2 ? HALF : 0) + wr * 64 + fr, col0 = u.pn * BM + wc * 32 + 8 * fq;
#pragma unroll
        for (int ai = 0; ai < 2; ++ai) if (ai == 0 || u.half == 0)
#pragma unroll
            for (int m = 0; m < 4; ++m) { const size_t off = (size_t)(row0 + ai * HALF + m * 16) * ldc + col0;
#pragma unroll
                for (int bj = 0; bj < 2; ++bj) { const u32x4 bw = __builtin_nontemporal_load((const u32x4*)(base + off + bj * HALF));
                    const f32x4 b0 = {__uint_as_float(bw.x << 16), __uint_as_float(bw.x & 0xffff0000u), __uint_as_float(bw.y << 16), __uint_as_float(bw.y & 0xffff0000u)};
                    const f32x4 b1 = {__uint_as_float(bw.z << 16), __uint_as_float(bw.z & 0xffff0000u), __uint_as_float(bw.w << 16), __uint_as_float(bw.w & 0xffff0000u)};
                    const f32x4 v0 = b0 + acc[ai][bj][m][0], v1 = b1 + acc[ai][bj][m][1];
                    u32x4 w; w.x = cvt_pk_bf16(v0[0], v0[1]); w.y = cvt_pk_bf16(v0[2], v0[3]); w.z = cvt_pk_bf16(v1[0], v1[1]); w.w = cvt_pk_bf16(v1[2], v1[3]);
                    *(u32x4*)(C + off + bj * HALF) = w; } }
    }
};
struct EpResidQ8 {
    static constexpr int PERM = 2; typedef f32x4 acc_t;
    const signed char* xq; const float* sx; bf16_t* C; int ldc;
    __device__ __forceinline__ void prefetch(const Unit&, int, int) const {}
    __device__ __forceinline__ void operator()(const f32x4 (&acc)[2][2][4][2], const Unit& u, int wr, int wc, int fr, int fq, int) const {
        const int row0 = u.pm * BM + (u.half == 2 ? HALF : 0) + wr * 64 + fr, col0 = u.pn * BM + wc * 64 + 16 * fq;
#pragma unroll
        for (int ai = 0; ai < 2; ++ai) if (ai == 0 || u.half == 0)
#pragma unroll
            for (int m = 0; m < 4; ++m) { const int row = row0 + ai * HALF + m * 16; const size_t off = (size_t)row * ldc + col0; const float s = sx[row], c = -128.0f * s;
                u32x4 q = __builtin_nontemporal_load((const u32x4*)(xq + off)); q.x ^= 0x80808080u; q.y ^= 0x80808080u; q.z ^= 0x80808080u; q.w ^= 0x80808080u;
#pragma unroll
                for (int bj = 0; bj < 2; ++bj) { const unsigned qa = bj ? q.z : q.x, qb = bj ? q.w : q.y;
                    const f32x4 b0 = {(float)(qa & 255u) * s + c, (float)((qa >> 8) & 255u) * s + c, (float)((qa >> 16) & 255u) * s + c, (float)(qa >> 24) * s + c};
                    const f32x4 b1 = {(float)(qb & 255u) * s + c, (float)((qb >> 8) & 255u) * s + c, (float)((qb >> 16) & 255u) * s + c, (float)(qb >> 24) * s + c};
                    const f32x4 v0 = b0 + acc[ai][bj][m][0], v1 = b1 + acc[ai][bj][m][1];
                    u32x4 w; w.x = cvt_pk_bf16(v0[0], v0[1]); w.y = cvt_pk_bf16(v0[2], v0[3]); w.z = cvt_pk_bf16(v1[0], v1[1]); w.w = cvt_pk_bf16(v1[2], v1[3]);
                    *(u32x4*)(C + off + bj * 8) = w; } }
    }
};
__device__ __forceinline__ f32x4 i2f(const i32x4 v) { return (f32x4){(float)v.x, (float)v.y, (float)v.z, (float)v.w}; }
__device__ __forceinline__ unsigned q4(const float a, const float b, const float c, const float d) {
    unsigned w = __builtin_amdgcn_cvt_pk_u8_f32(a + 128.0f, 0, 0u); w = __builtin_amdgcn_cvt_pk_u8_f32(b + 128.0f, 1, w); w = __builtin_amdgcn_cvt_pk_u8_f32(c + 128.0f, 2, w); w = __builtin_amdgcn_cvt_pk_u8_f32(d + 128.0f, 3, w);
    return w ^ 0x80808080u; }
typedef float f32x2p __attribute__((ext_vector_type(2)));
__device__ __forceinline__ f32x2p swiglu_q2(f32x2p gate, f32x2p up) {
    f32x2p g, uu; g.x = fminf(gate.x, 7.0f); g.y = fminf(gate.y, 7.0f); uu.x = __builtin_amdgcn_fmed3f(up.x, -7.0f, 7.0f); uu.y = __builtin_amdgcn_fmed3f(up.y, -7.0f, 7.0f);
    const f32x2p a = g * (-1.702f * 1.44269504f); f32x2p e; e.x = __builtin_amdgcn_exp2f(a.x); e.y = __builtin_amdgcn_exp2f(a.y);
    const f32x2p d = e + 1.0f; f32x2p r; r.x = __builtin_amdgcn_rcpf(d.x); r.y = __builtin_amdgcn_rcpf(d.y);
    const f32x2p t = g * r, uq = uu * ACT_Q + ACT_Q;
    return t * uq + 128.0f;
}
__device__ __forceinline__ unsigned pk_u8x4(f32x2p a, f32x2p b) {
    unsigned w = __builtin_amdgcn_cvt_pk_u8_f32(a.x, 0, 0u); w = __builtin_amdgcn_cvt_pk_u8_f32(a.y, 1, w); w = __builtin_amdgcn_cvt_pk_u8_f32(b.x, 2, w); w = __builtin_amdgcn_cvt_pk_u8_f32(b.y, 3, w); return w ^ 0x80808080u; }
struct EpGlu8 {
    static constexpr bool PERM = true; typedef i32x4 acc_t;
    signed char* act; const float* bg; const float* bu; const float* sgu; const LAS float* tsc; int nmine; mutable int ui; LAS unsigned char* epi;
    __device__ __forceinline__ void prefetch(const Unit& u, int slot, int wid) const {
        const int arr = wid >> 1, j = ((wid & 1) << 6) + flane();
        const float* pb = (arr == 0 ? bg : bu) + u.e * FF + u.pn * HALF + j; const float* ps = sgu + (size_t)u.e * 2048 + u.pn * BM + (arr == 3 ? HALF : 0) + j;
        __builtin_amdgcn_global_load_lds((const unsigned*)(arr < 2 ? pb : ps), (LAS unsigned*)(epi + slot * 2048 + wid * 256), 4, 0, 0); }
    __device__ __forceinline__ void operator()(const i32x4 (&acc)[2][2][4][2], const Unit& u, int wr, int wc, int fr, int fq, int slot) const {
        const int c0 = u.pn * HALF + wc * 32 + 8 * fq;
        const LAS f32x4* ev = (const LAS f32x4*)(epi + slot * 2048 + (wc * 32 + 8 * fq) * 4);
        f32x2p bgv[4], buv[4], sgv[4], suv[4];
#pragma unroll
        for (int hq = 0; hq < 2; ++hq) { const f32x4 b = ev[hq], bu4 = ev[32 + hq], sg4 = ev[64 + hq], su4 = ev[96 + hq];
            bgv[2 * hq] = (f32x2p){b.x, b.y}; bgv[2 * hq + 1] = (f32x2p){b.z, b.w}; buv[2 * hq] = (f32x2p){bu4.x, bu4.y}; buv[2 * hq + 1] = (f32x2p){bu4.z, bu4.w};
            sgv[2 * hq] = (f32x2p){sg4.x, sg4.y}; sgv[2 * hq + 1] = (f32x2p){sg4.z, sg4.w}; suv[2 * hq] = (f32x2p){su4.x, su4.y}; suv[2 * hq + 1] = (f32x2p){su4.z, su4.w}; }
        const LAS float* ts = tsc + (ui % nmine) * 256;
        float sav[2][4];
#pragma unroll
        for (int ai = 0; ai < 2; ++ai)
#pragma unroll
            for (int m = 0; m < 4; ++m) sav[ai][m] = ts[ai * HALF + wr * 64 + m * 16 + fr];
        asm volatile("s_waitcnt lgkmcnt(0)" ::: "memory");
#pragma unroll 1
        for (int rep_ = 0; rep_ < 1 + ((DUP_MASK >> 11) & 1); ++rep_)
#pragma unroll
        for (int ai = 0; ai < 2; ++ai)
#pragma unroll
            for (int m = 0; m < 4; ++m) { const int r = ai * HALF + wr * 64 + m * 16 + fr; const float sa = sav[ai][m];
                f32x2p o[4];
#pragma unroll
                for (int q = 0; q < 4; ++q) { const i32x4 ga = acc[ai][0][m][q >> 1], ua = acc[ai][1][m][q >> 1];
                    f32x2p gf, uf; if (q & 1) { gf.x = (float)ga.z; gf.y = (float)ga.w; uf.x = (float)ua.z; uf.y = (float)ua.w; } else { gf.x = (float)ga.x; gf.y = (float)ga.y; uf.x = (float)ua.x; uf.y = (float)ua.y; }
                    o[q] = swiglu_q2(gf * (sgv[q] * sa) + bgv[q], uf * (suv[q] * sa) + buv[q]); }
                const unsigned w0 = pk_u8x4(o[0], o[1]), w1 = pk_u8x4(o[2], o[3]);
                *(u32x2*)(act + (size_t)(u.pm * BM + r) * FF + c0) = (u32x2){w0, w1}; }
        ++ui;
    }
};
struct EpDown8 {
    static constexpr int PERM = 2; typedef i32x4 acc_t;
    unsigned char* ybuf; const float* bd; const float* sd; const LAS int* tok; const LAS float* tsc; int nmine; mutable int ui; LAS unsigned char* epi;
    __device__ __forceinline__ void prefetch(const Unit& u, int slot, int wid) const {
        const int j = ((wid & 3) << 6) + flane();
        __builtin_amdgcn_global_load_lds((const unsigned*)((wid < 4 ? bd : sd) + u.e * D + u.pn * BM + j), (LAS unsigned*)(epi + slot * 2048 + wid * 256), 4, 0, 0); }
    __device__ __forceinline__ void operator()(const i32x4 (&acc)[2][2][4][2], const Unit& u, int wr, int wc, int fr, int fq, int slot) const {
        const int c0 = u.pn * BM + wc * 64 + 16 * fq;
        const LAS f32x4* ev = (const LAS f32x4*)(epi + slot * 2048 + (wc * 64 + 16 * fq) * 4);
        f32x4 bv[2][2], sv[2][2];
#pragma unroll
        for (int bj = 0; bj < 2; ++bj)
#pragma unroll
            for (int n = 0; n < 2; ++n) { bv[bj][n] = ev[bj * 2 + n]; sv[bj][n] = ev[64 + bj * 2 + n] * ACT_SCALE; }
        int av[2][4]; float gwv[2][4];
#pragma unroll
        for (int ai = 0; ai < 2; ++ai)
#pragma unroll
            for (int m = 0; m < 4; ++m) { const int r = (u.half == 2 ? HALF : 0) + ai * HALF + wr * 64 + m * 16 + fr; const int rc = r < 256 ? r : 255;
                av[ai][m] = tok[(ui % nmine) * 256 + rc]; gwv[ai][m] = tsc[(ui % nmine) * 256 + rc] * Y_Q; }
        asm volatile("s_waitcnt lgkmcnt(0)" ::: "memory");
#pragma unroll 1
        for (int rep_ = 0; rep_ < 1 + ((DUP_MASK >> 23) & 1); ++rep_)
#pragma unroll
        for (int ai = 0; ai < 2; ++ai) if (ai == 0 || u.half == 0)
#pragma unroll
            for (int m = 0; m < 4; ++m) { const int r = (u.half == 2 ? HALF : 0) + ai * HALF + wr * 64 + m * 16 + fr;
                if (r < u.nv) { const int a = av[ai][m]; const float gw = gwv[ai][m]; unsigned char* rowp = ybuf + (size_t)a * D + c0;
                    u32x4 w;
#pragma unroll
                    for (int bj = 0; bj < 2; ++bj) { const f32x4 v0 = (i2f(acc[ai][bj][m][0]) * sv[bj][0] + bv[bj][0]) * gw + 128.0f, v1 = (i2f(acc[ai][bj][m][1]) * sv[bj][1] + bv[bj][1]) * gw + 128.0f;
                        const unsigned w0 = pk_u8x4((f32x2p){v0[0], v0[1]}, (f32x2p){v0[2], v0[3]}) ^ 0x80808080u, w1 = pk_u8x4((f32x2p){v1[0], v1[1]}, (f32x2p){v1[2], v1[3]}) ^ 0x80808080u;
                        if (bj == 0) { w.x = w0; w.y = w1; } else { w.z = w0; w.w = w1; } }
                    *(u32x4*)rowp = w; } }
        ++ui;
    }
};

template <class Epi, class Sched, bool I8 = false, bool ALIGN_EPI = true>
__device__ __forceinline__ void gemm_phase(LAS unsigned char* lds, const Sched& S, const Epi& E, const int wid  ) {
    static_assert(Sched::ESZ_ == (I8 ? 1 : 2), "element size");
    typedef typename Epi::acc_t acc_t;
    const int lane = flane(), tid = wid * 64 + lane, wr = wid >> 2, wc = wid & 3, fr = lane & 15, fq = lane >> 4;
    const int K = S.K, PITCH = K * (I8 ? 1 : 2), nt = PITCH / (BK * 2);
    unsigned voffB[2], vA[2][2]; int Rr[2], Cc[2];
#pragma unroll
    for (int i = 0; i < 2; ++i) { int R, C; stage_rc(tid * 16 + i * 8192, R, C); const int Rb = (int)Epi::PERM == 2 ? (64 * (R >> 5) + 16 * ((R & 15) >> 2) + 4 * ((R >> 4) & 1) + (R & 3)) : (Epi::PERM ? ((R & ~31) + perm32(R & 31)) : R);
        voffB[i] = (unsigned)(Rb * PITCH + C * 2); Rr[i] = R; Cc[i] = C; }
    const size_t kstep = (size_t)(BK * 2);
    const size_t hstep = (size_t)((int)Epi::PERM == 2 ? 8 : HALF) * PITCH;
    const unsigned ldsw = (unsigned)wid * 1024u;
    const int aoff = lds_byte(wr * 64 + fr, fq * 8), boff = lds_byte(wc * 32 + fr, fq * 8);
#define PG8_SA(b, h) (((b) * 2 + (h)) * HTB)
#define PG8_SB(b, h) ((4 + (b) * 2 + (h)) * HTB)
#define PG8_STAGE(bufoff, gbase, voff) do { _Pragma("unroll") for (int _i = 0; _i < 2; ++_i) \
        __builtin_amdgcn_global_load_lds((const unsigned*)((const char*)(gbase) + (voff)[_i]), (LAS unsigned*)(lds + (bufoff) + ldsw + _i * 8192), 16, 0, 0); } while (0)
#define PG8_LDA(dst, b, h) do { _Pragma("unroll") for (int m = 0; m < 4; ++m) _Pragma("unroll") for (int k = 0; k < 2; ++k) dst[m][k] = *(const LAS bf16x8*)(lds + PG8_SA(b, h) + aoff + m * 2048 + k * 1024); } while (0)
#define PG8_LDB(dst, b, h) do { _Pragma("unroll") for (int n = 0; n < 2; ++n) _Pragma("unroll") for (int k = 0; k < 2; ++k) dst[n][k] = *(const LAS bf16x8*)(lds + PG8_SB(b, h) + boff + n * 2048 + k * 1024); } while (0)
#define PG8_MMA(ai, bj, At, Bt) do { __builtin_amdgcn_s_setprio(1); _Pragma("unroll") for (int m = 0; m < 4; ++m) _Pragma("unroll") for (int n = 0; n < 2; ++n) _Pragma("unroll") for (int k = 0; k < 2; ++k) \
        { if constexpr (I8) acc[ai][bj][m][n] = __builtin_amdgcn_mfma_i32_16x16x64_i8(__builtin_bit_cast(i32x4, Bt[n][k]), __builtin_bit_cast(i32x4, At[m][k]), acc[ai][bj][m][n], 0, 0, 0); \
          else acc[ai][bj][m][n] = __builtin_amdgcn_mfma_f32_16x16x32_bf16(Bt[n][k], At[m][k], acc[ai][bj][m][n], 0, 0, 0); } __builtin_amdgcn_s_setprio(0); } while (0)
#define PG8_WAIT_V(n) asm volatile("s_waitcnt vmcnt(" #n ")" ::: "memory")
#define PG8_WAIT_L(n) asm volatile("s_waitcnt lgkmcnt(" #n ")" ::: "memory")
#define PG8_BAR __builtin_amdgcn_s_barrier()
#define PG8_SCHED __builtin_amdgcn_sched_barrier(0)
    Unit cur, nxt; int ui = 0;
    if (!S.next(0, cur)) return;
    S.a_voff(0, Rr, Cc, vA);
    acc_t acc[2][2][4][2];
#pragma unroll
    for (int a = 0; a < 2; ++a)
#pragma unroll
        for (int b = 0; b < 2; ++b)
#pragma unroll
            for (int m = 0; m < 4; ++m)
#pragma unroll
                for (int n = 0; n < 2; ++n) acc[a][b][m][n] = (acc_t){0, 0, 0, 0};
    bf16x8 At[4][2], B0[2][2], B1[2][2];
    const char* cA = S.a_ptr(cur); const char* cB = S.b_ptr(cur);
    PG8_STAGE(PG8_SB(0, 0), cB, voffB); PG8_STAGE(PG8_SB(0, 1), cB + hstep, voffB); PG8_STAGE(PG8_SA(0, 0), cA, vA[0]); PG8_STAGE(PG8_SA(0, 1), cA, vA[1]);
    if (wr == 1) PG8_BAR;
    PG8_WAIT_V(2); PG8_BAR;
    PG8_STAGE(PG8_SB(1, 0), cB + kstep, voffB); PG8_STAGE(PG8_SA(1, 0), cA + kstep, vA[0]); PG8_STAGE(PG8_SB(1, 1), cB + hstep + kstep, voffB);
    PG8_WAIT_V(6); PG8_BAR;
    for (;;) {
        const bool has_next = S.next(ui + 1, nxt);
        E.prefetch(cur, ui & 1, wid);
        const bool hu = __builtin_amdgcn_readfirstlane(cur.half) != 0;
        const char* nA = has_next ? S.a_ptr(nxt) : cA; const char* nB = has_next ? S.b_ptr(nxt) : cB;
        constexpr int KP = (I8 && ((DUP_MASK >> 22) & 1)) ? 2 : 1;
#pragma unroll 1
        for (int kp = 0; kp < KP; ++kp)
#pragma unroll 1
        for (int t = 0; t < nt; t += 2) {
            const bool lastk = (t == nt - 2), last = lastk && (kp == KP - 1);
            const char* a1 = cA + (size_t)(t + 1) * kstep;
            const char* a2 = lastk ? (last ? nA : cA) : cA + (size_t)(t + 2) * kstep; const char* b2 = lastk ? (last ? nB : cB) : cB + (size_t)(t + 2) * kstep;
#define PG8_ZB() do { if (KP == 2 && kp == 0) { _Pragma("unroll") for (int n = 0; n < 2; ++n) _Pragma("unroll") for (int k = 0; k < 2; ++k) { B0[n][k] = (bf16x8){0,0,0,0,0,0,0,0}; B1[n][k] = (bf16x8){0,0,0,0,0,0,0,0}; } } } while (0)
            const char* a3 = a2 + kstep; const char* b3 = b2 + kstep;
            PG8_LDB(B0, 0, 0); PG8_LDB(B1, 0, 1); PG8_SCHED; PG8_LDA(At, 0, 0); PG8_STAGE(PG8_SA(1, 1), a1, vA[1]);
            if (Sched::GATHER) { if (last && has_next) S.a_voff(ui + 1, Rr, Cc, vA); }
            PG8_WAIT_V(8); PG8_WAIT_L(0); PG8_ZB(); PG8_BAR; PG8_MMA(0, 0, At, B0); PG8_MMA(0, 1, At, B1); PG8_BAR; PG8_SCHED;
            if (!hu) PG8_LDA(At, 0, 1); PG8_STAGE(PG8_SB(0, 0), b2, voffB); PG8_STAGE(PG8_SB(0, 1), b2 + hstep, voffB); PG8_STAGE(PG8_SA(0, 0), a2, vA[0]);
            PG8_WAIT_V(8); PG8_WAIT_L(0); PG8_BAR; if (!hu) { PG8_MMA(1, 0, At, B0); PG8_MMA(1, 1, At, B1); } PG8_BAR; PG8_SCHED;
            PG8_LDB(B0, 1, 0); PG8_LDB(B1, 1, 1); PG8_SCHED; PG8_LDA(At, 1, 0); PG8_STAGE(PG8_SA(0, 1), a2, vA[1]);
            PG8_WAIT_V(8); PG8_WAIT_L(0); PG8_ZB(); PG8_BAR; PG8_MMA(0, 0, At, B0); PG8_MMA(0, 1, At, B1); PG8_BAR; PG8_SCHED;
            if (!hu) PG8_LDA(At, 1, 1); PG8_STAGE(PG8_SB(1, 0), b3, voffB); PG8_STAGE(PG8_SB(1, 1), b3 + hstep, voffB); PG8_STAGE(PG8_SA(1, 0), a3, vA[0]);
            PG8_WAIT_V(8); PG8_WAIT_L(0); PG8_BAR; if (!hu) { PG8_MMA(1, 0, At, B0); PG8_MMA(1, 1, At, B1); } PG8_BAR; PG8_SCHED;
        }
        if constexpr (ALIGN_EPI) { if (wr == 0) PG8_BAR; }
        E(acc, cur, wr, wc, fr, fq, ui & 1);
        if (!has_next) break;
#pragma unroll
        for (int a = 0; a < 2; ++a)
#pragma unroll
            for (int b = 0; b < 2; ++b)
#pragma unroll
                for (int m = 0; m < 4; ++m)
#pragma unroll
                    for (int n = 0; n < 2; ++n) acc[a][b][m][n] = (acc_t){0, 0, 0, 0};
        cur = nxt; cA = nA; cB = nB; ++ui;
        if constexpr (ALIGN_EPI) { if (wr == 1) PG8_BAR; }
    }
    PG8_WAIT_V(0);
    if constexpr (!ALIGN_EPI) { if (wr == 0) PG8_BAR; }
    PG8_BAR;
#undef PG8_SA
#undef PG8_ZB
#undef PG8_SB
#undef PG8_STAGE
#undef PG8_LDA
#undef PG8_LDB
#undef PG8_MMA
#undef PG8_WAIT_V
#undef PG8_WAIT_L
#undef PG8_BAR
#undef PG8_SCHED
}
}

constexpr int NWAVES = 8, NTHR = 512;
struct Frame {
    LAS unsigned char* lds;
    int wave, vcu, G;
    const float* in[20]; float* out; unsigned char* ws;
};
struct Args { const float* in[20]; float* out; unsigned char* ws; int ph_lo, ph_hi; };
enum { I_X = 0, I_N1G, I_WIN, I_IGB, I_FGB, I_CONVW, I_HNG, I_POOLW, I_POOLS, I_WOUT, I_N2G, I_WR, I_BR, I_WG, I_BG, I_WU, I_BU, I_WD, I_BD, I_NFG };

#define LDS_WAIT() asm volatile("s_waitcnt lgkmcnt(0)" ::: "memory")

constexpr int QITEMS = NE * 3 * 32;
constexpr int QEXTRA = ((DUP_MASK >> 13) & 1) * 1024;
constexpr int QSTATIC = 0; static_assert(QSTATIC == 0, "the two-queue pull assumes no static share");
__device__ __forceinline__ void quant_item(const Frame& F, const int it, const int par) {
    const int lane = flane();
    signed char* wgu_q = (signed char*)(F.ws + WS_WGU); signed char* wd_q = (signed char*)(F.ws + WS_WD); float* sgu = (float*)(F.ws + WS_SGU); float* sd = (float*)(F.ws + WS_SD);
    LAS float* scr = (LAS float*)(F.lds + F.wave * 12800);
    LAS unsigned* tile = (LAS unsigned*)(F.lds + F.wave * 12800 + 8704);
    LAS float* cmax = (LAS float*)(F.lds + 8 * 12800);
    const int rsub = lane >> 3, cg = lane & 7, nn = lane & 31, kh = lane >> 5, k0 = 128 * F.wave;
    const float* const p_wg = F.in[I_WG]; const float* const p_wu = F.in[I_WU]; const float* const p_wd = F.in[I_WD];
    const int e = it / 96, r2 = it % 96, which = r2 >> 5, nb = r2 & 31;
    const float* mat = (which == 0 ? p_wg : (which == 1 ? p_wu : p_wd)) + (size_t)e * D * FF;
    const __amdgpu_buffer_rsrc_t rsrc = __builtin_amdgcn_make_buffer_rsrc((void*)mat, 0, D * FF * 4, 0x00020000);
    const int voff = ((k0 + rsub) * 1024 + 32 * nb + 4 * cg) * 4;
    f32x4 v[16];
#pragma unroll
    for (int i = 0; i < 16; ++i) v[i] = __builtin_bit_cast(f32x4, __builtin_amdgcn_raw_buffer_load_b128(rsrc, voff, i * 32768, 2  ));
    f32x4 m4 = {0.f, 0.f, 0.f, 0.f};
#pragma unroll
    for (int i = 0; i < 16; ++i) { m4.x = fmaxf(m4.x, fabsf(v[i].x)); m4.y = fmaxf(m4.y, fabsf(v[i].y)); m4.z = fmaxf(m4.z, fabsf(v[i].z)); m4.w = fmaxf(m4.w, fabsf(v[i].w)); }
#pragma unroll
    for (int o = 8; o < 64; o <<= 1) { m4.x = fmaxf(m4.x, __shfl_xor(m4.x, o)); m4.y = fmaxf(m4.y, __shfl_xor(m4.y, o)); m4.z = fmaxf(m4.z, __shfl_xor(m4.z, o)); m4.w = fmaxf(m4.w, __shfl_xor(m4.w, o)); }
    if (rsub == 0) *(LAS f32x4*)(cmax + (par * 8 + F.wave) * 32 + 4 * cg) = m4;
    __syncthreads();
    float M = 0.f;
#pragma unroll
    for (int w = 0; w < 8; ++w) M = fmaxf(M, cmax[(par * 8 + w) * 32 + nn]);
    const float inv = M > 0.f ? 127.0f / M : 0.f;
    { const int col = 32 * nb + nn, rowi = (which == 2) ? col : 256 * (col >> 7) + 128 * which + (col & 127);
      if (F.wave == 0 && kh == 0) { if (which == 2) sd[e * D + rowi] = M > 0.f ? M * (1.0f / 127.0f) : 1.0f; else sgu[e * 2048 + rowi] = M > 0.f ? M * (1.0f / 127.0f) : 1.0f; } }
#pragma unroll
    for (int half = 0; half < 2; ++half) {
#pragma unroll
        for (int i = 0; i < 8; ++i) { LAS float* d = scr + (8 * i + rsub) * 33 + 4 * cg; const f32x4 x = v[8 * half + i]; d[0] = x.x; d[1] = x.y; d[2] = x.z; d[3] = x.w; }
        LDS_WAIT(); asm volatile("" ::: "memory");
#pragma unroll
        for (int j = 0; j < 8; ++j) { const LAS float* sp = scr + (32 * kh + 4 * j) * 33 + nn;
            const unsigned w = pg8::q4(sp[0] * inv, sp[33] * inv, sp[66] * inv, sp[99] * inv);
            const int word = 16 * half + 8 * kh + j; tile[nn * 32 + (word ^ nn)] = w; }
        LDS_WAIT(); asm volatile("" ::: "memory");
    }
    signed char* dst = (which == 2) ? wd_q + (size_t)e * D * 1024 : wgu_q + (size_t)e * 2048 * 1024;
#pragma unroll
    for (int pss = 0; pss < 4; ++pss) { const int n = pss * 8 + (lane >> 3), j4 = lane & 7; u32x4 w;
        w.x = tile[n * 32 + ((4 * j4 + 0) ^ n)]; w.y = tile[n * 32 + ((4 * j4 + 1) ^ n)]; w.z = tile[n * 32 + ((4 * j4 + 2) ^ n)]; w.w = tile[n * 32 + ((4 * j4 + 3) ^ n)];
        const int coln = 32 * nb + n, rown = (which == 2) ? coln : 256 * (coln >> 7) + 128 * which + (coln & 127);
        *(u32x4*)(dst + (size_t)rown * 1024 + k0 + 16 * j4) = w; }
    LDS_WAIT(); asm volatile("" ::: "memory");
}
__device__ __forceinline__ void quant_win_item(const Frame& F, const int nb, const int par) {
    const int lane = flane();
    signed char* dstq = (signed char*)(F.ws + WS_WIN); float* sw = (float*)(F.ws + WS_SWIN);
    LAS float* scr = (LAS float*)(F.lds + F.wave * 12800);
    LAS unsigned* tile = (LAS unsigned*)(F.lds + F.wave * 12800 + 8704);
    LAS float* cmax = (LAS float*)(F.lds + 8 * 12800);
    const int rsub = lane >> 3, cg = lane & 7, nn = lane & 31, kh = lane >> 5, k0 = 128 * F.wave;
    const float* const mat = F.in[I_WIN]; const float* const g1 = F.in[I_N1G];
    const int n0 = 32 * nb, col0 = n0 < 2048 ? n0 : n0 + 8;
    const __amdgpu_buffer_rsrc_t rsrc = __builtin_amdgcn_make_buffer_rsrc((void*)mat, 0, D * NIN * 4, 0x00020000);
    const int voff = ((k0 + rsub) * NIN + col0 + 4 * cg) * 4;
    f32x4 v[16];
#pragma unroll
    for (int i = 0; i < 16; ++i) v[i] = __builtin_bit_cast(f32x4, __builtin_amdgcn_raw_buffer_load_b128(rsrc, voff, i * (8 * NIN * 4), 2  ));
    float gk[16];
#pragma unroll
    for (int i = 0; i < 16; ++i) gk[i] = g1[k0 + 8 * i + rsub];
    f32x4 m4 = {0.f, 0.f, 0.f, 0.f};
#pragma unroll
    for (int i = 0; i < 16; ++i) { v[i] = v[i] * gk[i]; m4.x = fmaxf(m4.x, fabsf(v[i].x)); m4.y = fmaxf(m4.y, fabsf(v[i].y)); m4.z = fmaxf(m4.z, fabsf(v[i].z)); m4.w = fmaxf(m4.w, fabsf(v[i].w)); }
#pragma unroll
    for (int o = 8; o < 64; o <<= 1) { m4.x = fmaxf(m4.x, __shfl_xor(m4.x, o)); m4.y = fmaxf(m4.y, __shfl_xor(m4.y, o)); m4.z = fmaxf(m4.z, __shfl_xor(m4.z, o)); m4.w = fmaxf(m4.w, __shfl_xor(m4.w, o)); }
    if (rsub == 0) *(LAS f32x4*)(cmax + (par * 8 + F.wave) * 32 + 4 * cg) = m4;
    __syncthreads();
    float M = 0.f;
#pragma unroll
    for (int w = 0; w < 8; ++w) M = fmaxf(M, cmax[(par * 8 + w) * 32 + nn]);
    const float inv = M > 0.f ? 127.0f / M : 0.f;
    if (F.wave == 0 && kh == 0) sw[n0 + nn] = M > 0.f ? M * (1.0f / 127.0f) : 1.0f;
#pragma unroll
    for (int half = 0; half < 2; ++half) {
#pragma unroll
        for (int i = 0; i < 8; ++i) { LAS float* d = scr + (8 * i + rsub) * 33 + 4 * cg; const f32x4 x = v[8 * half + i]; d[0] = x.x; d[1] = x.y; d[2] = x.z; d[3] = x.w; }
        LDS_WAIT(); asm volatile("" ::: "memory");
#pragma unroll
        for (int j = 0; j < 8; ++j) { const LAS float* sp = scr + (32 * kh + 4 * j) * 33 + nn;
            const unsigned w = pg8::q4(sp[0] * inv, sp[33] * inv, sp[66] * inv, sp[99] * inv);
            const int word = 16 * half + 8 * kh + j; tile[nn * 32 + (word ^ nn)] = w; }
        LDS_WAIT(); asm volatile("" ::: "memory");
    }
#pragma unroll
    for (int pss = 0; pss < 4; ++pss) { const int n = pss * 8 + (lane >> 3), j4 = lane & 7; u32x4 w;
        w.x = tile[n * 32 + ((4 * j4 + 0) ^ n)]; w.y = tile[n * 32 + ((4 * j4 + 1) ^ n)]; w.z = tile[n * 32 + ((4 * j4 + 2) ^ n)]; w.w = tile[n * 32 + ((4 * j4 + 3) ^ n)];
        *(u32x4*)(dstq + (size_t)(n0 + n) * 1024 + k0 + 16 * j4) = w; }
    LDS_WAIT(); asm volatile("" ::: "memory");
}
__device__ __forceinline__ bool quant_pull(const Frame& F, const int par, const int nq) {
    LAS unsigned* qw = (LAS unsigned*)(F.lds + LDS_BARW) + 2;
    if (F.wave == 0 && flane() == 0) { unsigned* qh = (unsigned*)(F.ws + WS_CTL) + CW_QHEAD;
        unsigned q = (unsigned)atomicAdd(qh, 1u), it = 0xffffffffu;
        if (q < (unsigned)(NE * 64 + QEXTRA)) { q %= (unsigned)(NE * 64); it = (q >> 6) * 96u + (q & 63u); }
        else if (nq > 1) { q = (unsigned)atomicAdd(qh + 64, 1u); if (q < (unsigned)(NE * 32)) it = (q >> 5) * 96u + 64u + (q & 31u); }
        qw[par] = it; }
    __syncthreads();
    const unsigned it = qw[par];
    if (it == 0xffffffffu) return false;
    quant_item(F, (int)it, par);
    return true;
}
__device__ __forceinline__ void xcd_barrier_fill(const XcdBarrier& b, const Frame& F) {
    asm volatile("s_waitcnt vmcnt(0)" ::: "memory");
    __syncthreads();
    LAS unsigned* st = (LAS unsigned*)(F.lds + LDS_BARW);
    const bool t0 = (F.wave == 0 && flane() == 0);
    if (t0) {
        unsigned* bar = b.bar;
        __builtin_amdgcn_s_waitcnt(0);
        unsigned nloc = b.st[0], nx = b.st[1];
        if (nloc == 0u) { xcd_barrier_complete(bar, b.x, nloc, nx); b.st[0] = nloc; b.st[1] = nx; }
        const unsigned old = xb_add(&bar[XB_XSUB(b.x)], 1u);
        const unsigned gen = old / nloc;
        if (old + 1u == (gen + 1u) * nloc) {
            __builtin_amdgcn_fence(__ATOMIC_RELEASE, "agent");
            asm volatile("s_waitcnt vmcnt(0)" ::: "memory");
            const unsigned og = xb_add(&bar[XB_TOP], 1u);
            const unsigned tg = og / nx;
            if (og + 1u == (tg + 1u) * nx) xb_add(&bar[XB_TOPGEN], 1u);
            else XB_SPIN(xb_ld(&bar[XB_TOPGEN]) == tg, bar);
            __builtin_amdgcn_fence(__ATOMIC_ACQUIRE, "agent");
            xb_add(&bar[XB_XGEN(b.x)], 1u);
            asm volatile("s_waitcnt vmcnt(0)" ::: "memory");
            st[2] = 0xffffffffu;
        } else { st[2] = 0u; st[3] = gen; }
    }
    __syncthreads();
    if (st[2] != 0xffffffffu) {
        const unsigned gen = st[3];
        LAS unsigned* rw = (LAS unsigned*)(F.lds + LDS_BARW + 32);
        __syncthreads();
        int par = 0;
        for (;;) {
            if (t0) rw[par] = (xb_ld(&b.bar[XB_XGEN(b.x)]) != gen) ? 1u : 0u;
            __syncthreads();
            if (rw[par]) break;
            if (!quant_pull(F, par, 2)) { if (t0) XB_SPIN(xb_ld(&b.bar[XB_XGEN(b.x)]) == gen, b.bar); break; }
            par ^= 1;
        }
        if (t0) { asm volatile("buffer_inv sc0" ::: "memory"); asm volatile("s_waitcnt vmcnt(0)" ::: "memory"); }
    }
    __syncthreads();
}

__device__ __forceinline__ void p0_item_load(const float* __restrict__ W, int ldw, int col0, int k0, int lane, float (&wv)[32]) {
#pragma unroll
    for (int i = 0; i < 32; ++i) wv[i] = __builtin_nontemporal_load(W + (size_t)(k0 + 2 * i + (lane >> 5)) * ldw + col0 + (lane & 31));
}
__device__ __forceinline__ void p0_item_finish(const float (&wv)[32], const float* __restrict__ gk, bf16_t* wt, int k0, LAS float* scr, int lane) {
    const int c = lane & 7;
    f32x4 g0 = {1.f, 1.f, 1.f, 1.f}, g1 = {1.f, 1.f, 1.f, 1.f};
    if (gk) { g0 = *(const f32x4*)(gk + k0 + 8 * c); g1 = *(const f32x4*)(gk + k0 + 8 * c + 4); }
#pragma unroll
    for (int i = 0; i < 32; ++i) scr[(2 * i + (lane >> 5)) * 33 + (lane & 31)] = wv[i];
    LDS_WAIT(); asm volatile("" ::: "memory");
#pragma unroll
    for (int j = 0; j < 4; ++j) { const int n = (lane >> 3) + 8 * j; const LAS float* sp = scr + (8 * c) * 33 + n;
        u32x4 o; o.x = cvt_pk_bf16(sp[0 * 33] * g0.x, sp[1 * 33] * g0.y); o.y = cvt_pk_bf16(sp[2 * 33] * g0.z, sp[3 * 33] * g0.w); o.z = cvt_pk_bf16(sp[4 * 33] * g1.x, sp[5 * 33] * g1.y); o.w = cvt_pk_bf16(sp[6 * 33] * g1.z, sp[7 * 33] * g1.w);
        *(u32x4*)(wt + (size_t)n * 1024 + k0 + 8 * c) = o; }
    LDS_WAIT(); asm volatile("" ::: "memory");
}
#define P0_ITEM_OF(it_, W_, gk_, wt_, ldw_, col0_, k0_) \
    const bool in_ = (it_) < 16 * (NP / 32); const int q_ = in_ ? (it_) : (it_) - 16 * (NP / 32), nbk_ = in_ ? (NP / 32) : 32, kb_ = q_ / nbk_, nb_ = q_ % nbk_, n0_ = 32 * nb_; \
    const float* W_ = in_ ? p_win : p_wout; const float* gk_ = in_ ? p_g : nullptr; bf16_t* wt_ = (in_ ? win_t : wout_t) + (size_t)n0_ * 1024; \
    const int ldw_ = in_ ? NIN : D, col0_ = (in_ && n0_ >= 2048) ? n0_ + 8 : n0_, k0_ = 64 * kb_
__device__ __forceinline__ void phase0(Frame& F) {
    const int lane = flane(), tid = F.wave * 64 + lane;
    const int gw = F.vcu * NWAVES + F.wave, NGW = F.G * NWAVES;
    constexpr int I_IN_ = 16 * (NP / 32), NITEMS = 16 * 32;
    for (int nb = blockIdx.x; nb < NP / 32; nb += F.G) quant_win_item(F, nb, 0);
    __syncthreads();
    const int pi = blockIdx.x * NTHR + tid; float pwv = 0.f; const float* pw = F.in[I_POOLW];
    if (pi < 4 * 128 * 128) { const int g = pi >> 14, d = (pi >> 7) & 127, cc = pi & 127; pwv = pw[(g * 128 + cc) * 128 + d]; }
    const float* const p_win = F.in[I_WIN]; const float* const p_wout = F.in[I_WOUT]; const float* const p_g = F.in[I_N1G];
    bf16_t* const win_t = (bf16_t*)(F.ws + WS_WIN); bf16_t* const wout_t = (bf16_t*)(F.ws + WS_WOUT);
    const int gwi = gw - (NP / 32) * NWAVES;
    float wv[32]; const bool have_item = gwi >= 0 && gwi < NITEMS; const int it_first = (have_item ? gwi : 0) + I_IN_;
    P0_ITEM_OF(it_first, iW, igk, iwt, ildw, icol0, ik0);
    if (have_item) p0_item_load(iW, ildw, icol0, ik0, lane, wv);
    {
        LAS float* wgl = (LAS float*)(F.lds + 98304);
        const float* w_in = F.in[I_WIN]; const float* g1 = F.in[I_N1G];
        const float* x = F.in[I_X];
        f32x4 nx[4];
        if (gw < T) { const f32x4* xr = (const f32x4*)(x + (size_t)gw * D) + lane;
#pragma unroll
            for (int j = 0; j < 4; ++j) nx[j] = __builtin_nontemporal_load(xr + 64 * j); }
        { float gwv[2][8], gg[2];
#pragma unroll
          for (int t = 0; t < 2; ++t) { const int sidx = tid + t * NTHR, j = sidx >> 8, q = (sidx >> 6) & 3, l = sidx & 63, k = 256 * j + 4 * l + q; gg[t] = g1[k];
#pragma unroll
              for (int i = 0; i < 8; ++i) gwv[t][i] = w_in[(size_t)k * NIN + 2048 + i]; }
#pragma unroll
          for (int t = 0; t < 2; ++t)
#pragma unroll
              for (int i = 0; i < 8; ++i) wgl[(tid + t * NTHR) * 8 + i] = gwv[t][i] * gg[t]; }
        __syncthreads();
        bf16_t* xb = (bf16_t*)(F.ws + WS_XB); float* rs1 = (float*)(F.ws + WS_RS1); float* gates = (float*)(F.ws + WS_GATES); signed char* xq = (signed char*)(F.ws + WS_XQ);
        for (int row = gw; row < T; row += NGW) {
            f32x4 v[4]; float ss = 0.f; float ga[8];
#pragma unroll
            for (int j = 0; j < 4; ++j) v[j] = nx[j];
            if (row + NGW < T) { const f32x4* xr = (const f32x4*)(x + (size_t)(row + NGW) * D) + lane;
#pragma unroll
                for (int j = 0; j < 4; ++j) nx[j] = __builtin_nontemporal_load(xr + 64 * j); }
#pragma unroll
            for (int i = 0; i < 8; ++i) ga[i] = 0.f;
#pragma unroll
            for (int j = 0; j < 4; ++j) ss += (v[j].x * v[j].x + v[j].y * v[j].y) + (v[j].z * v[j].z + v[j].w * v[j].w);
#pragma unroll
            for (int j = 0; j < 4; ++j)
#pragma unroll
                for (int q = 0; q < 4; ++q) { const LAS f32x4* wp = (const LAS f32x4*)(wgl + (256 * j + 64 * q + lane) * 8); const f32x4 w0 = wp[0], w1 = wp[1]; const float xv = v[j][q];
                    ga[0] += xv * w0.x; ga[1] += xv * w0.y; ga[2] += xv * w0.z; ga[3] += xv * w0.w; ga[4] += xv * w1.x; ga[5] += xv * w1.y; ga[6] += xv * w1.z; ga[7] += xv * w1.w; }
            const float rs = rsqrtf(wave_sum(ss) * (1.f / D) + EPS);
            float mine = 0.f;
#pragma unroll
            for (int i = 0; i < 8; ++i) { const float sm = wave_sum(ga[i]); mine = (lane == i) ? sm : mine; }
            if (lane < 8) gates[(size_t)row * 8 + lane] = mine * rs;
            float am = 0.f;
#pragma unroll
            for (int j = 0; j < 4; ++j) am = fmaxf(fmaxf(am, fmaxf(fabsf(v[j].x), fabsf(v[j].y))), fmaxf(fabsf(v[j].z), fabsf(v[j].w)));
            am = wave_max(am); const float qi = am > 0.f ? 127.0f / am : 0.f;
            { unsigned* q8 = (unsigned*)(xq + (size_t)row * D) + lane;
#pragma unroll
              for (int j = 0; j < 4; ++j) q8[64 * j] = pg8::q4(v[j].x * qi, v[j].y * qi, v[j].z * qi, v[j].w * qi); }
            if (lane == 0) { const float sxr = am > 0.f ? am * (1.0f / 127.0f) : 1.0f; rs1[row] = rs * sxr; ((float*)(F.ws + WS_SX))[row] = sxr; }
            asm volatile("" ::: "memory");
        }
    }
    {
        LAS float* scr = (LAS float*)(F.lds + F.wave * 8704);
        if (have_item) p0_item_finish(wv, igk, iwt, ik0, scr, lane);
        for (int it = (gwi >= 0 ? gwi : gwi + NGW) + (have_item ? NGW : 0); it < NITEMS; it += NGW) { P0_ITEM_OF(it + I_IN_, tW, tgk, twt, tldw, tcol0, tk0); p0_item_load(tW, tldw, tcol0, tk0, lane, wv); p0_item_finish(wv, tgk, twt, tk0, scr, lane); }
    }
    if (pi < 4 * 128 * 128) { bf16_t* pwt = (bf16_t*)(F.ws + WS_POOLWT); pwt[pi] = (bf16_t)(cvt_pk_bf16(pwv, 0.f) & 0xffffu); }
    for (int i = pi + F.G * NTHR; i < 4 * 128 * 128; i += F.G * NTHR) { const int g = i >> 14, d = (i >> 7) & 127, cc = i & 127; ((bf16_t*)(F.ws + WS_POOLWT))[i] = (bf16_t)(cvt_pk_bf16(pw[(g * 128 + cc) * 128 + d], 0.f) & 0xffffu); }
    __syncthreads();
#pragma unroll 1
    for (int j = 0; j < QSTATIC * (1 + (DUP_MASK & 1)); ++j) quant_item(F, F.vcu + (j % (QSTATIC > 0 ? QSTATIC : 1)) * F.G, j & 1);
}

__device__ __forceinline__ void xcd_barrier_x1(const XcdBarrier& b, const Frame& F) {
    asm volatile("s_waitcnt vmcnt(0)" ::: "memory");
    __syncthreads();
    if (F.wave == 0) xcd_barrier_thread0(b);
    else { const char* x1 = (const char*)(F.ws + WS_X1); const int lane = flane();
#pragma unroll 1
        for (int hr = F.wave - 1; hr < 128; hr += 7) { const int slot = hr >> 1, hf = hr & 1, w = slot & 7, k = slot >> 3;
            __builtin_amdgcn_global_load_lds((const unsigned*)(x1 + (size_t)(F.vcu * 8 + w + 2048 * k) * (D * 2) + hf * 1024 + lane * 16), (LAS unsigned*)(F.lds + hr * 1024), 16, 0, 0); }
        asm volatile("s_waitcnt vmcnt(0)" ::: "memory"); }
    __syncthreads();
}
typedef short s16x4 __attribute__((ext_vector_type(4)));
typedef float f32x16 __attribute__((ext_vector_type(16)));
typedef float f32x8 __attribute__((ext_vector_type(8)));
typedef float f32x2 __attribute__((ext_vector_type(2)));
typedef __bf16 bfv8 __attribute__((ext_vector_type(8)));
typedef __bf16 bfv2 __attribute__((ext_vector_type(2)));
#define MFMA32(a, b, c) __builtin_amdgcn_mfma_f32_32x32x16_bf16((a), (b), (c), 0, 0, 0)
__device__ __forceinline__ bf16x8 pack8(float a0, float a1, float a2, float a3, float a4, float a5, float a6, float a7) {
    const f32x8 f = {a0, a1, a2, a3, a4, a5, a6, a7}; return __builtin_bit_cast(bf16x8, __builtin_convertvector(f, bfv8)); }
__device__ __forceinline__ unsigned pack2(float a, float b) { const f32x2 f = {a, b}; return __builtin_bit_cast(unsigned, __builtin_convertvector(f, bfv2)); }
__device__ __forceinline__ unsigned img_off(unsigned row, unsigned ch) { return 256u * row + 16u * (ch ^ (((row & 3u) << 2) | ((row >> 2) & 3u))); }
__device__ __forceinline__ bf16x8 img_rr(const LAS unsigned char* img, unsigned row0, unsigned lane, unsigned s) { return *(const LAS bf16x8*)(img + img_off(row0 + (lane & 31u), 2u * s + (lane >> 5))); }
__device__ __forceinline__ bf16x8 img_trn(const LAS unsigned char* img, unsigned k0, unsigned lane, unsigned c) {
    const unsigned h = lane >> 5, blk = (lane >> 4) & 1u, q = (lane & 15u) >> 2, p = lane & 3u, ch = 4u * c + 2u * blk + (p >> 1), sub = 8u * (p & 1u);
    const s16x4 lo = __builtin_amdgcn_ds_read_tr16_b64_v4i16((LAS s16x4*)(img + img_off(k0 + 8u * h + q, ch) + sub));
    const s16x4 hi = __builtin_amdgcn_ds_read_tr16_b64_v4i16((LAS s16x4*)(img + img_off(k0 + 8u * h + 4u + q, ch) + sub));
    return __builtin_shufflevector(lo, hi, 0, 1, 2, 3, 4, 5, 6, 7); }
__device__ __forceinline__ bf16x8 img_trp(const LAS unsigned char* img, unsigned k0, unsigned lane, unsigned c) {
    const unsigned h = lane >> 5, blk = (lane >> 4) & 1u, q = (lane & 15u) >> 2, p = lane & 3u, ch = 4u * c + 2u * blk + (p >> 1), sub = 8u * (p & 1u);
    const s16x4 lo = __builtin_amdgcn_ds_read_tr16_b64_v4i16((LAS s16x4*)(img + img_off(k0 + 4u * h + q, ch) + sub));
    const s16x4 hi = __builtin_amdgcn_ds_read_tr16_b64_v4i16((LAS s16x4*)(img + img_off(k0 + 8u + 4u * h + q, ch) + sub));
    return __builtin_shufflevector(lo, hi, 0, 1, 2, 3, 4, 5, 6, 7); }
__device__ __forceinline__ float wave_scan_add(float v, int) {
    v += dpp_old<0x111, 0xF>(0.f, v); v += dpp_old<0x112, 0xF>(0.f, v); v += dpp_old<0x114, 0xF>(0.f, v); v += dpp_old<0x118, 0xF>(0.f, v);
    v += dpp_old<0x142, 0xA>(0.f, v); v += dpp_old<0x143, 0xC>(0.f, v);
    return v; }
__device__ __forceinline__ float wave_scan_max(float v, int) {
    constexpr float NI = -3.0e38f;
    v = fmaxf(v, dpp_old<0x111, 0xF>(NI, v)); v = fmaxf(v, dpp_old<0x112, 0xF>(NI, v)); v = fmaxf(v, dpp_old<0x114, 0xF>(NI, v)); v = fmaxf(v, dpp_old<0x118, 0xF>(NI, v));
    v = fmaxf(v, dpp_old<0x142, 0xA>(NI, v)); v = fmaxf(v, dpp_old<0x143, 0xC>(NI, v));
    return v; }
__device__ __forceinline__ void unpack8(const u32x4 w, float (&f)[8]) { f[0] = bflo(w.x); f[1] = bfhi(w.x); f[2] = bflo(w.y); f[3] = bfhi(w.y); f[4] = bflo(w.z); f[5] = bfhi(w.z); f[6] = bflo(w.w); f[7] = bfhi(w.w); }
__device__ __forceinline__ void conv2rows(const u32x4 (&pre)[5], const float (&cw)[4][8], float (&out)[2][8]) {
    float pf[5][8];
#pragma unroll
    for (int i = 0; i < 5; ++i) unpack8(pre[i], pf[i]);
#pragma unroll
    for (int rr = 0; rr < 2; ++rr)
#pragma unroll
        for (int e = 0; e < 8; ++e) { float a = 0.f;
#pragma unroll
            for (int j = 0; j < 4; ++j) a += pf[rr + j][e] * cw[j][e];
            out[rr][e] = a * fast_sigmoid(a); }
}
__device__ __forceinline__ void load_pre5(const bf16_t* __restrict__ P, int tok0, int c, int l0, int col, u32x4 (&pre)[5]) {
#pragma unroll
    for (int i = 0; i < 5; ++i) { const int l = l0 - 3 + i; pre[i] = (c * 64 + l >= 0) ? *(const u32x4*)(P + (size_t)(tok0 + l) * NP + col) : (u32x4){0u, 0u, 0u, 0u}; }
}
__device__ __forceinline__ void load_cw(const float* __restrict__ conv_w, int ch, float (&cw)[4][8]) {
#pragma unroll
    for (int j = 0; j < 4; ++j) { const f32x4 a = *(const f32x4*)(conv_w + j * 1024 + ch), b = *(const f32x4*)(conv_w + j * 1024 + ch + 4);
        cw[j][0] = a.x; cw[j][1] = a.y; cw[j][2] = a.z; cw[j][3] = a.w; cw[j][4] = b.x; cw[j][5] = b.y; cw[j][6] = b.z; cw[j][7] = b.w; }
}
constexpr float KSCALE = 0.08838834764831845f;

__device__ __forceinline__ void phase2_group(Frame& F) {
    const bf16_t* P = (const bf16_t*)(F.ws + WS_P); const float* gates = (const float*)(F.ws + WS_GATES); const float* conv_w = F.in[I_CONVW];
    u32x4* Cloc = (u32x4*)(F.ws + WS_CST); u32x4* Ctot = (u32x4*)(F.ws + WS_CIN); float* nst = (float*)(F.ws + WS_NST); float* mloc = (float*)(F.ws + WS_MLOC); float* btot = (float*)(F.ws + WS_BTOT);
    float* ntot = (float*)(F.ws + WS_NIN); float* mgrp = (float*)(F.ws + WS_MIN);
    LAS unsigned char* IMG_WK = F.lds; LAS unsigned char* IMG_V = F.lds + 16384; LAS float* s_w = (LAS float*)(F.lds + 32768);
    const int lane = flane(), wave = F.wave, tid = wave * 64 + lane, d8 = tid & 15, lq = tid >> 4, l0 = 2 * lq;
    u32x4 pre[5], vv[2]; float g_i = 0.f, g_f = 0.f;
#define P2_LOAD(uu) do { const int c_ = (uu) & 63, h_ = ((uu) >> 6) & 3, b_ = (uu) >> 8, tok0_ = b_ * SEQ + c_ * 64; \
        load_pre5(P, tok0_, c_, l0, 512 + h_ * 128 + 8 * d8, pre); \
        _Pragma("unroll") for (int rr = 0; rr < 2; ++rr) vv[rr] = *(const u32x4*)(P + (size_t)(tok0_ + l0 + rr) * NP + PC_V + h_ * 128 + 8 * d8); \
        if (wave == 0) { const float* pr_ = gates + (size_t)(tok0_ + lane) * 8; g_i = pr_[h_]; g_f = pr_[4 + h_]; } } while (0)
    for (int up = blockIdx.x; up < 256; up += F.G) {
        const int u0 = (up >> 4) * 64 + 4 * (up & 15), h = (up >> 4) & 3;
        P2_LOAD(u0);
        float cw[4][8]; load_cw(conv_w, 512 + h * 128 + 8 * d8, cw);
        const int a = wave >> 1, b0 = 2 * (wave & 1), r = lane & 31, hh = lane >> 5;
        f32x16 ct0, ct1, cn;
#pragma unroll
        for (int i = 0; i < 16; ++i) { ct0[i] = 0.f; ct1[i] = 0.f; cn[i] = 0.f; }
        float mg = -1e30f, Bg = 0.f;
#pragma unroll 1
        for (int cc = 0; cc < 4; ++cc) {
            const int u = u0 + cc;
            LAS float* sw = s_w + 128 * (cc & 1);
            if (wave == 0) { const float ig = g_i + F.in[I_IGB][h]; const float lf = logsigmoidf_(g_f + F.in[I_FGB][h]);
                const float bb = wave_scan_add(lf, lane); const float bt = lane_bcast(bb, 63); const float g = bt - bb + ig; const float m = wave_max(g);
                sw[lane] = __expf(g - m); if (lane == 0) { mloc[u] = m; btot[u] = bt; sw[64] = m; sw[65] = bt; } }
            __syncthreads();
            const float ml = sw[64], bt = sw[65];
            { float kc[2][8]; conv2rows(pre, cw, kc);
#pragma unroll
              for (int rr = 0; rr < 2; ++rr) { const float w = sw[l0 + rr] * KSCALE;
                  *(LAS bf16x8*)(IMG_WK + img_off(l0 + rr, d8)) = pack8(kc[rr][0] * w, kc[rr][1] * w, kc[rr][2] * w, kc[rr][3] * w, kc[rr][4] * w, kc[rr][5] * w, kc[rr][6] * w, kc[rr][7] * w);
                  *(LAS u32x4*)(IMG_V + img_off(l0 + rr, d8)) = vv[rr]; } }
            __syncthreads();
            if (cc < 3) P2_LOAD(u + 1);
            f32x16 acc0, acc1, accn;
#pragma unroll
            for (int i = 0; i < 16; ++i) { acc0[i] = 0.f; acc1[i] = 0.f; accn[i] = 0.f; }
            const bf16x8 ones = {(short)0x3F80, (short)0x3F80, (short)0x3F80, (short)0x3F80, (short)0x3F80, (short)0x3F80, (short)0x3F80, (short)0x3F80};
#pragma unroll
            for (int ks = 0; ks < 4; ++ks) { const bf16x8 A = img_trn(IMG_WK, 16 * ks, lane, a);
                acc0 = MFMA32(A, img_trn(IMG_V, 16 * ks, lane, b0), acc0); acc1 = MFMA32(A, img_trn(IMG_V, 16 * ks, lane, b0 + 1), acc1);
                if (b0 == 0) accn = MFMA32(A, ones, accn); }
            if (b0 == 0 && r == 0) {
#pragma unroll
                for (int i = 0; i < 16; ++i) nst[(size_t)u * 128 + 32 * a + (i & 3) + 8 * (i >> 2) + 4 * hh] = accn[i]; }
            { u32x4* dst = Cloc + ((size_t)u * 8 + wave) * 256 + lane;
#pragma unroll
              for (int q = 0; q < 2; ++q) {
                  dst[q * 64] = (u32x4){pack2(acc0[8 * q], acc0[8 * q + 1]), pack2(acc0[8 * q + 2], acc0[8 * q + 3]), pack2(acc0[8 * q + 4], acc0[8 * q + 5]), pack2(acc0[8 * q + 6], acc0[8 * q + 7])};
                  dst[(2 + q) * 64] = (u32x4){pack2(acc1[8 * q], acc1[8 * q + 1]), pack2(acc1[8 * q + 2], acc1[8 * q + 3]), pack2(acc1[8 * q + 4], acc1[8 * q + 5]), pack2(acc1[8 * q + 6], acc1[8 * q + 7])}; } }
            { const float mn = fmaxf(bt + mg, ml), so = __expf(bt + mg - mn), sl = __expf(ml - mn);
#pragma unroll
              for (int i = 0; i < 16; ++i) { ct0[i] = so * ct0[i] + sl * acc0[i]; ct1[i] = so * ct1[i] + sl * acc1[i]; cn[i] = so * cn[i] + sl * accn[i]; }
              mg = mn; Bg += bt; }
        }
        { u32x4* dst = Ctot + ((size_t)up * 8 + wave) * 256 + lane;
#pragma unroll
          for (int q = 0; q < 2; ++q) {
              dst[q * 64] = (u32x4){pack2(ct0[8 * q], ct0[8 * q + 1]), pack2(ct0[8 * q + 2], ct0[8 * q + 3]), pack2(ct0[8 * q + 4], ct0[8 * q + 5]), pack2(ct0[8 * q + 6], ct0[8 * q + 7])};
              dst[(2 + q) * 64] = (u32x4){pack2(ct1[8 * q], ct1[8 * q + 1]), pack2(ct1[8 * q + 2], ct1[8 * q + 3]), pack2(ct1[8 * q + 4], ct1[8 * q + 5]), pack2(ct1[8 * q + 6], ct1[8 * q + 7])}; } }
        if (b0 == 0 && r == 0) {
#pragma unroll
            for (int i = 0; i < 16; ++i) ntot[(size_t)up * 128 + 32 * a + (i & 3) + 8 * (i >> 2) + 4 * hh] = cn[i]; }
        if (tid == 0) { mgrp[up] = mg; mgrp[256 + up] = Bg; }
        __syncthreads();
    }
#undef P2_LOAD
}
__device__ __forceinline__ void phase2_pool(Frame& F) {
    const bf16_t* P = (const bf16_t*)(F.ws + WS_P); bf16_t* ycat = (bf16_t*)(F.ws + WS_YCAT); const bf16_t* pwt = (const bf16_t*)(F.ws + WS_POOLWT); const float* pool_scale = F.in[I_POOLS];
    LAS unsigned char* IMG_PL = F.lds; LAS unsigned char* IMG_PW = F.lds + 16384; LAS unsigned char* STG = F.lds + 49152;
    const int lane = flane(), wave = F.wave, tid = wave * 64 + lane, d8 = tid & 15, lq = tid >> 4, l0 = 2 * lq;
    const int gi = blockIdx.x & 3, w = 2 << gi;
    const float sc = pool_scale[gi * 128 + 32 * (wave & 3) + (lane & 31)];
    u32x4 rw[17];
#define POOL_LOAD(uu) do { const int tok0_ = ((uu) >> 2) * 64, s1_ = ((tok0_ + l0 + 1) & (SEQ - 1)); const bf16_t* base_ = P + (size_t)(tok0_ + l0 + 1) * NP + PC_U + gi * 128 + 8 * d8; \
        _Pragma("unroll") for (int j = 0; j < 17; ++j) { int jj = j < w ? j : w; jj = jj < s1_ ? jj : s1_; rw[j] = *(const u32x4*)(base_ - (size_t)jj * NP); } } while (0)
    if ((int)blockIdx.x < 1024) {
        POOL_LOAD((int)blockIdx.x);
#pragma unroll
        for (int i = 0; i < 4; ++i) { const int idx = tid + i * NTHR, d = idx >> 4, j = idx & 15;
            *(LAS u32x4*)(IMG_PW + img_off(d, j)) = *(const u32x4*)(pwt + ((size_t)gi * 128 + d) * 128 + j * 8); } }
    for (int u = blockIdx.x; u < 1024; u += F.G) {
        const int tok0 = (u >> 2) * 64;
        {   const int s1 = ((tok0 + l0 + 1) & (SEQ - 1));
            float sum[8], cur0[8], cur1[8], old[8], f[8];
#pragma unroll
            for (int e = 0; e < 8; ++e) sum[e] = 0.f;
#pragma unroll
            for (int j = 2; j < 16; ++j) { const bool on = (j < w) && (s1 - j >= 0); unpack8(rw[j], f);
#pragma unroll
                for (int e = 0; e < 8; ++e) sum[e] += on ? f[e] : 0.f; }
            unpack8(rw[1], cur0); unpack8(rw[0], cur1);
            { const u32x4 ro = (w == 2) ? rw[2] : ((w == 4) ? rw[4] : ((w == 8) ? rw[8] : rw[16])); unpack8(ro, old); const bool on = (s1 - w >= 0);
#pragma unroll
              for (int e = 0; e < 8; ++e) old[e] = on ? old[e] : 0.f; }
            const int s0 = s1 - 1; const float ic0 = 1.f / (float)((s0 + 1 < w) ? s0 + 1 : w), ic1 = 1.f / (float)((s1 + 1 < w) ? s1 + 1 : w);
            float p0[8], p1[8];
#pragma unroll
            for (int e = 0; e < 8; ++e) { const float mid = sum[e] + cur0[e];
                p0[e] = (mid + old[e]) * ic0 - cur0[e]; p1[e] = (mid + cur1[e]) * ic1 - cur1[e]; }
            *(LAS bf16x8*)(IMG_PL + img_off(l0, d8)) = pack8(p0[0], p0[1], p0[2], p0[3], p0[4], p0[5], p0[6], p0[7]);
            *(LAS bf16x8*)(IMG_PL + img_off(l0 + 1, d8)) = pack8(p1[0], p1[1], p1[2], p1[3], p1[4], p1[5], p1[6], p1[7]);
        }
        __syncthreads();
        if (u + F.G < 1024) POOL_LOAD(u + F.G);
        { const int wi = wave >> 2, wj = wave & 3, r = lane & 31, hh = lane >> 5;
          f32x16 acc;
#pragma unroll
          for (int i = 0; i < 16; ++i) acc[i] = 0.f;
#pragma unroll
          for (int sx = 0; sx < 8; ++sx) acc = MFMA32(img_rr(IMG_PL, 32 * wi, lane, sx), img_rr(IMG_PW, 32 * wj, lane, sx), acc);
          const int d = 32 * wj + r;
#pragma unroll
          for (int i = 0; i < 16; ++i) { const int l = 32 * wi + (i & 3) + 8 * (i >> 2) + 4 * hh;
              *(LAS unsigned short*)(STG + l * 256 + 2 * (d ^ ((l & 15) << 3))) = (unsigned short)(pack2(acc[i] * sc, 0.f) & 0xffffu); } }
        __syncthreads();
#pragma unroll
        for (int i = 0; i < 2; ++i) { const int idx = tid + i * NTHR, l = idx >> 4, j = idx & 15;
            *(u32x4*)(ycat + (size_t)(tok0 + l) * D + 512 + gi * 128 + j * 8) = *(const LAS u32x4*)(STG + l * 256 + ((j ^ (l & 15)) << 4)); }
        __syncthreads();
    }
#undef POOL_LOAD
}
__device__ __forceinline__ void state_axpy(f32x16& C0, f32x16& C1, const float so, const float sl, const u32x4 (&t)[4]) {
#pragma unroll
    for (int q = 0; q < 2; ++q) { float f[8]; unpack8(t[q], f);
#pragma unroll
        for (int e = 0; e < 8; ++e) C0[8 * q + e] = so * C0[8 * q + e] + sl * f[e];
        unpack8(t[2 + q], f);
#pragma unroll
        for (int e = 0; e < 8; ++e) C1[8 * q + e] = so * C1[8 * q + e] + sl * f[e]; }
}
__device__ __forceinline__ void phase4_group(Frame& F) {
    const bf16_t* P = (const bf16_t*)(F.ws + WS_P); const float* gates = (const float*)(F.ws + WS_GATES); const float* conv_w = F.in[I_CONVW]; const float* head_norm_g = F.in[I_HNG];
    const u32x4* Cloc = (const u32x4*)(F.ws + WS_CST); const u32x4* Ctot = (const u32x4*)(F.ws + WS_CIN); const float* nst = (const float*)(F.ws + WS_NST);
    const float* mloc = (const float*)(F.ws + WS_MLOC); const float* btot = (const float*)(F.ws + WS_BTOT); const float* ntot = (const float*)(F.ws + WS_NIN); const float* mgrp = (const float*)(F.ws + WS_MIN);
    bf16_t* ycat = (bf16_t*)(F.ws + WS_YCAT);
    LAS unsigned char* IMG_Q = F.lds; LAS unsigned char* IMG_K = F.lds + 16384; LAS unsigned char* IMG_V = F.lds + 32768; LAS unsigned char* IMG_C = F.lds + 49152;
    LAS float* HB = (LAS float*)(F.lds + 81920);
    LAS unsigned char* RAWQ = F.lds + 115712; LAS unsigned char* RAWK = RAWQ + 17408;
    LAS float* s_c = (LAS float*)(F.lds + 150528); LAS float* s_M = s_c + 64; LAS float* s_int = s_M + 64; LAS float* s_edn = s_int + 64; LAS float* s_qn = s_edn + 64; LAS float* s_rd = s_qn + 64;
    LAS float* s_n = s_rd + 256;
    const int lane = flane(), wave = F.wave, tid = wave * 64 + lane, d8 = tid & 15, lq = tid >> 4, l0 = 2 * lq;
#define P4_DMA_RAW(uu) do { const int c_ = (uu) & 63, h_ = ((uu) >> 6) & 3, b_ = (uu) >> 8, tok0_ = b_ * SEQ + c_ * 64; \
        _Pragma("unroll") for (int i = 0; i < 3; ++i) { const int pc = 8 * i + wave; if (pc < 17) { const int rr_ = pc * 4 + (lane >> 4); int tk = tok0_ - 3 + rr_; tk = tk < 0 ? 0 : (tk > T - 1 ? T - 1 : tk); \
            const char* src_ = (const char*)(P + (size_t)tk * NP + h_ * 128) + (lane & 15) * 16; \
            __builtin_amdgcn_global_load_lds((const unsigned*)src_, (LAS unsigned*)(RAWQ + pc * 1024), 16, 0, 0); \
            __builtin_amdgcn_global_load_lds((const unsigned*)(src_ + 1024), (LAS unsigned*)(RAWK + pc * 1024), 16, 0, 0); } } } while (0)
#define P4_DMA_V(uu) do { const int c_ = (uu) & 63, h_ = ((uu) >> 6) & 3, b_ = (uu) >> 8, tok0_ = b_ * SEQ + c_ * 64; const unsigned ol_ = (unsigned)olane(); \
        _Pragma("unroll") for (int i = 0; i < 2; ++i) { const unsigned d = (unsigned)((8 * i + wave) * 64) + ol_, row = d >> 4, sl = d & 15u, j = sl ^ (((row & 3u) << 2) | ((row >> 2) & 3u)); \
            __builtin_amdgcn_global_load_lds((const unsigned*)((const char*)(P + (size_t)(tok0_ + row) * NP + PC_V + h_ * 128) + j * 16), (LAS unsigned*)(IMG_V + (8 * i + wave) * 1024), 16, 0, 0); } } while (0)
    float g_i = 0.f, g_f = 0.f;
#define P4_GATES(uu) do { if (wave == 0) { const int c_ = (uu) & 63, h_ = ((uu) >> 6) & 3, b_ = (uu) >> 8; const float* pr_ = gates + (size_t)(b_ * SEQ + c_ * 64 + lane) * 8; g_i = pr_[h_]; g_f = pr_[4 + h_]; } } while (0)
    const int ca = wave >> 1, cb0 = 2 * (wave & 1), cr = lane & 31, chh = lane >> 5;
    {
        const int up = blockIdx.x; const int bh = up >> 4, g = up & 15, h = bh & 3, b = bh >> 2, u0 = bh * 64 + 4 * g;
        P4_DMA_RAW(u0); P4_DMA_V(u0); P4_GATES(u0);
        f32x16 C0, C1;
#pragma unroll
        for (int i = 0; i < 16; ++i) { C0[i] = 0.f; C1[i] = 0.f; }
        float m = 0.f, nv = 0.f;
        float mgv = -1e30f, Bgv = 0.f;
        if (lane < g) { mgv = mgrp[bh * 16 + lane]; Bgv = mgrp[256 + bh * 16 + lane]; }
#pragma unroll 1
        for (int j0 = 0; j0 < g; j0 += 8) {
            u32x4 t[8][4]; float nt[8];
#pragma unroll
            for (int jj = 0; jj < 8; ++jj) { const int j = (j0 + jj < g) ? j0 + jj : g - 1; const u32x4* src = Ctot + ((size_t)(bh * 16 + j) * 8 + wave) * 256 + lane;
#pragma unroll
                for (int q = 0; q < 4; ++q) t[jj][q] = src[q * 64];
                nt[jj] = (tid < 128) ? ntot[(size_t)(bh * 16 + j) * 128 + tid] : 0.f; }
#pragma unroll
            for (int jj = 0; jj < 8; ++jj) { const float mgj = lane_bcast(mgv, j0 + jj), Bgj = lane_bcast(Bgv, j0 + jj);
                const float mn = fmaxf(Bgj + m, mgj), so = __expf(Bgj + m - mn), sl = __expf(mgj - mn);
                state_axpy(C0, C1, so, sl, t[jj]); nv = so * nv + sl * nt[jj]; m = mn; }
        }
#pragma unroll
        for (int bb = 0; bb < 2; ++bb) { const unsigned dv = 32 * (cb0 + bb) + cr;
#pragma unroll
            for (int gq = 0; gq < 4; ++gq) { u32x2 w;
                if (bb == 0) { w.x = pack2(C0[4 * gq], C0[4 * gq + 1]); w.y = pack2(C0[4 * gq + 2], C0[4 * gq + 3]); } else { w.x = pack2(C1[4 * gq], C1[4 * gq + 1]); w.y = pack2(C1[4 * gq + 2], C1[4 * gq + 3]); }
                *(LAS u32x2*)(IMG_C + img_off(dv, 4 * ca + gq) + 8 * chh) = w; } }
#pragma unroll 1
        for (int cc = 0; cc < 4; ++cc) {
            const int u = u0 + cc, c = 4 * g + cc, tok0 = b * SEQ + c * 64;
            if (tid < 128) s_n[tid] = nv;
            float cwq[4][8], cwk[4][8]; load_cw(conv_w, h * 128 + 8 * d8, cwq); load_cw(conv_w, 512 + h * 128 + 8 * d8, cwk);
            asm volatile("s_waitcnt vmcnt(0)" ::: "memory");
            __syncthreads();
            if (wave == 0) { const float ig = g_i + F.in[I_IGB][h]; const float lf = logsigmoidf_(g_f + F.in[I_FGB][h]);
                const float bb = wave_scan_add(lf, lane); const float cc_ = ig - bb; const float M = fmaxf(m, wave_scan_max(cc_, lane));
                s_c[lane] = cc_; s_M[lane] = M; s_int[lane] = __expf(m - M); s_edn[lane] = __expf(-bb - M); }
            { u32x4 preq[5], prek[5];
              const f32x4 n0 = *(const LAS f32x4*)(s_n + 8 * d8), n1 = *(const LAS f32x4*)(s_n + 8 * d8 + 4);
#pragma unroll
              for (int i = 0; i < 5; ++i) { const bool ok = (c * 64 + l0 - 3 + i) >= 0; const u32x4 zq = *(const LAS u32x4*)(RAWQ + (l0 + i) * 256 + d8 * 16), zk = *(const LAS u32x4*)(RAWK + (l0 + i) * 256 + d8 * 16);
                  preq[i] = ok ? zq : (u32x4){0u, 0u, 0u, 0u}; prek[i] = ok ? zk : (u32x4){0u, 0u, 0u, 0u}; }
              float qc[2][8], kc[2][8]; conv2rows(preq, cwq, qc); conv2rows(prek, cwk, kc);
#pragma unroll
              for (int rr = 0; rr < 2; ++rr) {
                  *(LAS bf16x8*)(IMG_Q + img_off(l0 + rr, d8)) = pack8(qc[rr][0], qc[rr][1], qc[rr][2], qc[rr][3], qc[rr][4], qc[rr][5], qc[rr][6], qc[rr][7]);
                  *(LAS bf16x8*)(IMG_K + img_off(l0 + rr, d8)) = pack8(kc[rr][0] * KSCALE, kc[rr][1] * KSCALE, kc[rr][2] * KSCALE, kc[rr][3] * KSCALE, kc[rr][4] * KSCALE, kc[rr][5] * KSCALE, kc[rr][6] * KSCALE, kc[rr][7] * KSCALE);
                  float qn = (qc[rr][0] * n0.x + qc[rr][1] * n0.y) + (qc[rr][2] * n0.z + qc[rr][3] * n0.w) + (qc[rr][4] * n1.x + qc[rr][5] * n1.y) + (qc[rr][6] * n1.z + qc[rr][7] * n1.w);
                  qn = row16_sum(qn);
                  if (d8 == 0) s_qn[l0 + rr] = qn; } }
            __syncthreads();
            const bool more = (cc < 3);
            if (more) { P4_DMA_RAW(u + 1); P4_GATES(u + 1); }
            {
                const int wi = wave >> 2, wj = wave & 3, r = lane & 31, hh = lane >> 5, lcol = 32 * wi + r;
                const float Ml = s_M[lcol];
                bf16x8 pa[2][2]; float dsum = 0.f;
                bf16x8 qf[8];
#pragma unroll
                for (int sx = 0; sx < 8; ++sx) qf[sx] = img_rr(IMG_Q, 32 * wi, lane, sx);
#pragma unroll
                for (int rb = 0; rb < 2; ++rb) {
                    if (rb <= wi) {
                        f32x16 sa;
#pragma unroll
                        for (int i = 0; i < 16; ++i) sa[i] = 0.f;
                        { bf16x8 kf[8];
#pragma unroll
                          for (int sx = 0; sx < 8; ++sx) kf[sx] = img_rr(IMG_K, 32 * rb, lane, sx);
#pragma unroll
                          for (int sx = 0; sx < 8; ++sx) sa = MFMA32(kf[sx], qf[sx], sa); }
                        float pv[16];
#pragma unroll
                        for (int gq = 0; gq < 4; ++gq) { const f32x4 c4 = *(const LAS f32x4*)(s_c + 32 * rb + 8 * gq + 4 * hh);
#pragma unroll
                            for (int j = 0; j < 4; ++j) { const int rrow = 32 * rb + 8 * gq + 4 * hh + j; const float e = __expf(c4[j] - Ml);
                                const float v = (rrow <= lcol) ? sa[4 * gq + j] * e : 0.f; pv[4 * gq + j] = v; dsum += v; } }
                        pa[rb][0] = pack8(pv[0], pv[1], pv[2], pv[3], pv[4], pv[5], pv[6], pv[7]);
                        pa[rb][1] = pack8(pv[8], pv[9], pv[10], pv[11], pv[12], pv[13], pv[14], pv[15]);
                    }
                }
                dsum += __shfl_xor(dsum, 32);
                { const float den = dsum + s_int[lcol] * s_qn[lcol]; const float rd = __builtin_amdgcn_rcpf(fmaxf(fabsf(den), s_edn[lcol])); if (hh == 0) s_rd[wave * 32 + r] = rd; }
                f32x16 z, z2;
#pragma unroll
                for (int i = 0; i < 16; ++i) { z[i] = 0.f; z2[i] = 0.f; }
#pragma unroll
                for (int rb = 0; rb < 2; ++rb) if (rb <= wi) {
#pragma unroll
                    for (int sx = 0; sx < 2; ++sx) z = MFMA32(pa[rb][sx], img_trp(IMG_V, 32 * rb + 16 * sx, lane, wj), z); }
                { bf16x8 cf[8];
#pragma unroll
                  for (int sx = 0; sx < 8; ++sx) cf[sx] = img_rr(IMG_C, 32 * wj, lane, sx);
#pragma unroll
                  for (int sx = 0; sx < 8; ++sx) z2 = MFMA32(qf[sx], cf[sx], z2); }
#pragma unroll
                for (int gq = 0; gq < 4; ++gq) { const f32x4 rd4 = *(const LAS f32x4*)(s_rd + wave * 32 + 8 * gq + 4 * hh), in4 = *(const LAS f32x4*)(s_int + 32 * wi + 8 * gq + 4 * hh);
#pragma unroll
                    for (int j = 0; j < 4; ++j) HB[(32 * wi + 8 * gq + 4 * hh + j) * 132 + 32 * wj + r] = (z[4 * gq + j] + in4[j] * z2[4 * gq + j]) * rd4[j]; }
            }
            unsigned owc[8];
#pragma unroll
            for (int i = 0; i < 8; ++i) owc[i] = *(const unsigned*)(P + (size_t)(tok0 + wave * 8 + i) * NP + PC_O + h * 128 + 2 * lane);
            __syncthreads();
            u32x4 cl[4] = {{0u, 0u, 0u, 0u}, {0u, 0u, 0u, 0u}, {0u, 0u, 0u, 0u}, {0u, 0u, 0u, 0u}}; float nl = 0.f, ml = 0.f, bt = 0.f;
            if (more) { P4_DMA_V(u + 1);
                const u32x4* src = Cloc + ((size_t)u * 8 + wave) * 256 + olane();
#pragma unroll
                for (int q = 0; q < 4; ++q) cl[q] = src[q * 64];
                if (tid < 128) nl = nst[(size_t)u * 128 + tid];
                ml = mloc[u]; bt = btot[u]; }
            const f32x2 gg = *(const f32x2*)(head_norm_g + h * 128 + 2 * lane);
#pragma unroll
            for (int i = 0; i < 8; ++i) { const int l = wave * 8 + i; const f32x2 hv = *(const LAS f32x2*)(HB + l * 132 + 2 * lane);
                const float mu = wave_sum(hv.x + hv.y) * (1.f / 128.f); const float e0 = hv.x - mu, e1 = hv.y - mu;
                const float var = wave_sum(e0 * e0 + e1 * e1) * (1.f / 128.f); const float rstd = rsqrtf(var + EPS);
                *(unsigned*)(ycat + (size_t)(tok0 + l) * D + h * 128 + 2 * lane) = pack2(fast_sigmoid(bflo(owc[i])) * e0 * rstd * gg.x, fast_sigmoid(bfhi(owc[i])) * e1 * rstd * gg.y); }
            if (more) { const float mn = fmaxf(bt + m, ml), so = __expf(bt + m - mn), sl = __expf(ml - mn);
                const int ol = olane(), ocr = ol & 31, ochh = ol >> 5;
#pragma unroll
                for (int bb = 0; bb < 2; ++bb) { const unsigned dv = 32 * (cb0 + bb) + ocr;
#pragma unroll
                    for (int gq = 0; gq < 4; ++gq) { LAS u32x2* pp = (LAS u32x2*)(IMG_C + img_off(dv, 4 * ca + gq) + 8 * ochh); const u32x2 w = *pp;
                        const u32x4 cw4 = cl[2 * bb + (gq >> 1)]; const unsigned c0 = (gq & 1) ? cw4.z : cw4.x, c1 = (gq & 1) ? cw4.w : cw4.y;
                        u32x2 o; o.x = pack2(so * bflo(w.x) + sl * bflo(c0), so * bfhi(w.x) + sl * bfhi(c0)); o.y = pack2(so * bflo(w.y) + sl * bflo(c1), so * bfhi(w.y) + sl * bfhi(c1));
                        *pp = o; } }
                nv = so * nv + sl * nl; m = mn; }
        }
        asm volatile("s_waitcnt vmcnt(0)" ::: "memory");
        __syncthreads();
    }
#undef P4_DMA_RAW
#undef P4_DMA_V
#undef P4_GATES
}

__device__ __forceinline__ void phase6_route(Frame& F, const int probe_rep) {
    const int lane = flane(), wave = F.wave, tid = wave * 64 + lane;
    const bf16_t* x1 = (const bf16_t*)(F.ws + WS_X1); const float* g2 = F.in[I_N2G]; const float* w_router = F.in[I_WR]; const float* b_router = F.in[I_BR];
    signed char* h2 = (signed char*)(F.ws + WS_H2); float* shv = (float*)(F.ws + WS_SH); int* cnt0 = (int*)(F.ws + WS_CTL) + CW_CNT; int* list0 = (int*)(F.ws + WS_LIST); float* gate_of = (float*)(F.ws + WS_GATEOF);
    LAS unsigned char* WH = F.lds; LAS unsigned char* WL = F.lds + 65536;
    LAS float* LG = (LAS float*)(F.lds + LDS_TOK);
    LAS float* RST = LG + 64 * 33;
    LAS float* s_rs = RST + 256;
    LAS int* hist = (LAS int*)(F.lds + LDS_P6); LAS int* base = hist + 64; LAS int* s_e = base + 64; LAS int* s_t = s_e + 1024; LAS float* s_g = (LAS float*)(s_t + 256); LAS float* s_sh = s_g + 256;
    float* lsc = (float*)(F.ws + WS_LSC); float* lgw = (float*)(F.ws + WS_LGW);
    { const int e = tid & 31, kg = tid >> 5;
#pragma unroll 2
      for (int i = 0; i < 8; ++i) { const int c = kg + 16 * i; float w[8], wl[8];
#pragma unroll
          for (int j = 0; j < 8; ++j) { const int k = 8 * c + j; w[j] = w_router[(size_t)k * NE + e] * g2[k]; }
          const bf16x8 hi = pack8(w[0], w[1], w[2], w[3], w[4], w[5], w[6], w[7]);
#pragma unroll
          for (int j = 0; j < 8; ++j) wl[j] = w[j] - bf2f((unsigned short)hi[j]);
          const unsigned off = (unsigned)e * 2048u + 16u * (unsigned)(c ^ (e & 15));
          *(LAS bf16x8*)(WH + off) = hi; *(LAS bf16x8*)(WL + off) = pack8(wl[0], wl[1], wl[2], wl[3], wl[4], wl[5], wl[6], wl[7]); } }
    if (tid < 64) hist[tid] = 0;
    __syncthreads();
    const int t0 = 64 * F.vcu;
    const __amdgpu_buffer_rsrc_t x1rsrc = __builtin_amdgcn_make_buffer_rsrc((void*)x1, 0, T * D * 2, 0x00020000);
#pragma unroll 1
    for (int rep = 0; rep < probe_rep; ++rep) {
        {
            const int tb = wave >> 2, kq = wave & 3, r = lane & 31, h = lane >> 5;
            const int voff = (r * 1024 + 8 * h) * 2, sbase = ((t0 + 32 * tb) * 1024 + 256 * kq) * 2;
            f32x16 acc;
#pragma unroll
            for (int i = 0; i < 16; ++i) acc[i] = 0.f;
            float ss = 0.f;
#pragma unroll
            for (int sb = 0; sb < 16; sb += 8) {
                u32x4 xa[8];
#pragma unroll
                for (int sx = 0; sx < 8; ++sx) xa[sx] = __builtin_amdgcn_raw_buffer_load_b128(x1rsrc, voff, sbase + (sb + sx) * 32, 0);
#pragma unroll
                for (int sx = 0; sx < 8; ++sx) { float f[8]; unpack8(xa[sx], f);
                    ss += ((f[0] * f[0] + f[1] * f[1]) + (f[2] * f[2] + f[3] * f[3])) + ((f[4] * f[4] + f[5] * f[5]) + (f[6] * f[6] + f[7] * f[7]));
                    const bf16x8 ah = __builtin_bit_cast(bf16x8, xa[sx]);
                    const unsigned boff = (unsigned)r * 2048u + 16u * (unsigned)((32 * kq + 2 * (sb + sx) + h) ^ (r & 15));
                    const bf16x8 bh = *(const LAS bf16x8*)(WH + boff), bl = *(const LAS bf16x8*)(WL + boff);
                    acc = MFMA32(ah, bh, acc); acc = MFMA32(ah, bl, acc); }
            }
            ss += __shfl_xor(ss, 32);
            if (h == 0) RST[(32 * tb + r) * 4 + kq] = ss;
#pragma unroll 1
            for (int q = 0; q < 4; ++q) {
                if (kq == q) {
#pragma unroll
                    for (int i = 0; i < 16; ++i) { LAS float* pp = LG + (32 * tb + (i & 3) + 8 * (i >> 2) + 4 * h) * 33 + r; *pp = (q == 0 ? 0.f : *pp) + acc[i]; } }
                __syncthreads();
            }
        }
        LAS int* hist_ = hist + 32 * rep;
        if (wave == 0) {
            const int t = t0 + lane;
            const float rs = rsqrtf(((RST[lane * 4] + RST[lane * 4 + 1]) + (RST[lane * 4 + 2] + RST[lane * 4 + 3])) * (1.f / D) + EPS);
            s_rs[lane] = rs;
            float lg[32];
#pragma unroll
            for (int e = 0; e < 32; ++e) lg[e] = LG[lane * 33 + e] * rs + b_router[e];
            int bi[4]; float bv[4];
#pragma unroll
            for (int k = 0; k < 4; ++k) { float best = -INFINITY; int bb = 0;
#pragma unroll
                for (int e = 0; e < 32; ++e) if (lg[e] > best) { best = lg[e]; bb = e; }
#pragma unroll
                for (int e = 0; e < 32; ++e) if (e == bb) lg[e] = -INFINITY;
                bi[k] = bb; bv[k] = best; }
            float ex[4], se = 0.f;
#pragma unroll
            for (int k = 0; k < 4; ++k) { ex[k] = __expf(bv[k] - bv[0]); se += ex[k]; }
            const float rse = __builtin_amdgcn_rcpf(se);
#pragma unroll
            for (int k = 0; k < 4; ++k) { const int lr = __hip_atomic_fetch_add(hist_ + bi[k], 1, __ATOMIC_RELAXED, __HIP_MEMORY_SCOPE_WORKGROUP);
                s_e[lane * 4 + k] = bi[k] | (lr << 8); s_g[lane * 4 + k] = ex[k] * rse; }
            s_t[lane] = t;
        }
        __syncthreads();
        int nbase = 0;
        if (tid < 32) { const int n = hist_[tid]; nbase = n ? atomicAdd(cnt0 + (rep ? 8128 : 0) + tid * 64, n) : 0; }
        if (rep == 0) {
            f32x4 gg[4]; u32x2 nx[4];
#pragma unroll
            for (int j = 0; j < 4; ++j) { gg[j] = *(const f32x4*)(g2 + 256 * j + 4 * lane); nx[j] = ((const u32x2*)(x1 + (size_t)(t0 + wave * 8) * D) + lane)[64 * j]; }
#pragma unroll 1
            for (int i = 0; i < 8; ++i) {
                const int li = wave * 8 + i, t = t0 + li; const float rs = s_rs[li];
                f32x4 hv[4]; float hmax = 0.f;
#pragma unroll
                for (int j = 0; j < 4; ++j) { hv[j] = (f32x4){bflo(nx[j].x), bfhi(nx[j].x), bflo(nx[j].y), bfhi(nx[j].y)} * gg[j];
                    hmax = fmaxf(fmaxf(hmax, fmaxf(fabsf(hv[j].x), fabsf(hv[j].y))), fmaxf(fabsf(hv[j].z), fabsf(hv[j].w))); }
                if (i < 7) { const u32x2* xr = (const u32x2*)(x1 + (size_t)(t + 1) * D) + lane;
#pragma unroll
                    for (int j = 0; j < 4; ++j) nx[j] = xr[64 * j]; }
                hmax = wave_max(hmax);
                const float qi = hmax > 0.f ? 127.0f / hmax : 0.f; unsigned* o4 = (unsigned*)(h2 + (size_t)t * D) + lane;
#pragma unroll
                for (int j = 0; j < 4; ++j) { const f32x4 hq = hv[j] * qi; o4[64 * j] = pg8::q4(hq.x, hq.y, hq.z, hq.w); }
                if (lane == 0) { const float shval = hmax > 0.f ? hmax * rs * (1.0f / 127.0f) : 1.0f; shv[t] = shval; s_sh[li] = shval; }
            }
        }
        if (tid < 32) base[tid] = nbase;
        __syncthreads();
        if (tid < 256) { const int li = tid >> 2, k = tid & 3, t = s_t[li]; const int ew = s_e[tid], e = ew & 255, lr = ew >> 8; int* list = rep ? (int*)(F.ws + WS_ACT) : list0;
            list[e * T + base[e] + lr] = t * 4 + k;
            if (!rep) { gate_of[t * 4 + k] = s_g[tid]; lsc[e * T + base[e] + lr] = s_sh[li]; lgw[e * T + base[e] + lr] = s_g[tid]; } }
        __syncthreads();
    }
}

__device__ __forceinline__ int moe_tables(Frame& F) {
    LAS int* lcnt = (LAS int*)(F.lds + LDS_CNT); LAS int* ltp = (LAS int*)(F.lds + LDS_TP); LAS int* lte = (LAS int*)(F.lds + LDS_TE);
    const int* cnt = (const int*)(F.ws + WS_CTL) + CW_CNT;
    const int lane = flane();
    if (F.wave == 0) {
        const int c = lane < NE ? cnt[lane * 64] : 0, nt = (c + 255) >> 8;
        const int incl = (int)wave_scan_add((float)nt, lane);
        const int excl = incl - nt;
        if (lane < NE) { lcnt[lane] = c; ltp[lane] = excl; for (int j = 0; j < nt; ++j) lte[excl + j] = lane; }
        if (lane == NE - 1) ltp[NE] = incl;
    }
    __syncthreads();
    return ltp[NE];
}
template <int MODE, class Sched>
__device__ __forceinline__ void build_row_tables(Frame& F, const Sched& S) {
    const int* list = (const int*)(F.ws + WS_LIST); const float* vals = (const float*)(F.ws + (MODE == 0 ? WS_LSC : WS_LGW));
    LAS int* tok = (LAS int*)(F.lds + LDS_TOK); LAS float* tsc = (LAS float*)(F.lds + LDS_TSC);
    const int tid = F.wave * 64 + flane(); const int nent = (S.nmine < 10 ? S.nmine : 10) * 256;
    int a[5]; float v[5];
#pragma unroll
    for (int k = 0; k < 5; ++k) { const int idx = tid + k * NTHR; a[k] = -1; v[k] = 0.f;
        if (idx < nent) { pg8::Unit u; S.next(idx >> 8, u); const int r = idx & 255; if (r < u.nv) { a[k] = list[u.lbase + r]; v[k] = vals[u.lbase + r]; } } }
#pragma unroll
    for (int k = 0; k < 5; ++k) { const int idx = tid + k * NTHR; if (idx < nent) { tok[idx] = a[k] < 0 ? 0 : (MODE == 0 ? (a[k] >> 2) * D : a[k]); tsc[idx] = v[k]; } }
    __syncthreads();
}

__device__ __forceinline__ void phase9_final(Frame& F, const bool x1_lds) {
    const bf16_t* x1 = (const bf16_t*)(F.ws + WS_X1); const unsigned char* ybuf = (const unsigned char*)(F.ws + WS_YBUF); const float* gf = F.in[I_NFG]; float* out = F.out;
    const int gw = F.vcu * NWAVES + F.wave, NGW = F.G * NWAVES, lane = flane();
    f32x4 gg[4];
#pragma unroll
    for (int j = 0; j < 4; ++j) gg[j] = *(const f32x4*)(gf + 256 * j + 4 * lane);
    for (int t = gw; t < T; t += 2 * NGW) {
        f32x4 v[2][4]; unsigned y[2][4][4];
#pragma unroll
        for (int q = 0; q < 2; ++q) { const int tq = (t + q * NGW < T) ? t + q * NGW : t; const u32x2* xr = (const u32x2*)(x1 + (size_t)tq * D) + lane;
            const LAS u32x2* xl = (const LAS u32x2*)(F.lds + (((tq - gw) / NGW) * 8 + F.wave) * 2048) + lane;
#pragma unroll
            for (int j = 0; j < 4; ++j) { const u32x2 xw = x1_lds ? xl[64 * j] : __builtin_nontemporal_load(xr + 64 * j); v[q][j] = (f32x4){bflo(xw.x), bfhi(xw.x), bflo(xw.y), bfhi(xw.y)}; }
#pragma unroll
            for (int k = 0; k < 4; ++k) { const unsigned* yr = (const unsigned*)(ybuf + (size_t)(tq * 4 + k) * D) + lane;
#pragma unroll
                for (int j = 0; j < 4; ++j) y[q][k][j] = __builtin_nontemporal_load(yr + 64 * j); } }
#pragma unroll
        for (int q = 0; q < 2; ++q) { if (t + q * NGW < T) {
#pragma unroll
            for (int j = 0; j < 4; ++j) { f32x4 sb = {0.f, 0.f, 0.f, 0.f};
#pragma unroll
                for (int k = 0; k < 4; ++k) { const unsigned yy = y[q][k][j]; sb.x += (float)(yy & 255u); sb.y += (float)((yy >> 8) & 255u); sb.z += (float)((yy >> 16) & 255u); sb.w += (float)(yy >> 24); }
                v[q][j] = v[q][j] + (sb - 512.0f) * Y_SCALE; }
            float ss = 0.f;
#pragma unroll
            for (int j = 0; j < 4; ++j) ss += (v[q][j].x * v[q][j].x + v[q][j].y * v[q][j].y) + (v[q][j].z * v[q][j].z + v[q][j].w * v[q][j].w);
            const float rs = rsqrtf(wave_sum(ss) * (1.f / D) + EPS);
            f32x4* orow = (f32x4*)(out + (size_t)(t + q * NGW) * D) + lane;
#pragma unroll
            for (int j = 0; j < 4; ++j) __builtin_nontemporal_store(v[q][j] * rs * gg[j], orow + 64 * j); } }
    }
}

__global__ void __launch_bounds__(NTHR, 2) mega(Args args) {
    extern __shared__ __attribute__((aligned(16))) unsigned char lds_raw[];
    Frame F;
    F.lds = (LAS unsigned char*)lds_raw;
    F.wave = __builtin_amdgcn_readfirstlane((int)threadIdx.x >> 6);
    F.G = gridDim.x; { const int bx = blockIdx.x; F.vcu = (F.G % 8 == 0) ? (bx % 8) * (F.G / 8) + bx / 8 : bx; }
#pragma unroll
    for (int i = 0; i < 20; ++i) F.in[i] = args.in[i];
    F.out = args.out; F.ws = args.ws;
    if (threadIdx.x < 16) ((LAS unsigned*)(F.lds + LDS_BARW))[threadIdx.x] = 0u;
    __syncthreads();
    unsigned* ctl = (unsigned*)(F.ws + WS_CTL);
    XcdBarrier bar; bar.bar = ctl + CW_BAR; bar.x = 0; bar.st = nullptr;
    if (MK_N_LAUNCHES == 1) bar = xcd_barrier_post(ctl + CW_BAR, (volatile LAS unsigned*)(F.lds + LDS_BARW));
    const int lo = args.ph_lo, hi = args.ph_hi;
#define IN(k) (lo <= (k) && (k) < hi)
#define SEAM(k) do { if (IN(k) && IN((k) + 1)) { if ((k) <= 6) xcd_barrier_fill(bar, F); else if ((k) == 8) xcd_barrier_x1(bar, F); else xcd_barrier(bar, F.wave); if ((DUP_MASK >> 10) & 1) xcd_barrier(bar, F.wave); } } while (0)

    if (IN(0)) { REP(0) phase0(F); SEAM(0); }
    if (IN(1)) { {
        pg8::DenseSchedT<1> S; S.init((const bf16_t*)(F.ws + WS_XQ), (const bf16_t*)(F.ws + WS_WIN), T, NP, D, F.G, (int)blockIdx.x, 1 + ((DUP_MASK >> 1) & 1));
        pg8::EpRowColScale8 E{(bf16_t*)(F.ws + WS_P), NP, (const float*)(F.ws + WS_RS1), (const float*)(F.ws + WS_SWIN), F.lds + LDS_EPI};
        pg8::gemm_phase<pg8::EpRowColScale8, pg8::DenseSchedT<1>, true, true>(F.lds, S, E, F.wave); }
        SEAM(1);
    }
    if (IN(2)) { REP(2) { phase2_group(F); phase2_pool(F); } SEAM(2); }
    if (IN(4)) { REP(4) phase4_group(F); SEAM(4); }
    if (IN(5)) { {
        pg8::DenseSched S; S.init((const bf16_t*)(F.ws + WS_YCAT), (const bf16_t*)(F.ws + WS_WOUT), T, D, D, F.G, (int)blockIdx.x, 1 + ((DUP_MASK >> 5) & 1));
        pg8::EpResidQ8 E{(const signed char*)(F.ws + WS_XQ), (const float*)(F.ws + WS_SX), (bf16_t*)(F.ws + WS_X1), D};
        pg8::gemm_phase(F.lds, S, E, F.wave); }
        SEAM(5);
    }
    if (IN(6)) { phase6_route(F, 1 + ((DUP_MASK >> 6) & 1)); __syncthreads(); { int par = 0; while (quant_pull(F, par, 1)) par ^= 1; } SEAM(6); }
    if (IN(7)) {
        const int ntiles = moe_tables(F);
        pg8::MoeSched<true, 8, 1> S; S.A = (const void*)(F.ws + WS_H2); S.Bt = (const void*)(F.ws + WS_WGU); S.K = D; S.setup(ntiles * 8, F.G, (int)blockIdx.x, 1 + ((DUP_MASK >> 7) & 1), false);
        S.cnt = (const LAS int*)(F.lds + LDS_CNT); S.tp = (const LAS int*)(F.lds + LDS_TP); S.te = (const LAS int*)(F.lds + LDS_TE); S.tok = (const LAS int*)(F.lds + LDS_TOK);
        build_row_tables<0>(F, S);
        pg8::EpGlu8 E{(signed char*)(F.ws + WS_ACT), F.in[I_BG], F.in[I_BU], (const float*)(F.ws + WS_SGU), (const LAS float*)(F.lds + LDS_TSC), S.nmine > 0 ? S.nmine : 1, 0, F.lds + LDS_EPI};
        pg8::gemm_phase<pg8::EpGlu8, pg8::MoeSched<true, 8, 1>, true, MOE_ALIGN>(F.lds, S, E, F.wave);
        { int par = 0; while (quant_pull(F, par, 2)) par ^= 1; }
        SEAM(7);
    }
    if (IN(8)) {
        const int ntiles = IN(7) ? ((const LAS int*)(F.lds + LDS_TP))[NE] : moe_tables(F);
        pg8::MoeSched<false, 4, 1> S; S.A = (const void*)(F.ws + WS_ACT); S.Bt = (const void*)(F.ws + WS_WD); S.K = FF; S.setup(ntiles * 4, F.G, (int)blockIdx.x, 1 + ((DUP_MASK >> 8) & 1), true);
        S.cnt = (const LAS int*)(F.lds + LDS_CNT); S.tp = (const LAS int*)(F.lds + LDS_TP); S.te = (const LAS int*)(F.lds + LDS_TE); S.tok = (const LAS int*)(F.lds + LDS_TOK);
        build_row_tables<1>(F, S);
        pg8::EpDown8 E{(unsigned char*)(F.ws + WS_YBUF), F.in[I_BD], (const float*)(F.ws + WS_SD), (const LAS int*)(F.lds + LDS_TOK), (const LAS float*)(F.lds + LDS_TSC), S.nmine > 0 ? S.nmine : 1, 0, F.lds + LDS_EPI};
        pg8::gemm_phase<pg8::EpDown8, pg8::MoeSched<false, 4, 1>, true, MOE_ALIGN>(F.lds, S, E, F.wave);
        SEAM(8);
    }
    if (IN(9)) { REP(9) phase9_final(F, IN(8) && F.G == 256); }
#undef IN
#undef SEAM
}

extern "C" void kernel_launch(void* const* d_in, const int* in_sizes, int n_in, void* d_out, int out_size, void* d_ws, size_t ws_size, hipStream_t stream) {
    static int grid = 0;
    if (grid == 0) {
        if (n_in != 20 || in_sizes[0] != T * D || out_size != T * D || ws_size < WS_END) { fprintf(stderr, "kernel_launch: unexpected problem (n_in %d, ws %zu)\n", n_in, ws_size); grid = -1; return; }
        int dev = 0, cus = 0, per_cu = 0;
        if (hipGetDevice(&dev) != hipSuccess || hipDeviceGetAttribute(&cus, hipDeviceAttributeMultiprocessorCount, dev) != hipSuccess) { grid = -1; return; }
        if (hipFuncSetAttribute((const void*)mega, hipFuncAttributeMaxDynamicSharedMemorySize, LDS_BYTES) != hipSuccess) { fprintf(stderr, "kernel_launch: hipFuncSetAttribute failed\n"); grid = -1; return; }
        if (hipOccupancyMaxActiveBlocksPerMultiprocessor(&per_cu, (const void*)mega, NTHR, LDS_BYTES) != hipSuccess || per_cu < 1) fprintf(stderr, "kernel_launch: occupancy query reports %d\n", per_cu);
        (void)hipGetLastError();
        if (cus != 256) { fprintf(stderr, "kernel_launch: built for a 256-CU device (one 64-token routing block and one workgroup per CU); found %d CUs, nothing launched\n", cus); grid = -1; return; }
        grid = cus;
    }
    if (grid < 0) return;
    (void)hipMemsetAsync((char*)d_ws + WS_CTL, 0, CTL_ZERO_BYTES, stream);
    Args a{};
    for (int i = 0; i < 20; ++i) a.in[i] = (const float*)d_in[i];
    a.out = (float*)d_out; a.ws = (unsigned char*)d_ws;
    if (MK_N_LAUNCHES == 1) { a.ph_lo = 0; a.ph_hi = N_PHASES; hipLaunchKernelGGL(mega, dim3(grid), dim3(NTHR), LDS_BYTES, stream, a); }
    else for (int p = 0; p < N_PHASES; ++p) { a.ph_lo = p; a.ph_hi = p + 1; hipLaunchKernelGGL(mega, dim3(grid), dim3(NTHR), LDS_BYTES, stream, a); }
}
```
